# Optimizing an MI355X kernel written in HIP

```python
import jax, jax.numpy as jnp
from jax import lax
import numpy as np


D_MODEL = 1024
BATCH = 8
SEQ = 2048
DEPTH = 1

CHUNK = 64
Q_BLOCK = 128
D_A = D_MODEL // 2
HEAD_A = 64
H_A = D_A // HEAD_A
DECAY_RANK = 64
AAA_RANK = 64
D_B = D_MODEL // 2
HEAD_B = 64
H_B = D_B // HEAD_B
RWKV_COLS = 4 * D_A + DECAY_RANK + AAA_RANK
FOX_COLS = 4 * D_B + H_B
GATE_COLS = 2 * D_MODEL
IN_COLS = RWKV_COLS + FOX_COLS + GATE_COLS
RMS_EPS = 1e-6
LNX_EPS = 64e-5

kernel_name = 'hybrid_rwkv7_fox_gated_block'


def _rmsnorm(x, g):
    xf = x.astype(jnp.float32)
    y = xf * lax.rsqrt(jnp.mean(xf * xf, axis=-1, keepdims=True) + RMS_EPS)
    return (y * g.astype(jnp.float32)).astype(x.dtype)


def _token_shift(u):
    return jnp.pad(u, ((0, 0), (1, 0), (0, 0)))[:, :-1]


def _wkv7_scan(r, decay, k, v, a_vec, b_vec):
    B, S, H, N = r.shape

    def step(state, inp):
        r_t, w_t, k_t, v_t, a_t, b_t = inp
        sa = jnp.einsum('bhij,bhj->bhi', state, a_t)
        state = (state * w_t[:, :, None, :]
                 + sa[..., None] * b_t[:, :, None, :]
                 + v_t[..., None] * k_t[:, :, None, :])
        return state, jnp.einsum('bhij,bhj->bhi', state, r_t)

    xs = (jnp.moveaxis(r, 1, 0), jnp.moveaxis(decay, 1, 0), jnp.moveaxis(k, 1, 0),
          jnp.moveaxis(v, 1, 0), jnp.moveaxis(a_vec, 1, 0), jnp.moveaxis(b_vec, 1, 0))
    state0 = jnp.zeros((B, H, N, N), jnp.float32)
    _, y = lax.scan(step, state0, xs)
    return jnp.moveaxis(y, 0, 1)


def _rwkv7_mixer(u, mu, w_up, w0, a_up, a0, k_k, k_a, r_k, lnx_w, lnx_b):
    B, S, _ = u.shape
    u = u + (_token_shift(u) - u) * mu
    r, k, v, wd, ad, gate = jnp.split(
        u, [D_A, 2 * D_A, 3 * D_A, 3 * D_A + DECAY_RANK, 3 * D_A + DECAY_RANK + AAA_RANK], axis=-1)
    w = -jax.nn.softplus(-(w0 + jnp.tanh(wd) @ w_up)) - 0.5
    decay = jnp.exp(-jnp.exp(w.astype(jnp.float32)))
    a = jax.nn.sigmoid(a0 + ad @ a_up)
    heads = lambda t: t.reshape(B, S, H_A, HEAD_A).astype(jnp.float32)
    kk = heads(k * k_k)
    kk = kk / jnp.maximum(jnp.linalg.norm(kk, axis=-1, keepdims=True), 1e-12)
    k = k * (1.0 + (a - 1.0) * k_a)
    r_h, k_h, v_h, a_h = heads(r), heads(k), heads(v), heads(a)
    y = _wkv7_scan(r_h, heads(decay), k_h, v_h, -kk, kk * a_h)
    mean = jnp.mean(y, axis=-1, keepdims=True)
    var = jnp.mean(jnp.square(y - mean), axis=-1, keepdims=True)
    y = (y - mean) * lax.rsqrt(var + LNX_EPS)
    y = y * lnx_w.reshape(H_A, HEAD_A).astype(jnp.float32) + lnx_b.reshape(H_A, HEAD_A).astype(jnp.float32)
    bonus = jnp.sum(r_h * k_h * r_k.astype(jnp.float32), axis=-1, keepdims=True) * v_h
    y = (y + bonus).reshape(B, S, D_A).astype(u.dtype)
    return y * jax.nn.silu(gate)


def _fox_mixer(u, f_bias, q_norm_g, k_norm_g):
    B, S, _ = u.shape
    q, k, v, gate, f_logit = jnp.split(u, [D_B, 2 * D_B, 3 * D_B, 4 * D_B], axis=-1)
    to_bhsd = lambda t: jnp.transpose(t, (0, 2, 1, 3))
    q = to_bhsd(_rmsnorm(q.reshape(B, S, H_B, HEAD_B), q_norm_g))
    k = to_bhsd(_rmsnorm(k.reshape(B, S, H_B, HEAD_B), k_norm_g))
    v = to_bhsd(v.reshape(B, S, H_B, HEAD_B))
    log_f = jax.nn.log_sigmoid((f_logit + f_bias).astype(jnp.float32))
    cum = jnp.transpose(jnp.cumsum(log_f, axis=1), (0, 2, 1))
    scale = HEAD_B ** -0.5
    outs = []
    for i in range(S // Q_BLOCK):
        lo, hi = i * Q_BLOCK, (i + 1) * Q_BLOCK
        qb, kp, vp = q[:, :, lo:hi], k[:, :, :hi], v[:, :, :hi]
        logits = (jnp.einsum('bhqd,bhkd->bhqk', qb, kp).astype(jnp.float32) * scale
                  + cum[:, :, lo:hi, None] - cum[:, :, None, :hi])
        causal = (lo + jnp.arange(Q_BLOCK))[:, None] >= jnp.arange(hi)[None, :]
        logits = jnp.where(causal, logits, -jnp.inf)
        p = jax.nn.softmax(logits, axis=-1)
        outs.append(jnp.einsum('bhqk,bhkd->bhqd', p.astype(vp.dtype), vp))
    o = jnp.concatenate(outs, axis=2)
    o = jnp.transpose(o, (0, 2, 1, 3)).reshape(B, S, D_B)
    return o * jax.nn.silu(gate)


def setup_inputs(seed: int = 0) -> dict:
    key = jax.random.key(seed)
    ks = jax.random.split(key, 20)
    nrm = lambda k, shape, s: jax.random.normal(k, shape, jnp.float32) * s
    unif = lambda k, shape, lo, hi: jax.random.uniform(k, shape, jnp.float32, lo, hi)
    return {
        'x': jax.random.normal(ks[0], (BATCH, SEQ, D_MODEL), jnp.float32),
        'norm_g': 1.0 + nrm(ks[1], (DEPTH, D_MODEL), 0.02),
        'w_in': nrm(ks[2], (DEPTH, D_MODEL, IN_COLS), D_MODEL ** -0.5),
        'shift_mu': unif(ks[3], (DEPTH, RWKV_COLS), 0.0, 1.0),
        'w_lora_up': nrm(ks[4], (DEPTH, DECAY_RANK, D_A), 0.1 * DECAY_RANK ** -0.5),
        'w0': unif(ks[5], (DEPTH, D_A), -6.0, -1.0),
        'a_lora_up': nrm(ks[6], (DEPTH, AAA_RANK, D_A), 0.1 * AAA_RANK ** -0.5),
        'a0': nrm(ks[7], (DEPTH, D_A), 0.5),
        'k_k': 0.85 + nrm(ks[8], (DEPTH, D_A), 0.02),
        'k_a': 1.0 + nrm(ks[9], (DEPTH, D_A), 0.02),
        'r_k': nrm(ks[10], (DEPTH, H_A, HEAD_A), 0.1),
        'lnx_w': 1.0 + nrm(ks[11], (DEPTH, D_A), 0.02),
        'lnx_b': nrm(ks[12], (DEPTH, D_A), 0.02),
        'f_bias': unif(ks[13], (DEPTH, H_B), 1.0, 5.0),
        'q_norm_g': 1.0 + nrm(ks[14], (DEPTH, HEAD_B), 0.02),
        'k_norm_g': 1.0 + nrm(ks[15], (DEPTH, HEAD_B), 0.02),
        'w_out_a': nrm(ks[16], (DEPTH, D_A, D_MODEL), D_A ** -0.5),
        'w_out_b': nrm(ks[17], (DEPTH, D_B, D_MODEL), D_B ** -0.5),
        'w_out': nrm(ks[18], (DEPTH, D_MODEL, D_MODEL), D_MODEL ** -0.5),
        'final_norm_g': 1.0 + nrm(ks[19], (D_MODEL,), 0.02),
    }


def reference(x, norm_g, w_in, shift_mu, w_lora_up, w0, a_lora_up, a0, k_k, k_a, r_k,
              lnx_w, lnx_b, f_bias, q_norm_g, k_norm_g, w_out_a, w_out_b, w_out, final_norm_g):
    for l in range(DEPTH):
        h = _rmsnorm(x, norm_g[l])
        u = h @ w_in[l]
        u_a, u_b, u_g = jnp.split(u, [RWKV_COLS, RWKV_COLS + FOX_COLS], axis=-1)
        y_a = _rwkv7_mixer(u_a, shift_mu[l], w_lora_up[l], w0[l], a_lora_up[l], a0[l],
                           k_k[l], k_a[l], r_k[l], lnx_w[l], lnx_b[l]) @ w_out_a[l]
        y_b = _fox_mixer(u_b, f_bias[l], q_norm_g[l], k_norm_g[l]) @ w_out_b[l]
        g_a, g_b = jnp.split(u_g, 2, axis=-1)
        merged = jax.nn.sigmoid(g_a) * y_a + jax.nn.sigmoid(g_b) * y_b
        x = x + merged @ w_out[l]
    return _rmsnorm(x, final_norm_g)
```

```cpp
#include <hip/hip_runtime.h>
#include <hip/hip_bf16.h>
#include <cstdio>
#include <cstdint>
#include <cmath>

#define GAS __attribute__((address_space(1)))
#define LAS __attribute__((address_space(3)))
typedef unsigned short bf16;
typedef unsigned v4u __attribute__((ext_vector_type(4)));
typedef unsigned v2u __attribute__((ext_vector_type(2)));
typedef float f32x2 __attribute__((ext_vector_type(2)));
typedef float f32x4 __attribute__((ext_vector_type(4)));
typedef float f32x16 __attribute__((ext_vector_type(16)));
typedef short bf16x8 __attribute__((ext_vector_type(8)));
typedef short s16x4 __attribute__((ext_vector_type(4)));

constexpr int NB = 8, SEQ = 2048, DM = 1024, T = NB * SEQ, NH = 8, HD = 64;
constexpr int IN_COLS = 6280, NPAD = 6400;
constexpr float RMS_EPS = 1e-6f, LNX_EPS = 64e-5f;
constexpr float LOG2E = 1.4426950408889634f;
constexpr float C2 = 0.125f * LOG2E;

constexpr size_t MiB = 1u << 20;
constexpr size_t WS_CTL = 0, CTL_ZERO_BYTES = 64 * 1024;
constexpr size_t WS_WINT = 1 * MiB;
constexpr size_t WS_WAB = 14 * MiB;
constexpr size_t WS_WOUT = 16 * MiB;
constexpr size_t WS_G2 = 19 * MiB;
constexpr size_t WS_BONUS = 19 * MiB + 512 * 1024;
constexpr size_t WS_ACOMB = 20 * MiB;
constexpr size_t WS_UA = 84 * MiB;
constexpr size_t WS_UB = 148 * MiB;
constexpr size_t WS_US = 212 * MiB;
constexpr size_t WS_YLOC = 228 * MiB;
constexpr size_t WS_MERGED = 212 * MiB;
constexpr size_t WS_END = 256 * MiB;
constexpr int ACOMB_LD = 2048, U_LD = 2048;
constexpr int ZA_OFF = 1024, ZB_OFF = 1536;

#define RLX_AGENT __ATOMIC_RELAXED, __HIP_MEMORY_SCOPE_AGENT
#define LDS_WAIT() asm volatile("s_waitcnt lgkmcnt(0)" ::: "memory")
#define VM_WAIT() asm volatile("s_waitcnt vmcnt(0)" ::: "memory")

__device__ __forceinline__ unsigned f2bf(float f) { unsigned u = __builtin_bit_cast(unsigned, f); return (u + 0x7fffu + ((u >> 16) & 1u)) >> 16; }
__device__ __forceinline__ unsigned pk2(float lo, float hi) { return f2bf(lo) | (f2bf(hi) << 16); }
__device__ __forceinline__ float bf2f(unsigned b) { return __builtin_bit_cast(float, b << 16); }
__device__ __forceinline__ float bflo(unsigned w) { return __builtin_bit_cast(float, w << 16); }
__device__ __forceinline__ float bfhi(unsigned w) { return __builtin_bit_cast(float, w & 0xffff0000u); }
__device__ __forceinline__ float sigmoidf_(float x) { return 1.0f / (1.0f + __expf(-x)); }
__device__ __forceinline__ float siluf_(float x) { return x / (1.0f + __expf(-x)); }
__device__ __forceinline__ float wave_sum(float v) {
#pragma unroll
    for (int o = 1; o < 64; o <<= 1) v += __shfl_xor(v, o);
    return v;
}
template <int CTRL> __device__ __forceinline__ float dppf(float x) { return __builtin_bit_cast(float, __builtin_amdgcn_mov_dpp(__builtin_bit_cast(int, x), CTRL, 0xf, 0xf, true)); }
__device__ __forceinline__ float row16_sum(float v) { v += dppf<0x128>(v); v += dppf<0x124>(v); v += dppf<0x122>(v); v += dppf<0x121>(v); return v; }
namespace pg8 {
#define PG8_LAS __attribute__((address_space(3)))
typedef unsigned short bf16_t;
typedef unsigned u32x4 __attribute__((ext_vector_type(4)));
constexpr int BM = 256, BK = 64, HALF = 128, HTB = HALF * BK * 2  , STAGE_BYTES = 8 * HTB;

__host__ __device__ __forceinline__ int lds_byte(int r, int c) { const int st = (r >> 4) * 2 + (c >> 5), rr = r & 15, cc = c & 31, ob = rr * 64 + cc * 2; return st * 1024 + (ob ^ (((ob >> 9) & 1) << 5)); }
__host__ __device__ __forceinline__ void stage_rc(int b, int& R, int& C) { const int st = b / 1024, sb = b % 1024, swz = sb ^ (((sb >> 9) & 1) << 5); R = (st >> 1) * 16 + swz / 64; C = (st & 1) * 32 + (swz % 64) / 2; }
__host__ __device__ __forceinline__ int perm32(int rho) { const int n = rho >> 4, i = rho & 15; return 8 * (i >> 2) + 4 * n + (i & 3); }

struct Unit { int pm, pn, kind, nt; const char* a; const char* b; };

__device__ __forceinline__ unsigned cvt_pk_bf16(float lo, float hi) { unsigned r; asm volatile("v_cvt_pk_bf16_f32 %0, %1, %2" : "=v"(r) : "v"(lo), "v"(hi)); return r; }

template <class Epi, class Sched>
__device__ __forceinline__ void gemm_phase(PG8_LAS unsigned char* lds, const int lda, const int ldb, const Sched& S, const Epi& E) {
    const int tid = threadIdx.x, wid = __builtin_amdgcn_readfirstlane(tid >> 6), lane = tid & 63, wr = wid >> 2, wc = wid & 3, fr = lane & 15, fq = lane >> 4;
    unsigned voffA[2], voffB[2];
#pragma unroll
    for (int i = 0; i < 2; ++i) { int R, C; stage_rc(tid * 16 + i * 8192, R, C); const int Rb = (R & ~31) + perm32(R & 31);
        voffA[i] = (unsigned)(R * lda + C) * 2u; voffB[i] = (unsigned)(Rb * ldb + C) * 2u; }
    const size_t kstep = (size_t)(BK * 2);
    const size_t hstepA = (size_t)HALF * lda * 2, hstepB = (size_t)HALF * ldb * 2;
    const unsigned ldsw = (unsigned)wid * 1024u;
    const int aoff = lds_byte(wr * 64 + fr, fq * 8), boff = lds_byte(wc * 32 + fr, fq * 8);
#define PG8_SA(b, h) (((b) * 2 + (h)) * HTB)
#define PG8_SB(b, h) ((4 + (b) * 2 + (h)) * HTB)
#define PG8_STAGE(bufoff, gbase, voff) do { _Pragma("unroll") for (int _i = 0; _i < 2; ++_i) \
        __builtin_amdgcn_global_load_lds((const unsigned*)((const char*)(gbase) + (voff)[_i]), (PG8_LAS unsigned*)(lds + (bufoff) + ldsw + _i * 8192), 16, 0, 0); } while (0)
#define PG8_LDA(dst, b, h) do { _Pragma("unroll") for (int m = 0; m < 4; ++m) _Pragma("unroll") for (int k = 0; k < 2; ++k) dst[m][k] = *(const PG8_LAS bf16x8*)(lds + PG8_SA(b, h) + aoff + m * 2048 + k * 1024); } while (0)
#define PG8_LDB(dst, b, h) do { _Pragma("unroll") for (int n = 0; n < 2; ++n) _Pragma("unroll") for (int k = 0; k < 2; ++k) dst[n][k] = *(const PG8_LAS bf16x8*)(lds + PG8_SB(b, h) + boff + n * 2048 + k * 1024); } while (0)
#define PG8_MMA(ai, bj, At, Bt) do { __builtin_amdgcn_s_setprio(1); _Pragma("unroll") for (int m = 0; m < 4; ++m) _Pragma("unroll") for (int n = 0; n < 2; ++n) _Pragma("unroll") for (int k = 0; k < 2; ++k) \
        acc[ai][bj][m][n] = __builtin_amdgcn_mfma_f32_16x16x32_bf16(Bt[n][k], At[m][k], acc[ai][bj][m][n], 0, 0, 0); __builtin_amdgcn_s_setprio(0); } while (0)
#define PG8_WAIT_V(n) asm volatile("s_waitcnt vmcnt(" #n ")" ::: "memory")
#define PG8_WAIT_L(n) asm volatile("s_waitcnt lgkmcnt(" #n ")" ::: "memory")
#define PG8_BAR __builtin_amdgcn_s_barrier()
#define PG8_SCHED __builtin_amdgcn_sched_barrier(0)
    Unit cur, nxt; int ui = 0;
    if (!S.next(0, cur)) return;
    f32x4 acc[2][2][4][2];
#pragma unroll
    for (int a = 0; a < 2; ++a)
#pragma unroll
        for (int b = 0; b < 2; ++b)
#pragma unroll
            for (int m = 0; m < 4; ++m)
#pragma unroll
                for (int n = 0; n < 2; ++n) acc[a][b][m][n] = (f32x4){0.f, 0.f, 0.f, 0.f};
    bf16x8 At[4][2], B0[2][2], B1[2][2];
    const char* cA = cur.a; const char* cB = cur.b;
    PG8_STAGE(PG8_SB(0, 0), cB, voffB); PG8_STAGE(PG8_SB(0, 1), cB + hstepB, voffB); PG8_STAGE(PG8_SA(0, 0), cA, voffA); PG8_STAGE(PG8_SA(0, 1), cA + hstepA, voffA);
    if (wr == 1) PG8_BAR;
    PG8_WAIT_V(2); PG8_BAR;
    PG8_STAGE(PG8_SB(1, 0), cB + kstep, voffB); PG8_STAGE(PG8_SA(1, 0), cA + kstep, voffA); PG8_STAGE(PG8_SB(1, 1), cB + hstepB + kstep, voffB);
    PG8_WAIT_V(6); PG8_BAR;
    for (;;) {
        const bool has_next = S.next(ui + 1, nxt);
        const char* nA = has_next ? nxt.a : cA; const char* nB = has_next ? nxt.b : cB;
        const int nt = cur.nt;
        for (int t = 0; t < nt; t += 2) {
            const bool last = (t == nt - 2);
            const char* a1 = cA + (size_t)(t + 1) * kstep;
            const char* a2 = last ? nA : cA + (size_t)(t + 2) * kstep; const char* b2 = last ? nB : cB + (size_t)(t + 2) * kstep;
            const char* a3 = a2 + kstep; const char* b3 = b2 + kstep;
            PG8_LDB(B0, 0, 0); PG8_LDB(B1, 0, 1); PG8_SCHED; PG8_LDA(At, 0, 0); PG8_STAGE(PG8_SA(1, 1), a1 + hstepA, voffA);
            PG8_WAIT_V(8); PG8_WAIT_L(0); PG8_BAR; PG8_MMA(0, 0, At, B0); PG8_MMA(0, 1, At, B1); PG8_BAR; PG8_SCHED;
            PG8_LDA(At, 0, 1); PG8_STAGE(PG8_SB(0, 0), b2, voffB); PG8_STAGE(PG8_SB(0, 1), b2 + hstepB, voffB); PG8_STAGE(PG8_SA(0, 0), a2, voffA);
            PG8_WAIT_V(8); PG8_WAIT_L(0); PG8_BAR; PG8_MMA(1, 0, At, B0); PG8_MMA(1, 1, At, B1); PG8_BAR; PG8_SCHED;
            PG8_LDB(B0, 1, 0); PG8_LDB(B1, 1, 1); PG8_SCHED; PG8_LDA(At, 1, 0); PG8_STAGE(PG8_SA(0, 1), a2 + hstepA, voffA);
            PG8_WAIT_V(8); PG8_WAIT_L(0); PG8_BAR; PG8_MMA(0, 0, At, B0); PG8_MMA(0, 1, At, B1); PG8_BAR; PG8_SCHED;
            PG8_LDA(At, 1, 1); PG8_STAGE(PG8_SB(1, 0), b3, voffB); PG8_STAGE(PG8_SB(1, 1), b3 + hstepB, voffB); PG8_STAGE(PG8_SA(1, 0), a3, voffA);
            PG8_WAIT_V(8); PG8_WAIT_L(0); PG8_BAR; PG8_MMA(1, 0, At, B0); PG8_MMA(1, 1, At, B1); PG8_BAR; PG8_SCHED;
        }
        if (wr == 0) PG8_BAR;
        E(acc, cur, wr, wc, fr, fq);
        if (!has_next) break;
#pragma unroll
        for (int a = 0; a < 2; ++a)
#pragma unroll
            for (int b = 0; b < 2; ++b)
#pragma unroll
                for (int m = 0; m < 4; ++m)
#pragma unroll
                    for (int n = 0; n < 2; ++n) acc[a][b][m][n] = (f32x4){0.f, 0.f, 0.f, 0.f};
        cur = nxt; cA = nA; cB = nB; ++ui;
        if (wr == 1) PG8_BAR;
    }
    PG8_WAIT_V(0);
    PG8_BAR;
#undef PG8_SA
#undef PG8_SB
#undef PG8_STAGE
#undef PG8_LDA
#undef PG8_LDB
#undef PG8_MMA
#undef PG8_WAIT_V
#undef PG8_WAIT_L
#undef PG8_BAR
#undef PG8_SCHED
}
}
typedef GAS unsigned gu32;
#define XB_TMO      128
#define XB_XCNT(j)  (256  + 64 * (j))
#define XB_XSUB(j)  (1280 + 64 * (j))
#define XB_XGEN(j)  (2304 + 64 * (j))
#define XB_TOP      3328
#define XB_TOPGEN   3392
#define XCD_BAR_WORDS 3456
#define XB_SPIN_CAP (1u << 18)
__device__ __forceinline__ unsigned xb_ld(unsigned* p)              { return __hip_atomic_load(p, __ATOMIC_RELAXED, __HIP_MEMORY_SCOPE_AGENT); }
__device__ __forceinline__ unsigned xb_add(unsigned* p, unsigned v) { return __hip_atomic_fetch_add(p, v, __ATOMIC_RELAXED, __HIP_MEMORY_SCOPE_AGENT); }
__device__ __forceinline__ unsigned xb_xcc_id() { return (unsigned)__builtin_amdgcn_s_getreg((3 << 11) | 20) & 0xFu; }
#define XB_SPIN(cond, bar) do { unsigned _sp = 0; while (cond) { __builtin_amdgcn_s_sleep(1); \
    if ((++_sp & 255u) == 0u) { if (xb_ld(&(bar)[XB_TMO])) break; if (_sp > XB_SPIN_CAP) { atomicAdd(&(bar)[XB_TMO], 1u); break; } } } } while (0)
struct XcdBarrier { unsigned* bar; unsigned x; volatile LAS unsigned* st; };
__device__ __forceinline__ XcdBarrier xcd_barrier_post(unsigned* bar, volatile LAS unsigned* st) {
    XcdBarrier b; b.bar = bar; b.x = xb_xcc_id(); b.st = st;
    if (threadIdx.x == 0) (void)xb_add(&bar[XB_XCNT(b.x)], 1u);
    return b;
}
__device__ __forceinline__ void xcd_barrier_complete(unsigned* bar, unsigned x, unsigned& nloc, unsigned& nx) {
    const unsigned G = gridDim.x * gridDim.y * gridDim.z;
    unsigned sum, cnt, mine, sp = 0u;
    for (;;) {
        sum = 0u; cnt = 0u; mine = 0u;
#pragma unroll
        for (unsigned j = 0; j < 16; ++j) { const unsigned c = xb_ld(&bar[XB_XCNT(j)]); sum += c; cnt += (c > 0u) ? 1u : 0u; mine = (j == x) ? c : mine; }
        if (sum == G) break;
        __builtin_amdgcn_s_sleep(1);
        if ((++sp & 255u) == 0u) { if (xb_ld(&bar[XB_TMO])) break; if (sp > XB_SPIN_CAP) { atomicAdd(&bar[XB_TMO], 1u); break; } }
    }
    nloc = mine > 0u ? mine : 1u; nx = cnt > 0u ? cnt : 1u;
}
__device__ __forceinline__ void xcd_barrier(const XcdBarrier& b) {
    asm volatile("s_waitcnt vmcnt(0)" ::: "memory");
    __syncthreads();
    if (threadIdx.x == 0) {
        unsigned* bar = b.bar;
        __builtin_amdgcn_s_waitcnt(0);
        unsigned nloc = b.st[0], nx = b.st[1];
        if (nloc == 0u) { xcd_barrier_complete(bar, b.x, nloc, nx); b.st[0] = nloc; b.st[1] = nx; }
        const unsigned old = xb_add(&bar[XB_XSUB(b.x)], 1u);
        const unsigned gen = old / nloc;
        if (old + 1u == (gen + 1u) * nloc) {
            __builtin_amdgcn_fence(__ATOMIC_RELEASE, "agent");
            asm volatile("s_waitcnt vmcnt(0)" ::: "memory");
            const unsigned og = xb_add(&bar[XB_TOP], 1u);
            const unsigned tg = og / nx;
            if (og + 1u == (tg + 1u) * nx) xb_add(&bar[XB_TOPGEN], 1u);
            else XB_SPIN(xb_ld(&bar[XB_TOPGEN]) == tg, bar);
            __builtin_amdgcn_fence(__ATOMIC_ACQUIRE, "agent");
            xb_add(&bar[XB_XGEN(b.x)], 1u);
            asm volatile("s_waitcnt vmcnt(0)" ::: "memory");
        } else {
            XB_SPIN(xb_ld(&bar[XB_XGEN(b.x)]) == gen, bar);
            __builtin_amdgcn_fence(__ATOMIC_ACQUIRE, "agent");
            asm volatile("s_waitcnt vmcnt(0)" ::: "memory");
        }
    }
    __syncthreads();
}

constexpr int RING_OFF = 0, RING_BYTES = 131072;
constexpr int LDSCTL_OFF = RING_BYTES, MISC_OFF = LDSCTL_OFF + 320;
constexpr int LDS_BYTES = 147456;
constexpr int NWAVES = 8;
constexpr int CW_BAR = 4096;

struct Frame {
    LAS unsigned char* lds;
    volatile LAS unsigned* MISC;
    int tid, lane, wave, vcu, G;
    const float* in[20]; float* out; unsigned char* ws;
};
__device__ __forceinline__ void p0_transpose_item(const float* W, int ldw, bf16* WT, int ldt, int koff, LAS float* scr, int k0, int n0, int scol0, int nvalid, int lane) {
    const int li = lane & 31; const bool ok = li < nvalid;
#pragma unroll 8
    for (int i = 0; i < 32; ++i) { const int kk = 2 * i + (lane >> 5); scr[kk * 33 + li] = ok ? W[(size_t)(k0 + kk) * ldw + scol0 + li] : 0.f; }
    LDS_WAIT(); asm volatile("" ::: "memory");
    const int c = lane & 7;
#pragma unroll
    for (int j = 0; j < 4; ++j) { const int n = (lane >> 3) + 8 * j; const LAS float* s = scr + (8 * c) * 33 + n;
        v4u o; o.x = pk2(s[0 * 33], s[1 * 33]); o.y = pk2(s[2 * 33], s[3 * 33]); o.z = pk2(s[4 * 33], s[5 * 33]); o.w = pk2(s[6 * 33], s[7 * 33]);
        *(GAS v4u*)(WT + (size_t)(n0 + n) * ldt + koff + k0 + 8 * c) = o; }
    LDS_WAIT(); asm volatile("" ::: "memory");
}
__device__ __forceinline__ void win_map(int n0, int& scol0, int& nvalid) {
    nvalid = 32;
    if (n0 < 1536) scol0 = n0;
    else if (n0 < 4096) scol0 = n0 + 128;
    else if (n0 < 6144) scol0 = n0 + 136;
    else if (n0 < 6272) scol0 = n0 - 6144 + 1536;
    else if (n0 == 6272) { scol0 = 4224; nvalid = 8; }
    else { scol0 = 0; nvalid = 0; }
}
__device__ __forceinline__ void p0_prologue(Frame& F) {
    LAS float* scr = (LAS float*)(F.lds + RING_OFF + F.wave * 16384);
    const int gw = F.vcu * NWAVES + F.wave, NGW = F.G * NWAVES;
    bf16* WinT = (bf16*)(F.ws + WS_WINT); bf16* Wab = (bf16*)(F.ws + WS_WAB); bf16* WoutT = (bf16*)(F.ws + WS_WOUT);
    constexpr int I_IN = 16 * 200, I_AB = 8 * 32, I_OUT = 16 * 32;
    constexpr int NITEMS = I_IN + 2 * I_AB + I_OUT;
    for (int it = gw; it < NITEMS; it += NGW) {
        int r = it;
        if (r < I_IN) { const int kb = r / 200, nb = r % 200; int sc, nv; win_map(32 * nb, sc, nv); p0_transpose_item(F.in[2], IN_COLS, WinT, 1024, 0, scr, 64 * kb, 32 * nb, sc, nv, F.lane); continue; } r -= I_IN;
        if (r < I_AB) { const int kb = r / 32, nb = r % 32; p0_transpose_item(F.in[16], 1024, Wab, 1024, 0, scr, 64 * kb, 32 * nb, 32 * nb, 32, F.lane); continue; } r -= I_AB;
        if (r < I_AB) { const int kb = r / 32, nb = r % 32; p0_transpose_item(F.in[17], 1024, Wab, 1024, 512, scr, 64 * kb, 32 * nb, 32 * nb, 32, F.lane); continue; } r -= I_AB;
        { const int kb = r / 32, nb = r % 32; p0_transpose_item(F.in[18], 1024, WoutT, 1024, 0, scr, 64 * kb, 32 * nb, 32 * nb, 32, F.lane); }
    }
    bf16* Acomb = (bf16*)(F.ws + WS_ACOMB);
    const GAS f32x4* gp = (const GAS f32x4*)F.in[1] + F.lane;
    f32x4 g[4];
#pragma unroll
    for (int j = 0; j < 4; ++j) g[j] = gp[64 * j];
    for (int m = gw; m < T; m += NGW) {
        const GAS f32x4* xr = (const GAS f32x4*)(F.in[0] + (size_t)m * DM) + F.lane;
        f32x4 v[4]; float s = 0.f;
#pragma unroll
        for (int j = 0; j < 4; ++j) { v[j] = xr[64 * j]; s += (v[j].x * v[j].x + v[j].y * v[j].y) + (v[j].z * v[j].z + v[j].w * v[j].w); }
        const float rstd = 1.f / sqrtf(wave_sum(s) * (1.f / DM) + RMS_EPS);
        GAS unsigned long long* o8 = (GAS unsigned long long*)(Acomb + (size_t)m * ACOMB_LD) + F.lane;
#pragma unroll
        for (int j = 0; j < 4; ++j) o8[64 * j] = (unsigned long long)pk2(v[j].x * rstd * g[j].x, v[j].y * rstd * g[j].y) | ((unsigned long long)pk2(v[j].z * rstd * g[j].z, v[j].w * rstd * g[j].w) << 32);
    }
}

struct SchedP1 {
    int c, G; const char* A; const char* B;
    __device__ __forceinline__ bool next(int i, pg8::Unit& u) const {
        constexpr int nM = 64, nN = 17, nwg = nM * nN, NX = 8, WGM = 8;
        const int L = i * G + c; if (L >= nwg) return false;
        int wgid = L; { const int q = nwg / NX, r = nwg % NX, xcd = wgid % NX, off = wgid / NX; wgid = (xcd < r ? xcd * (q + 1) : r * (q + 1) + (xcd - r) * q) + off; }
        const int nig = WGM * nN, gid = wgid / nig, fm = gid * WGM;
        u.pm = fm + ((wgid % nig) % WGM); int pn = (wgid % nig) / WGM; u.pn = pn == 16 ? 24 : pn; u.kind = 0; u.nt = 16;
        u.a = A + (size_t)u.pm * 256 * ACOMB_LD * 2; u.b = B + (size_t)u.pn * 256 * 1024 * 2; return true;
    }
};
struct EpiP1 {
    bf16* UA; bf16* UB; float* US;
    __device__ __forceinline__ void operator()(const f32x4 (&acc)[2][2][4][2], const pg8::Unit& u, int wr, int wc, int fr, int fq) const {
        const int row0 = u.pm * 256 + wr * 64 + fr;
        if (u.pn < 16) {
            bf16* base = (u.pn < 8 ? UA + u.pn * 256 : UB + (u.pn - 8) * 256) + wc * 32 + 8 * fq;
#pragma unroll
            for (int ai = 0; ai < 2; ++ai)
#pragma unroll
                for (int m = 0; m < 4; ++m) { bf16* rowp = base + (size_t)(row0 + ai * 128 + m * 16) * U_LD;
#pragma unroll
                    for (int bj = 0; bj < 2; ++bj) { const f32x4 v0 = acc[ai][bj][m][0], v1 = acc[ai][bj][m][1];
                        pg8::u32x4 w; w.x = pg8::cvt_pk_bf16(v0[0], v0[1]); w.y = pg8::cvt_pk_bf16(v0[2], v0[3]); w.z = pg8::cvt_pk_bf16(v1[0], v1[1]); w.w = pg8::cvt_pk_bf16(v1[2], v1[3]);
                        *(pg8::u32x4*)(rowp + bj * 128) = w; } }
        } else {
            float* base = US + wc * 32 + 8 * fq;
#pragma unroll
            for (int ai = 0; ai < 2; ++ai)
#pragma unroll
                for (int m = 0; m < 4; ++m) { float* rowp = base + (size_t)(row0 + ai * 128 + m * 16) * 256;
#pragma unroll
                    for (int bj = 0; bj < 2; ++bj) { *(f32x4*)(rowp + bj * 128) = acc[ai][bj][m][0]; *(f32x4*)(rowp + bj * 128 + 4) = acc[ai][bj][m][1]; } }
        }
    }
};

__device__ __forceinline__ float softplusf_(float x) { return fmaxf(x, 0.f) + log1pf(__expf(-fabsf(x))); }
__device__ __forceinline__ void p2_prep(Frame& F) {
    const int gw = F.vcu * NWAVES + F.wave, lane = F.lane;
    const float* US = (const float*)(F.ws + WS_US);
    const float* mu = F.in[3];
    {
        LAS float* sw = (LAS float*)(F.lds + RING_OFF + F.wave * 4096);
        LAS float* sa = sw + 512;
        const int m0 = 8 * gw;
        const float muw = mu[1536 + lane], mua = mu[1600 + lane];
#pragma unroll
        for (int r = 0; r < 8; ++r) { const int m = m0 + r; const bool first = (m % SEQ) == 0;
            const float cw = US[(size_t)m * 256 + lane], ca = US[(size_t)m * 256 + 64 + lane];
            const float pw = first ? 0.f : US[(size_t)(m - 1) * 256 + lane], pa = first ? 0.f : US[(size_t)(m - 1) * 256 + 64 + lane];
            sw[r * 64 + lane] = tanhf(cw + (pw - cw) * muw); sa[r * 64 + lane] = ca + (pa - ca) * mua; }
        LDS_WAIT(); asm volatile("" ::: "memory");
        float aw[8][8], aa[8][8];
#pragma unroll
        for (int r = 0; r < 8; ++r)
#pragma unroll
            for (int c = 0; c < 8; ++c) { aw[r][c] = 0.f; aa[r][c] = 0.f; }
        const float* wup = F.in[4] + 8 * lane; const float* aup = F.in[6] + 8 * lane;
#pragma unroll 2
        for (int j = 0; j < 64; ++j) {
            const f32x4 w0 = *(const f32x4*)(wup + j * 512), w1 = *(const f32x4*)(wup + j * 512 + 4);
            const f32x4 a0 = *(const f32x4*)(aup + j * 512), a1 = *(const f32x4*)(aup + j * 512 + 4);
#pragma unroll
            for (int r = 0; r < 8; ++r) { const float t = sw[r * 64 + j], d = sa[r * 64 + j];
#pragma unroll
                for (int c = 0; c < 4; ++c) { aw[r][c] += t * w0[c]; aw[r][4 + c] += t * w1[c]; aa[r][c] += d * a0[c]; aa[r][4 + c] += d * a1[c]; } }
        }
        float* DEC = F.out; float* LR = F.out + (size_t)T * 512;
        float w0v[8], a0v[8];
#pragma unroll
        for (int c = 0; c < 8; ++c) { w0v[c] = F.in[5][8 * lane + c]; a0v[c] = F.in[7][8 * lane + c]; }
#pragma unroll
        for (int r = 0; r < 8; ++r) { f32x4 d0, d1, l0, l1;
#pragma unroll
            for (int c = 0; c < 8; ++c) { const float z = w0v[c] + aw[r][c]; const float w = -softplusf_(-z) - 0.5f; const float dec = __expf(-__expf(w)); const float lr = sigmoidf_(a0v[c] + aa[r][c]);
                if (c < 4) { d0[c] = dec; l0[c] = lr; } else { d1[c - 4] = dec; l1[c - 4] = lr; } }
            float* dp = DEC + (size_t)(m0 + r) * 512 + 8 * lane; float* lp = LR + (size_t)(m0 + r) * 512 + 8 * lane;
            *(f32x4*)dp = d0; *(f32x4*)(dp + 4) = d1; *(f32x4*)lp = l0; *(f32x4*)(lp + 4) = l1; }
        LDS_WAIT(); asm volatile("" ::: "memory");
    }
    {
        bf16* UB = (bf16*)(F.ws + WS_UB);
        const int d0 = (lane & 7) * 8;
        float gq[8], gk[8];
#pragma unroll
        for (int e = 0; e < 8; ++e) { gq[e] = F.in[14][d0 + e] * C2; gk[e] = F.in[15][d0 + e]; }
        for (int tsk = gw; tsk < 2 * T; tsk += F.G * NWAVES) {
            const int m = tsk >> 1, which = tsk & 1;
            GAS v4u* p = (GAS v4u*)(UB + (size_t)m * U_LD + which * 512) + lane;
            const v4u w = *p;
            float x[8] = {bflo(w.x), bfhi(w.x), bflo(w.y), bfhi(w.y), bflo(w.z), bfhi(w.z), bflo(w.w), bfhi(w.w)};
            float s = 0.f;
#pragma unroll
            for (int e = 0; e < 8; ++e) s += x[e] * x[e];
            s += __shfl_xor(s, 1); s += __shfl_xor(s, 2); s += __shfl_xor(s, 4);
            const float rs = 1.f / sqrtf(s * (1.f / 64.f) + RMS_EPS);
#pragma unroll
            for (int e = 0; e < 8; ++e) x[e] = x[e] * rs * (which ? gk[e] : gq[e]);
            v4u o; o.x = pk2(x[0], x[1]); o.y = pk2(x[2], x[3]); o.z = pk2(x[4], x[5]); o.w = pk2(x[6], x[7]);
            *p = o;
        }
    }
    if (gw < 64) {
        const int b = gw >> 3, h = gw & 7; const float fb = F.in[13][h];
        float* G2 = (float*)(F.ws + WS_G2) + (size_t)gw * SEQ + 32 * lane;
        float v[32]; float run = 0.f;
#pragma unroll
        for (int i = 0; i < 32; ++i) { const float x = US[(size_t)(b * SEQ + 32 * lane + i) * 256 + 128 + h] + fb; run += -softplusf_(-x) * LOG2E; v[i] = run; }
        float tot = run, ex = run;
#pragma unroll
        for (int o = 1; o < 64; o <<= 1) { const float n = __shfl_up(ex, o); if (lane >= o) ex += n; }
        ex -= tot;
#pragma unroll
        for (int i = 0; i < 32; i += 4) *(f32x4*)(G2 + i) = (f32x4){v[i] + ex, v[i + 1] + ex, v[i + 2] + ex, v[i + 3] + ex};
    }
}
__device__ __forceinline__ int crow(int r, int hi) { return (r & 3) + 8 * (r >> 2) + 4 * hi; }
__device__ __forceinline__ s16x4 vtr(const LAS char* p) { typedef short v4i16_t __attribute__((ext_vector_type(4))); return __builtin_bit_cast(s16x4, __builtin_amdgcn_ds_read_tr16_b64_v4i16((LAS v4i16_t*)p)); }
__device__ __forceinline__ unsigned cvtpk_s(float lo, float hi) { typedef __bf16 bf16x2_t __attribute__((ext_vector_type(2))); f32x2 v = {lo, hi}; bf16x2_t b = __builtin_convertvector(v, bf16x2_t); return __builtin_bit_cast(unsigned, b); }

constexpr int AT_K = 0, AT_V = 8192, AT_BIAS = 16384, AT_WS = 16640, AT_OST = 20480;

__device__ __forceinline__ void attn_unit(Frame& F, int b, int h, int qb) {
    const int tid = F.tid, lane = F.lane, r32 = lane & 31, hi = lane >> 5, wid = F.wave;
    const bf16* UB = (const bf16*)(F.ws + WS_UB);
    const float* G2 = (const float*)(F.ws + WS_G2) + (size_t)(b * NH + h) * SEQ;
    bf16* Acomb = (bf16*)(F.ws + WS_ACOMB);
    LAS char* lds = (LAS char*)F.lds;
    const long rowbase = (long)b * SEQ; const int q0 = qb * 256; const int qrow = q0 + wid * 32 + r32;
    const bf16* Qw = UB + (rowbase + q0 + wid * 32) * U_LD + h * 64;
    bf16x8 qr[4];
#pragma unroll
    for (int d0 = 0; d0 < 4; ++d0) qr[d0] = *(const bf16x8*)(Qw + (long)r32 * U_LD + d0 * 16 + hi * 8);
    const float gq = G2[qrow];
    float m_run = -1e30f, l_run = 0.f; f32x16 o[2]; o[0] = f32x16{}; o[1] = f32x16{};
    LAS float* wsf = (LAS float*)(lds + AT_WS) + wid * 64;
    LAS float* biasl = (LAS float*)(lds + AT_BIAS);
    const int NT = (q0 + 256) / 64;
    const int kvl = tid >> 3, ch = tid & 7;
    const LAS char* kp0 = lds + AT_K + hi * 1024 + r32 * 16;
    const LAS char* vp0 = lds + AT_V + ((lane >> 4) & 1) * 32 + (lane & 3) * 8 + (4 * hi + ((lane & 15) >> 2)) * 64;
    for (int t = 0; t < NT; ++t) {
        __syncthreads();
        { const bf16* src = UB + (rowbase + 64 * t + kvl) * U_LD + h * 64 + 8 * ch;
          const v4u kx = *(const v4u*)(src + 512), vx = *(const v4u*)(src + 1024);
          *(LAS v4u*)(lds + AT_K + ch * 1024 + kvl * 16) = kx;
          *(LAS v4u*)(lds + AT_V + (ch >> 2) * 4096 + kvl * 64 + (ch & 3) * 16) = vx;
          if (tid < 64) biasl[tid] = G2[64 * t + tid]; }
        __syncthreads();
        if (64 * t > q0 + wid * 32 + 31) continue;
        f32x16 p0 = f32x16{}, p1 = f32x16{};
#pragma unroll
        for (int d0 = 0; d0 < 4; ++d0) {
            const bf16x8 b0 = *(const LAS bf16x8*)(kp0 + d0 * 2048), b1 = *(const LAS bf16x8*)(kp0 + d0 * 2048 + 512);
            p0 = __builtin_amdgcn_mfma_f32_32x32x16_bf16(b0, qr[d0], p0, 0, 0, 0);
            p1 = __builtin_amdgcn_mfma_f32_32x32x16_bf16(b1, qr[d0], p1, 0, 0, 0);
        }
        float rm = -INFINITY;
#pragma unroll
        for (int g4 = 0; g4 < 4; ++g4) {
            const f32x4 gk0 = *(const LAS f32x4*)(biasl + 8 * g4 + 4 * hi), gk1 = *(const LAS f32x4*)(biasl + 32 + 8 * g4 + 4 * hi);
#pragma unroll
            for (int i = 0; i < 4; ++i) { const int r = 4 * g4 + i; const int key = 64 * t + crow(r, hi);
                float x0 = p0[r] + (gq - gk0[i]), x1 = p1[r] + (gq - gk1[i]);
                if (key > qrow) x0 = -INFINITY; if (key + 32 > qrow) x1 = -INFINITY;
                p0[r] = x0; p1[r] = x1; rm = fmaxf(rm, fmaxf(x0, x1)); }
        }
        { auto rr = __builtin_amdgcn_permlane32_swap(__float_as_uint(rm), __float_as_uint(rm), false, false); rm = fmaxf(__uint_as_float(rr[0]), __uint_as_float(rr[1])); }
        const float m_new = fmaxf(m_run, rm);
        const float alpha = __builtin_amdgcn_exp2f(m_run - m_new);
        m_run = m_new;
        float ls = 0.f;
#pragma unroll
        for (int r = 0; r < 16; ++r) { p0[r] = __builtin_amdgcn_exp2f(p0[r] - m_new); p1[r] = __builtin_amdgcn_exp2f(p1[r] - m_new); ls += p0[r] + p1[r]; }
        l_run = l_run * alpha + ls;
        if (hi == 0) wsf[r32] = alpha;
        v4u pw0, pw1, pw2, pw3;
        pw0 = (v4u){cvtpk_s(p0[0], p0[1]), cvtpk_s(p0[2], p0[3]), cvtpk_s(p0[4], p0[5]), cvtpk_s(p0[6], p0[7])};
        pw1 = (v4u){cvtpk_s(p0[8], p0[9]), cvtpk_s(p0[10], p0[11]), cvtpk_s(p0[12], p0[13]), cvtpk_s(p0[14], p0[15])};
        pw2 = (v4u){cvtpk_s(p1[0], p1[1]), cvtpk_s(p1[2], p1[3]), cvtpk_s(p1[4], p1[5]), cvtpk_s(p1[6], p1[7])};
        pw3 = (v4u){cvtpk_s(p1[8], p1[9]), cvtpk_s(p1[10], p1[11]), cvtpk_s(p1[12], p1[13]), cvtpk_s(p1[14], p1[15])};
        LDS_WAIT();
#pragma unroll
        for (int r = 0; r < 16; ++r) { const float a = wsf[crow(r, hi)]; o[0][r] *= a; o[1][r] *= a; }
#pragma unroll
        for (int d0 = 0; d0 < 2; ++d0) {
#define AT_PV(ks, PW) { const s16x4 lo = vtr(vp0 + d0 * 4096 + ks * 1024), hh = vtr(vp0 + d0 * 4096 + ks * 1024 + 512); \
              const bf16x8 vf = (bf16x8){lo[0], lo[1], lo[2], lo[3], hh[0], hh[1], hh[2], hh[3]}; \
              o[d0] = __builtin_amdgcn_mfma_f32_32x32x16_bf16(__builtin_bit_cast(bf16x8, PW), vf, o[d0], 0, 0, 0); }
            AT_PV(0, pw0) AT_PV(1, pw1) AT_PV(2, pw2) AT_PV(3, pw3)
#undef AT_PV
        }
    }
    { auto rr = __builtin_amdgcn_permlane32_swap(__float_as_uint(l_run), __float_as_uint(l_run), false, false); l_run = __uint_as_float(rr[0]) + __uint_as_float(rr[1]); }
    if (hi == 0) wsf[32 + r32] = l_run;
    LDS_WAIT();
    bf16* stg = (bf16*)(F.lds + AT_OST) + wid * 2048;
    LAS bf16* stgl = (LAS bf16*)(lds + AT_OST) + wid * 2048;
#pragma unroll
    for (int r = 0; r < 16; ++r) { const int orow = crow(r, hi); const float rl = 1.0f / wsf[32 + orow];
#pragma unroll
        for (int d0 = 0; d0 < 2; ++d0) stgl[orow * 64 + d0 * 32 + r32] = (bf16)f2bf(o[d0][r] * rl); }
    LDS_WAIT();
    (void)stg;
#pragma unroll
    for (int i = 0; i < 4; ++i) { const int row = i * 8 + (lane >> 3), c8 = lane & 7;
        const v4u v = *(const LAS v4u*)(stgl + row * 64 + c8 * 8);
        const long grow = rowbase + q0 + wid * 32 + row;
        const v4u gt = *(const v4u*)(UB + grow * U_LD + 1536 + h * 64 + c8 * 8);
        v4u ov;
        ov.x = pk2(bflo(v.x) * siluf_(bflo(gt.x)), bfhi(v.x) * siluf_(bfhi(gt.x)));
        ov.y = pk2(bflo(v.y) * siluf_(bflo(gt.y)), bfhi(v.y) * siluf_(bfhi(gt.y)));
        ov.z = pk2(bflo(v.z) * siluf_(bflo(gt.z)), bfhi(v.z) * siluf_(bfhi(gt.z)));
        ov.w = pk2(bflo(v.w) * siluf_(bflo(gt.w)), bfhi(v.w) * siluf_(bfhi(gt.w)));
        *(v4u*)(Acomb + grow * ACOMB_LD + ZB_OFF + h * 64 + c8 * 8) = ov; }
}
__device__ __forceinline__ void p3_attention(Frame& F) {
    const int bh = F.vcu >> 2, s = F.vcu & 3;
    attn_unit(F, bh >> 3, bh & 7, s);
    __syncthreads();
    attn_unit(F, bh >> 3, bh & 7, 7 - s);
}
template <int Q> __device__ __forceinline__ float bcq(float x) { return __builtin_bit_cast(float, __builtin_amdgcn_mov_dpp(__builtin_bit_cast(int, x), 0x150 + Q, 0xf, 0xf, true)); }

__device__ __forceinline__ void p4_scan_a(Frame& F) {
    const int lane = F.lane, q16 = lane & 15;
    const int id = F.vcu * NWAVES + F.wave;
    const int b = id >> 8, h = (id >> 5) & 7, c = id & 31;
    const bf16* UA = (const bf16*)(F.ws + WS_UA);
    const float* DEC = F.out; const float* LR = F.out + (size_t)T * 512;
    float* Gm = (float*)(F.ws + WS_UB); float* Hm = Gm + (size_t)2048 * 4096;
    bf16* Rbar = (bf16*)(F.ws + WS_US); bf16* Yloc = (bf16*)(F.ws + WS_YLOC);
    float* BON = (float*)(F.ws + WS_BONUS);
    const float* mu = F.in[3];
    const int ch0 = h * 64 + 4 * q16;
    f32x4 mu_r = *(const f32x4*)(mu + ch0), mu_k = *(const f32x4*)(mu + 512 + ch0), kkc = *(const f32x4*)(F.in[8] + ch0), kac = *(const f32x4*)(F.in[9] + ch0), rkc = *(const f32x4*)(F.in[10] + ch0);
    const float mu_v = mu[1024 + h * 64 + lane];
    const long m0 = (long)b * SEQ + c * 64;
    float sL[64], sG[64];
#pragma unroll
    for (int j = 0; j < 64; ++j) { sL[j] = 0.f; sG[j] = (j == lane) ? 1.f : 0.f; }
    f32x4 pr = {0.f, 0.f, 0.f, 0.f}, pk = {0.f, 0.f, 0.f, 0.f}; float pv = 0.f;
    if (c > 0) { const bf16* up = UA + (m0 - 1) * U_LD; const v2u a = *(const v2u*)(up + ch0), k = *(const v2u*)(up + 512 + ch0);
        pr = (f32x4){bflo(a.x), bfhi(a.x), bflo(a.y), bfhi(a.y)}; pk = (f32x4){bflo(k.x), bfhi(k.x), bflo(k.y), bfhi(k.y)}; pv = bf2f(up[1024 + h * 64 + lane]); }
    for (int t = 0; t < 64; ++t) {
        const long m = m0 + t;
        const bf16* up = UA + m * U_LD;
        const v2u ua = *(const v2u*)(up + ch0), uk = *(const v2u*)(up + 512 + ch0);
        const float cv = bf2f(up[1024 + h * 64 + lane]);
        const f32x4 lr = *(const f32x4*)(LR + m * 512 + ch0), wv = *(const f32x4*)(DEC + m * 512 + ch0);
        const f32x4 cr = (f32x4){bflo(ua.x), bfhi(ua.x), bflo(ua.y), bfhi(ua.y)}, ck = (f32x4){bflo(uk.x), bfhi(uk.x), bflo(uk.y), bfhi(uk.y)};
        f32x4 rv, kx, av, bv, km;
        float ss = 0.f, bon = 0.f;
#pragma unroll
        for (int e = 0; e < 4; ++e) { rv[e] = cr[e] + (pr[e] - cr[e]) * mu_r[e]; kx[e] = ck[e] + (pk[e] - ck[e]) * mu_k[e]; const float kk = kx[e] * kkc[e]; av[e] = kk; ss += kk * kk; }
        ss = row16_sum(ss);
        const float inv = 1.0f / fmaxf(sqrtf(ss), 1e-12f);
#pragma unroll
        for (int e = 0; e < 4; ++e) { av[e] = -av[e] * inv; bv[e] = -av[e] * lr[e]; km[e] = kx[e] * (1.0f + (lr[e] - 1.0f) * kac[e]); bon += rv[e] * km[e] * rkc[e]; }
        bon = row16_sum(bon);
        const float vi = cv + (pv - cv) * mu_v;
        pr = cr; pk = ck; pv = cv;
        if (lane == 0) BON[m * 8 + h] = bon;
        float saL0 = 0.f, saL1 = 0.f, saG0 = 0.f, saG1 = 0.f;
#define SA_BLK(Q) { const float a0 = bcq<Q>(av[0]), a1 = bcq<Q>(av[1]), a2 = bcq<Q>(av[2]), a3 = bcq<Q>(av[3]); \
            saL0 = fmaf(sL[4 * Q], a0, saL0); saG0 = fmaf(sG[4 * Q], a0, saG0); saL1 = fmaf(sL[4 * Q + 1], a1, saL1); saG1 = fmaf(sG[4 * Q + 1], a1, saG1); \
            saL0 = fmaf(sL[4 * Q + 2], a2, saL0); saG0 = fmaf(sG[4 * Q + 2], a2, saG0); saL1 = fmaf(sL[4 * Q + 3], a3, saL1); saG1 = fmaf(sG[4 * Q + 3], a3, saG1); }
        SA_BLK(0) SA_BLK(1) SA_BLK(2) SA_BLK(3) SA_BLK(4) SA_BLK(5) SA_BLK(6) SA_BLK(7) SA_BLK(8) SA_BLK(9) SA_BLK(10) SA_BLK(11) SA_BLK(12) SA_BLK(13) SA_BLK(14) SA_BLK(15)
#undef SA_BLK
        const float saL = saL0 + saL1, saG = saG0 + saG1;
        float yL0 = 0.f, yL1 = 0.f, yG0 = 0.f, yG1 = 0.f;
#define UP_ONE(Q, E, YL, YG) { const float w_ = bcq<Q>(wv[E]), b_ = bcq<Q>(bv[E]), k_ = bcq<Q>(km[E]), r_ = bcq<Q>(rv[E]); \
            sL[4 * Q + E] = fmaf(sL[4 * Q + E], w_, fmaf(saL, b_, vi * k_)); sG[4 * Q + E] = fmaf(sG[4 * Q + E], w_, saG * b_); \
            YL = fmaf(sL[4 * Q + E], r_, YL); YG = fmaf(sG[4 * Q + E], r_, YG); }
#define UP_BLK(Q) UP_ONE(Q, 0, yL0, yG0) UP_ONE(Q, 1, yL1, yG1) UP_ONE(Q, 2, yL0, yG0) UP_ONE(Q, 3, yL1, yG1)
        UP_BLK(0) UP_BLK(1) UP_BLK(2) UP_BLK(3) UP_BLK(4) UP_BLK(5) UP_BLK(6) UP_BLK(7) UP_BLK(8) UP_BLK(9) UP_BLK(10) UP_BLK(11) UP_BLK(12) UP_BLK(13) UP_BLK(14) UP_BLK(15)
#undef UP_BLK
#undef UP_ONE
        Yloc[m * 512 + h * 64 + lane] = (bf16)f2bf(yL0 + yL1);
        Rbar[m * 512 + h * 64 + lane] = (bf16)f2bf(yG0 + yG1);
    }
    float* hp = Hm + (size_t)id * 4096 + lane * 64; float* gp = Gm + (size_t)id * 4096 + lane * 64;
#pragma unroll
    for (int j = 0; j < 64; j += 4) { *(f32x4*)(hp + j) = (f32x4){sL[j], sL[j + 1], sL[j + 2], sL[j + 3]}; *(f32x4*)(gp + j) = (f32x4){sG[j], sG[j + 1], sG[j + 2], sG[j + 3]}; }
}

__device__ __forceinline__ void p5_scan_b(Frame& F) {
    const int bh = F.vcu >> 2, i0 = (F.vcu & 3) * 16, tid = F.tid;
    const float* Gm = (const float*)(F.ws + WS_UB); const float* Hm = Gm + (size_t)2048 * 4096;
    float* Sst = F.out;
    LAS float* Ss = (LAS float*)(F.lds + RING_OFF);
    LAS float* Gs = Ss + 1024;
    const int i = tid >> 5, jq = tid & 31;
    float s0 = 0.f, s1 = 0.f;
    const int id0 = ((bh >> 3) << 8) | ((bh & 7) << 5);
    for (int c = 0; c < 32; ++c) {
        const size_t base = (size_t)(id0 + c) * 4096;
        *(f32x2*)(Sst + base + (size_t)(i0 + i) * 64 + 2 * jq) = (f32x2){s0, s1};
        if (c == 31) break;
        *(LAS f32x2*)(Ss + i * 64 + 2 * jq) = (f32x2){s0, s1};
#pragma unroll
        for (int k = 0; k < 2; ++k) *(LAS f32x4*)(Gs + (k * 512 + tid) * 4) = *(const f32x4*)(Gm + base + (size_t)(k * 512 + tid) * 4);
        const f32x2 hv = *(const f32x2*)(Hm + base + (size_t)(i0 + i) * 64 + 2 * jq);
        __syncthreads();
        float a0 = hv.x, a1 = hv.y;
#pragma unroll 16
        for (int m = 0; m < 64; ++m) { const float sv = Ss[i * 64 + m]; const f32x2 g = *(const LAS f32x2*)(Gs + m * 64 + 2 * jq); a0 = fmaf(sv, g.x, a0); a1 = fmaf(sv, g.y, a1); }
        s0 = a0; s1 = a1;
        __syncthreads();
    }
}

__device__ __forceinline__ void p6_scan_c(Frame& F) {
    const int lane = F.lane, fr = lane & 15, fq = lane >> 4;
    const int id = F.vcu * NWAVES + F.wave;
    const int b = id >> 8, h = (id >> 5) & 7, c = id & 31;
    const bf16* UA = (const bf16*)(F.ws + WS_UA);
    const bf16* Rbar = (const bf16*)(F.ws + WS_US); const bf16* Yloc = (const bf16*)(F.ws + WS_YLOC);
    const float* BON = (const float*)(F.ws + WS_BONUS);
    const float* Sst = F.out + (size_t)id * 4096;
    bf16* Acomb = (bf16*)(F.ws + WS_ACOMB);
    const float* mu = F.in[3];
    const long m0 = (long)b * SEQ + c * 64;
    bf16x8 bfr[4][2];
#pragma unroll
    for (int it = 0; it < 4; ++it)
#pragma unroll
        for (int ks = 0; ks < 2; ++ks) { const float* p = Sst + (16 * it + fr) * 64 + 32 * ks + 8 * fq; const f32x4 x0 = *(const f32x4*)p, x1 = *(const f32x4*)(p + 4);
            v4u w; w.x = pk2(x0[0], x0[1]); w.y = pk2(x0[2], x0[3]); w.z = pk2(x1[0], x1[1]); w.w = pk2(x1[2], x1[3]); bfr[it][ks] = __builtin_bit_cast(bf16x8, w); }
    float lw[4], lb[4], muv[4], mug[4];
#pragma unroll
    for (int it = 0; it < 4; ++it) { const int ch = h * 64 + 16 * it + fr; lw[it] = F.in[11][ch]; lb[it] = F.in[12][ch]; muv[it] = mu[1024 + ch]; mug[it] = mu[1664 + ch]; }
#pragma unroll 1
    for (int tt = 0; tt < 4; ++tt) {
        f32x4 acc[4];
        bf16x8 afr[2];
#pragma unroll
        for (int ks = 0; ks < 2; ++ks) afr[ks] = *(const bf16x8*)(Rbar + (m0 + 16 * tt + fr) * 512 + h * 64 + 32 * ks + 8 * fq);
#pragma unroll
        for (int it = 0; it < 4; ++it) { acc[it] = (f32x4){0.f, 0.f, 0.f, 0.f};
#pragma unroll
            for (int ks = 0; ks < 2; ++ks) acc[it] = __builtin_amdgcn_mfma_f32_16x16x32_bf16(afr[ks], bfr[it][ks], acc[it], 0, 0, 0); }
#pragma unroll
        for (int rg = 0; rg < 4; ++rg) {
            const long m = m0 + 16 * tt + 4 * fq + rg; const bool first = (m % SEQ) == 0;
            float y[4]; float s = 0.f;
#pragma unroll
            for (int it = 0; it < 4; ++it) { y[it] = acc[it][rg] + bf2f(Yloc[m * 512 + h * 64 + 16 * it + fr]); s += y[it]; }
            const float mean = row16_sum(s) * (1.f / 64.f); float q = 0.f;
#pragma unroll
            for (int it = 0; it < 4; ++it) { y[it] -= mean; q += y[it] * y[it]; }
            const float rstd = 1.0f / sqrtf(row16_sum(q) * (1.f / 64.f) + LNX_EPS);
            const float bs = BON[m * 8 + h];
#pragma unroll
            for (int it = 0; it < 4; ++it) { const int ch = h * 64 + 16 * it + fr;
                const float cv = bf2f(UA[m * U_LD + 1024 + ch]), cg = bf2f(UA[m * U_LD + 1536 + ch]);
                const float pv = first ? 0.f : bf2f(UA[(m - 1) * U_LD + 1024 + ch]), pg = first ? 0.f : bf2f(UA[(m - 1) * U_LD + 1536 + ch]);
                const float vv = cv + (pv - cv) * muv[it], gg = cg + (pg - cg) * mug[it];
                const float z = (y[it] * rstd * lw[it] + lb[it] + bs * vv) * siluf_(gg);
                Acomb[m * ACOMB_LD + ZA_OFF + ch] = (bf16)f2bf(z); }
        }
    }
}
struct SchedP7 {
    int pm, pn; const char* Acomb; const char* WinT; const char* Wab;
    __device__ __forceinline__ bool next(int i, pg8::Unit& u) const {
        if (i >= 4) return false;
        u.pm = pm; u.pn = pn; u.kind = i;
        const char* arow = Acomb + (size_t)pm * 256 * ACOMB_LD * 2;
        if (i == 0)      { u.nt = 16; u.a = arow;                 u.b = WinT + (size_t)(4096 + pn * 256) * 1024 * 2; }
        else if (i == 1) { u.nt = 8;  u.a = arow + ZA_OFF * 2;    u.b = Wab + (size_t)(pn * 256) * 1024 * 2; }
        else if (i == 2) { u.nt = 16; u.a = arow;                 u.b = WinT + (size_t)(5120 + pn * 256) * 1024 * 2; }
        else             { u.nt = 8;  u.a = arow + ZB_OFF * 2;    u.b = Wab + (size_t)(pn * 256) * 1024 * 2 + 512 * 2; }
        return true;
    }
};
struct EpiP7 {
    f32x4* SG; f32x4* TMP; bf16* merged;
    __device__ __forceinline__ void operator()(const f32x4 (&acc)[2][2][4][2], const pg8::Unit& u, int wr, int wc, int fr, int fq) const {
        const int tid = threadIdx.x;
        f32x4* SG = this->SG; f32x4* TMP = this->TMP;
        asm volatile("" : "+s"(SG), "+s"(TMP));
        if (u.kind == 0 || u.kind == 2) {
#pragma unroll
            for (int ai = 0; ai < 2; ++ai)
#pragma unroll
                for (int bj = 0; bj < 2; ++bj)
#pragma unroll
                    for (int m = 0; m < 4; ++m)
#pragma unroll
                        for (int n = 0; n < 2; ++n) { const f32x4 v = acc[ai][bj][m][n]; f32x4* p = SG + (((((ai * 2 + bj) * 4 + m) * 2 + n)) << 9);
                            p[tid] = (f32x4){sigmoidf_(v[0]), sigmoidf_(v[1]), sigmoidf_(v[2]), sigmoidf_(v[3])}; asm volatile("" ::: "memory"); }
        } else if (u.kind == 1) {
#pragma unroll
            for (int ai = 0; ai < 2; ++ai)
#pragma unroll
                for (int bj = 0; bj < 2; ++bj)
#pragma unroll
                    for (int m = 0; m < 4; ++m)
#pragma unroll
                        for (int n = 0; n < 2; ++n) { const int ix = ((((ai * 2 + bj) * 4 + m) * 2 + n) << 9); const f32x4* ps = SG + ix; f32x4* pt = TMP + ix; pt[tid] = ps[tid] * acc[ai][bj][m][n]; if (n == 1) asm volatile("" ::: "memory"); }
        } else {
            const int row0 = u.pm * 256 + wr * 64 + fr; bf16* base = merged + u.pn * 256 + wc * 32 + 8 * fq;
#pragma unroll
            for (int ai = 0; ai < 2; ++ai)
#pragma unroll
                for (int m = 0; m < 4; ++m) { bf16* rowp = base + (size_t)(row0 + ai * 128 + m * 16) * 1024;
#pragma unroll
                    for (int bj = 0; bj < 2; ++bj) { const int ix = (((ai * 2 + bj) * 4 + m) * 2) << 9; const f32x4* ps = SG + ix; const f32x4* pt = TMP + ix;
                        const f32x4 v0 = pt[tid] + ps[tid] * acc[ai][bj][m][0], v1 = pt[512 + tid] + ps[512 + tid] * acc[ai][bj][m][1];
                        pg8::u32x4 w; w.x = pg8::cvt_pk_bf16(v0[0], v0[1]); w.y = pg8::cvt_pk_bf16(v0[2], v0[3]); w.z = pg8::cvt_pk_bf16(v1[0], v1[1]); w.w = pg8::cvt_pk_bf16(v1[2], v1[3]);
                        *(pg8::u32x4*)(rowp + bj * 128) = w; asm volatile("" ::: "memory"); } }
        }
    }
};
struct SchedP8 {
    int pm, pn; const char* A; const char* B;
    __device__ __forceinline__ bool next(int i, pg8::Unit& u) const {
        if (i >= 1) return false;
        u.pm = pm; u.pn = pn; u.kind = 0; u.nt = 16; u.a = A + (size_t)pm * 256 * 1024 * 2; u.b = B + (size_t)pn * 256 * 1024 * 2; return true;
    }
};
struct EpiP8 {
    const float* x; float* out;
    __device__ __forceinline__ void operator()(const f32x4 (&acc)[2][2][4][2], const pg8::Unit& u, int wr, int wc, int fr, int fq) const {
        const int row0 = u.pm * 256 + wr * 64 + fr; const int col0 = u.pn * 256 + wc * 32 + 8 * fq;
#pragma unroll
        for (int ai = 0; ai < 2; ++ai)
#pragma unroll
            for (int m = 0; m < 4; ++m) { const size_t off = (size_t)(row0 + ai * 128 + m * 16) * DM + col0;
#pragma unroll
                for (int bj = 0; bj < 2; ++bj) { const f32x4 x0 = *(const f32x4*)(x + off + bj * 128), x1 = *(const f32x4*)(x + off + bj * 128 + 4);
                    *(f32x4*)(out + off + bj * 128) = x0 + acc[ai][bj][m][0]; *(f32x4*)(out + off + bj * 128 + 4) = x1 + acc[ai][bj][m][1]; } }
    }
};
__device__ __forceinline__ void p9_final_norm(Frame& F) {
    const int gw = F.vcu * NWAVES + F.wave, NGW = F.G * NWAVES;
    const GAS f32x4* gp = (const GAS f32x4*)F.in[19] + F.lane;
    f32x4 g[4];
#pragma unroll
    for (int j = 0; j < 4; ++j) g[j] = gp[64 * j];
    for (int m = gw; m < T; m += NGW) {
        GAS f32x4* xr = (GAS f32x4*)(F.out + (size_t)m * DM) + F.lane;
        f32x4 v[4]; float s = 0.f;
#pragma unroll
        for (int j = 0; j < 4; ++j) { v[j] = xr[64 * j]; s += (v[j].x * v[j].x + v[j].y * v[j].y) + (v[j].z * v[j].z + v[j].w * v[j].w); }
        const float rstd = 1.f / sqrtf(wave_sum(s) * (1.f / DM) + RMS_EPS);
#pragma unroll
        for (int j = 0; j < 4; ++j) xr[64 * j] = v[j] * rstd * g[j];
    }
}

constexpr int N_PHASES = 10;
struct Args { const float* in[20]; float* out; unsigned char* ws; int ph_lo, ph_hi; };
__global__ void __launch_bounds__(NWAVES * 64, 2) hybrid_fwd(Args args) {
    extern __shared__ __attribute__((aligned(16))) unsigned char lds[];
    Frame F;
    F.lds = (LAS unsigned char*)lds;
    F.MISC = (volatile LAS unsigned*)(F.lds + MISC_OFF);
    F.tid = threadIdx.x; F.lane = F.tid & 63; F.wave = __builtin_amdgcn_readfirstlane(F.tid >> 6);
    F.G = gridDim.x; { const int bx = blockIdx.x; F.vcu = (bx % 8) * (F.G / 8) + bx / 8; }
#pragma unroll
    for (int i = 0; i < 20; ++i) F.in[i] = args.in[i];
    F.out = args.out; F.ws = args.ws;
    unsigned char* ws = args.ws;
    for (int u = F.tid; u < (LDS_BYTES - LDSCTL_OFF) / 4; u += NWAVES * 64) ((LAS unsigned*)(F.lds + LDSCTL_OFF))[u] = 0u;
    __syncthreads();
    const int lo = args.ph_lo, hi = args.ph_hi;
    const bool multi = (hi - lo) > 1;
    XcdBarrier bar; bar.bar = (unsigned*)(ws + WS_CTL) + CW_BAR; bar.x = 0; bar.st = nullptr;
    if (multi) bar = xcd_barrier_post((unsigned*)(ws + WS_CTL) + CW_BAR, F.MISC + 8);
#ifndef PH_MASK
#define PH_MASK 0x3ff
#endif
#define IN(k) (((PH_MASK >> (k)) & 1) && lo <= (k) && (k) < hi)
#define SEAM(k) do { if (IN(k) && IN((k) + 1)) xcd_barrier(bar); } while (0)
    if (IN(0)) { p0_prologue(F); SEAM(0); }
    if (IN(1)) {
        SchedP1 S{(int)blockIdx.x, F.G, (const char*)(ws + WS_ACOMB), (const char*)(ws + WS_WINT)};
        EpiP1 E{(bf16*)(ws + WS_UA), (bf16*)(ws + WS_UB), (float*)(ws + WS_US)};
        pg8::gemm_phase(F.lds + RING_OFF, ACOMB_LD, 1024, S, E);
        SEAM(1);
    }
    if (IN(2)) { p2_prep(F); SEAM(2); }
    if (IN(3)) { p3_attention(F); SEAM(3); }
    if (IN(4)) { p4_scan_a(F); SEAM(4); }
    if (IN(5)) { p5_scan_b(F); SEAM(5); }
    if (IN(6)) { p6_scan_c(F); SEAM(6); }
    const int pm = F.vcu >> 2, pn = F.vcu & 3;
    if (IN(7)) {
        SchedP7 S{pm, pn, (const char*)(ws + WS_ACOMB), (const char*)(ws + WS_WINT), (const char*)(ws + WS_WAB)};
        EpiP7 E{(f32x4*)(ws + WS_UA) + (size_t)blockIdx.x * 16384, (f32x4*)(ws + WS_UB) + (size_t)blockIdx.x * 16384, (bf16*)(ws + WS_MERGED)};
        pg8::gemm_phase(F.lds + RING_OFF, ACOMB_LD, 1024, S, E);
        SEAM(7);
    }
    if (IN(8)) {
        SchedP8 S{pm, pn, (const char*)(ws + WS_MERGED), (const char*)(ws + WS_WOUT)};
        EpiP8 E{F.in[0], F.out};
        pg8::gemm_phase(F.lds + RING_OFF, 1024, 1024, S, E);
        SEAM(8);
    }
    if (IN(9)) { p9_final_norm(F); }
#undef IN
#undef SEAM
}

#ifndef MK_N_LAUNCHES
#define MK_N_LAUNCHES 10
#endif
extern "C" void kernel_launch(void* const* d_in, const int* in_sizes, int n_in, void* d_out, int out_size, void* d_ws, size_t ws_size, hipStream_t stream) {
    static int grid = 0;
    if (grid == 0) {
        if (n_in != 20 || in_sizes[0] != T * DM || out_size != T * DM || ws_size < WS_END) { fprintf(stderr, "kernel_launch: unexpected shapes (n_in %d, in0 %d, out %d, ws %zu); nothing launched\n", n_in, n_in > 0 ? in_sizes[0] : -1, out_size, ws_size); grid = -1; return; }
        int dev = 0, cus = 0, per_cu = 0;
        if (hipGetDevice(&dev) != hipSuccess || hipDeviceGetAttribute(&cus, hipDeviceAttributeMultiprocessorCount, dev) != hipSuccess) { grid = -1; return; }
        if (hipFuncSetAttribute((const void*)hybrid_fwd, hipFuncAttributeMaxDynamicSharedMemorySize, LDS_BYTES) != hipSuccess) { fprintf(stderr, "kernel_launch: hipFuncSetAttribute failed\n"); grid = -1; return; }
        if (hipOccupancyMaxActiveBlocksPerMultiprocessor(&per_cu, (const void*)hybrid_fwd, NWAVES * 64, LDS_BYTES) != hipSuccess || per_cu < 1) fprintf(stderr, "kernel_launch: note: occupancy query reports %d workgroups per CU\n", per_cu);
        (void)hipGetLastError();
        grid = 256;
        if (cus != 256) fprintf(stderr, "kernel_launch: device reports %d CUs; this kernel is built for 256\n", cus);
    }
    if (grid < 0) return;
    (void)hipMemsetAsync((char*)d_ws + WS_CTL, 0, CTL_ZERO_BYTES, stream);
    Args a{};
    for (int i = 0; i < 20; ++i) a.in[i] = (const float*)d_in[i];
    a.out = (float*)d_out; a.ws = (unsigned char*)d_ws;
    if (MK_N_LAUNCHES == 1) { a.ph_lo = 0; a.ph_hi = N_PHASES; hipLaunchKernelGGL(hybrid_fwd, dim3(grid), dim3(NWAVES * 64), LDS_BYTES, stream, a); }
    else for (int p = 0; p < N_PHASES; ++p) { a.ph_lo = p; a.ph_hi = p + 1; hipLaunchKernelGGL(hybrid_fwd, dim3(grid), dim3(NWAVES * 64), LDS_BYTES, stream, a); }
}
```

```cpp
#include <hip/hip_runtime.h>
#include <hip/hip_bf16.h>
#include <cstdio>
#include <cstdint>
#include <cmath>

#define GAS __attribute__((address_space(1)))
#define LAS __attribute__((address_space(3)))
typedef unsigned short bf16;
typedef unsigned v4u __attribute__((ext_vector_type(4)));
typedef unsigned v2u __attribute__((ext_vector_type(2)));
typedef float f32x2 __attribute__((ext_vector_type(2)));
typedef float f32x4 __attribute__((ext_vector_type(4)));
typedef float f32x16 __attribute__((ext_vector_type(16)));
typedef short bf16x8 __attribute__((ext_vector_type(8)));
typedef short s16x4 __attribute__((ext_vector_type(4)));

constexpr int NB = 8, SEQ = 2048, DM = 1024, T = NB * SEQ, NH = 8, HD = 64;
constexpr int IN_COLS = 6280, NPAD = 6400;
constexpr float RMS_EPS = 1e-6f, LNX_EPS = 64e-5f;
constexpr float LOG2E = 1.4426950408889634f;
constexpr float C2 = 0.125f * LOG2E;

constexpr size_t MiB = 1u << 20;
constexpr size_t WS_CTL = 0, CTL_ZERO_BYTES = 64 * 1024;
constexpr size_t WS_WINT = 1 * MiB;
constexpr size_t WS_WAB = 14 * MiB;
constexpr size_t WS_WOUT = 16 * MiB;
constexpr size_t WS_G2 = 19 * MiB;
constexpr size_t WS_BONUS = 19 * MiB + 512 * 1024;
constexpr size_t WS_ACOMB = 20 * MiB;
constexpr size_t WS_UA = 84 * MiB;
constexpr size_t WS_UB = 148 * MiB;
constexpr size_t WS_US = 212 * MiB;
constexpr size_t WS_YLOC = 228 * MiB;
constexpr size_t WS_MERGED = 212 * MiB;
constexpr size_t WS_END = 256 * MiB;
constexpr int ACOMB_LD = 2048, U_LD = 2048;
constexpr int ZA_OFF = 1024, ZB_OFF = 1536;

#define RLX_AGENT __ATOMIC_RELAXED, __HIP_MEMORY_SCOPE_AGENT
#define LDS_WAIT() asm volatile("s_waitcnt lgkmcnt(0)" ::: "memory")
#define VM_WAIT() asm volatile("s_waitcnt vmcnt(0)" ::: "memory")

__device__ __forceinline__ unsigned f2bf(float f) { unsigned u = __builtin_bit_cast(unsigned, f); return (u + 0x7fffu + ((u >> 16) & 1u)) >> 16; }
__device__ __forceinline__ unsigned pk2(float lo, float hi) { return f2bf(lo) | (f2bf(hi) << 16); }
__device__ __forceinline__ float bf2f(unsigned b) { return __builtin_bit_cast(float, b << 16); }
__device__ __forceinline__ float bflo(unsigned w) { return __builtin_bit_cast(float, w << 16); }
__device__ __forceinline__ float bfhi(unsigned w) { return __builtin_bit_cast(float, w & 0xffff0000u); }
__device__ __forceinline__ float sigmoidf_(float x) { return 1.0f / (1.0f + __expf(-x)); }
__device__ __forceinline__ float siluf_(float x) { return x / (1.0f + __expf(-x)); }
__device__ __forceinline__ float wave_sum(float v) {
#pragma unroll
    for (int o = 1; o < 64; o <<= 1) v += __shfl_xor(v, o);
    return v;
}
template <int CTRL> __device__ __forceinline__ float dppf(float x) { return __builtin_bit_cast(float, __builtin_amdgcn_mov_dpp(__builtin_bit_cast(int, x), CTRL, 0xf, 0xf, true)); }
__device__ __forceinline__ float row16_sum(float v) { v += dppf<0x128>(v); v += dppf<0x124>(v); v += dppf<0x122>(v); v += dppf<0x121>(v); return v; }
namespace pg8 {
#define PG8_LAS __attribute__((address_space(3)))
typedef unsigned short bf16_t;
typedef unsigned u32x4 __attribute__((ext_vector_type(4)));
constexpr int BM = 256, BK = 64, HALF = 128, HTB = HALF * BK * 2  , STAGE_BYTES = 8 * HTB;

__host__ __device__ __forceinline__ int lds_byte(int r, int c) { const int st = (r >> 4) * 2 + (c >> 5), rr = r & 15, cc = c & 31, ob = rr * 64 + cc * 2; return st * 1024 + (ob ^ (((ob >> 9) & 1) << 5)); }
__host__ __device__ __forceinline__ void stage_rc(int b, int& R, int& C) { const int st = b / 1024, sb = b % 1024, swz = sb ^ (((sb >> 9) & 1) << 5); R = (st >> 1) * 16 + swz / 64; C = (st & 1) * 32 + (swz % 64) / 2; }
__host__ __device__ __forceinline__ int perm32(int rho) { const int n = rho >> 4, i = rho & 15; return 8 * (i >> 2) + 4 * n + (i & 3); }

struct Unit { int pm, pn, kind, nt; const char* a; const char* b; };

__device__ __forceinline__ unsigned cvt_pk_bf16(float lo, float hi) { unsigned r; asm volatile("v_cvt_pk_bf16_f32 %0, %1, %2" : "=v"(r) : "v"(lo), "v"(hi)); return r; }

template <class Epi, class Sched>
__device__ __forceinline__ void gemm_phase(PG8_LAS unsigned char* lds, const int lda, const int ldb, const Sched& S, const Epi& E) {
    const int tid = threadIdx.x, wid = __builtin_amdgcn_readfirstlane(tid >> 6), lane = tid & 63, wr = wid >> 2, wc = wid & 3, fr = lane & 15, fq = lane >> 4;
    unsigned voffA[2], voffB[2];
#pragma unroll
    for (int i = 0; i < 2; ++i) { int R, C; stage_rc(tid * 16 + i * 8192, R, C); const int Rb = (R & ~31) + perm32(R & 31);
        voffA[i] = (unsigned)(R * lda + C) * 2u; voffB[i] = (unsigned)(Rb * ldb + C) * 2u; }
    const size_t kstep = (size_t)(BK * 2);
    const size_t hstepA = (size_t)HALF * lda * 2, hstepB = (size_t)HALF * ldb * 2;
    const unsigned ldsw = (unsigned)wid * 1024u;
    const int aoff = lds_byte(wr * 64 + fr, fq * 8), boff = lds_byte(wc * 32 + fr, fq * 8);
#define PG8_SA(b, h) (((b) * 2 + (h)) * HTB)
#define PG8_SB(b, h) ((4 + (b) * 2 + (h)) * HTB)
#define PG8_STAGE(bufoff, gbase, voff) do { _Pragma("unroll") for (int _i = 0; _i < 2; ++_i) \
        __builtin_amdgcn_global_load_lds((const unsigned*)((const char*)(gbase) + (voff)[_i]), (PG8_LAS unsigned*)(lds + (bufoff) + ldsw + _i * 8192), 16, 0, 0); } while (0)
#define PG8_LDA(dst, b, h) do { _Pragma("unroll") for (int m = 0; m < 4; ++m) _Pragma("unroll") for (int k = 0; k < 2; ++k) dst[m][k] = *(const PG8_LAS bf16x8*)(lds + PG8_SA(b, h) + aoff + m * 2048 + k * 1024); } while (0)
#define PG8_LDB(dst, b, h) do { _Pragma("unroll") for (int n = 0; n < 2; ++n) _Pragma("unroll") for (int k = 0; k < 2; ++k) dst[n][k] = *(const PG8_LAS bf16x8*)(lds + PG8_SB(b, h) + boff + n * 2048 + k * 1024); } while (0)
#define PG8_MMA(ai, bj, At, Bt) do { __builtin_amdgcn_s_setprio(1); _Pragma("unroll") for (int m = 0; m < 4; ++m) _Pragma("unroll") for (int n = 0; n < 2; ++n) _Pragma("unroll") for (int k = 0; k < 2; ++k) \
        acc[ai][bj][m][n] = __builtin_amdgcn_mfma_f32_16x16x32_bf16(Bt[n][k], At[m][k], acc[ai][bj][m][n], 0, 0, 0); __builtin_amdgcn_s_setprio(0); } while (0)
#define PG8_WAIT_V(n) asm volatile("s_waitcnt vmcnt(" #n ")" ::: "memory")
#define PG8_WAIT_L(n) asm volatile("s_waitcnt lgkmcnt(" #n ")" ::: "memory")
#define PG8_BAR __builtin_amdgcn_s_barrier()
#define PG8_SCHED __builtin_amdgcn_sched_barrier(0)
    Unit cur, nxt; int ui = 0;
    if (!S.next(0, cur)) return;
    f32x4 acc[2][2][4][2];
#pragma unroll
    for (int a = 0; a < 2; ++a)
#pragma unroll
        for (int b = 0; b < 2; ++b)
#pragma unroll
            for (int m = 0; m < 4; ++m)
#pragma unroll
                for (int n = 0; n < 2; ++n) acc[a][b][m][n] = (f32x4){0.f, 0.f, 0.f, 0.f};
    bf16x8 At[4][2], B0[2][2], B1[2][2];
    const char* cA = cur.a; const char* cB = cur.b;
    PG8_STAGE(PG8_SB(0, 0), cB, voffB); PG8_STAGE(PG8_SB(0, 1), cB + hstepB, voffB); PG8_STAGE(PG8_SA(0, 0), cA, voffA); PG8_STAGE(PG8_SA(0, 1), cA + hstepA, voffA);
    if (wr == 1) PG8_BAR;
    PG8_WAIT_V(2); PG8_BAR;
    PG8_STAGE(PG8_SB(1, 0), cB + kstep, voffB); PG8_STAGE(PG8_SA(1, 0), cA + kstep, voffA); PG8_STAGE(PG8_SB(1, 1), cB + hstepB + kstep, voffB);
    PG8_WAIT_V(6); PG8_BAR;
    for (;;) {
        const bool has_next = S.next(ui + 1, nxt);
        const char* nA = has_next ? nxt.a : cA; const char* nB = has_next ? nxt.b : cB;
        const int nt = cur.nt;
        for (int t = 0; t < nt; t += 2) {
            const bool last = (t == nt - 2);
            const char* a1 = cA + (size_t)(t + 1) * kstep;
            const char* a2 = last ? nA : cA + (size_t)(t + 2) * kstep; const char* b2 = last ? nB : cB + (size_t)(t + 2) * kstep;
            const char* a3 = a2 + kstep; const char* b3 = b2 + kstep;
            PG8_LDB(B0, 0, 0); PG8_LDB(B1, 0, 1); PG8_SCHED; PG8_LDA(At, 0, 0); PG8_STAGE(PG8_SA(1, 1), a1 + hstepA, voffA);
            PG8_WAIT_V(8); PG8_WAIT_L(0); PG8_BAR; PG8_MMA(0, 0, At, B0); PG8_MMA(0, 1, At, B1); PG8_BAR; PG8_SCHED;
            PG8_LDA(At, 0, 1); PG8_STAGE(PG8_SB(0, 0), b2, voffB); PG8_STAGE(PG8_SB(0, 1), b2 + hstepB, voffB); PG8_STAGE(PG8_SA(0, 0), a2, voffA);
            PG8_WAIT_V(8); PG8_WAIT_L(0); PG8_BAR; PG8_MMA(1, 0, At, B0); PG8_MMA(1, 1, At, B1); PG8_BAR; PG8_SCHED;
            PG8_LDB(B0, 1, 0); PG8_LDB(B1, 1, 1); PG8_SCHED; PG8_LDA(At, 1, 0); PG8_STAGE(PG8_SA(0, 1), a2 + hstepA, voffA);
            PG8_WAIT_V(8); PG8_WAIT_L(0); PG8_BAR; PG8_MMA(0, 0, At, B0); PG8_MMA(0, 1, At, B1); PG8_BAR; PG8_SCHED;
            PG8_LDA(At, 1, 1); PG8_STAGE(PG8_SB(1, 0), b3, voffB); PG8_STAGE(PG8_SB(1, 1), b3 + hstepB, voffB); PG8_STAGE(PG8_SA(1, 0), a3, voffA);
            PG8_WAIT_V(8); PG8_WAIT_L(0); PG8_BAR; PG8_MMA(1, 0, At, B0); PG8_MMA(1, 1, At, B1); PG8_BAR; PG8_SCHED;
        }
        if (wr == 0) PG8_BAR;
        E(acc, cur, wr, wc, fr, fq);
        if (!has_next) break;
#pragma unroll
        for (int a = 0; a < 2; ++a)
#pragma unroll
            for (int b = 0; b < 2; ++b)
#pragma unroll
                for (int m = 0; m < 4; ++m)
#pragma unroll
                    for (int n = 0; n < 2; ++n) acc[a][b][m][n] = (f32x4){0.f, 0.f, 0.f, 0.f};
        cur = nxt; cA = nA; cB = nB; ++ui;
        if (wr == 1) PG8_BAR;
    }
    PG8_WAIT_V(0);
    PG8_BAR;
#undef PG8_SA
#undef PG8_SB
#undef PG8_STAGE
#undef PG8_LDA
#undef PG8_LDB
#undef PG8_MMA
#undef PG8_WAIT_V
#undef PG8_WAIT_L
#undef PG8_BAR
#undef PG8_SCHED
}
}
typedef GAS unsigned gu32;
#define XB_TMO      128
#define XB_XCNT(j)  (256  + 64 * (j))
#define XB_XSUB(j)  (1280 + 64 * (j))
#define XB_XGEN(j)  (2304 + 64 * (j))
#define XB_TOP      3328
#define XB_TOPGEN   3392
#define XCD_BAR_WORDS 3456
#define XB_SPIN_CAP (1u << 18)
__device__ __forceinline__ unsigned xb_ld(unsigned* p)              { return __hip_atomic_load(p, __ATOMIC_RELAXED, __HIP_MEMORY_SCOPE_AGENT); }
__device__ __forceinline__ unsigned xb_add(unsigned* p, unsigned v) { return __hip_atomic_fetch_add(p, v, __ATOMIC_RELAXED, __HIP_MEMORY_SCOPE_AGENT); }
__device__ __forceinline__ unsigned xb_xcc_id() { return (unsigned)__builtin_amdgcn_s_getreg((3 << 11) | 20) & 0xFu; }
#define XB_SPIN(cond, bar) do { unsigned _sp = 0; while (cond) { __builtin_amdgcn_s_sleep(1); \
    if ((++_sp & 255u) == 0u) { if (xb_ld(&(bar)[XB_TMO])) break; if (_sp > XB_SPIN_CAP) { atomicAdd(&(bar)[XB_TMO], 1u); break; } } } } while (0)
struct XcdBarrier { unsigned* bar; unsigned x; volatile LAS unsigned* st; };
__device__ __forceinline__ XcdBarrier xcd_barrier_post(unsigned* bar, volatile LAS unsigned* st) {
    XcdBarrier b; b.bar = bar; b.x = xb_xcc_id(); b.st = st;
    if (threadIdx.x == 0) (void)xb_add(&bar[XB_XCNT(b.x)], 1u);
    return b;
}
__device__ __forceinline__ void xcd_barrier_complete(unsigned* bar, unsigned x, unsigned& nloc, unsigned& nx) {
    const unsigned G = gridDim.x * gridDim.y * gridDim.z;
    unsigned sum, cnt, mine, sp = 0u;
    for (;;) {
        sum = 0u; cnt = 0u; mine = 0u;
#pragma unroll
        for (unsigned j = 0; j < 16; ++j) { const unsigned c = xb_ld(&bar[XB_XCNT(j)]); sum += c; cnt += (c > 0u) ? 1u : 0u; mine = (j == x) ? c : mine; }
        if (sum == G) break;
        __builtin_amdgcn_s_sleep(1);
        if ((++sp & 255u) == 0u) { if (xb_ld(&bar[XB_TMO])) break; if (sp > XB_SPIN_CAP) { atomicAdd(&bar[XB_TMO], 1u); break; } }
    }
    nloc = mine > 0u ? mine : 1u; nx = cnt > 0u ? cnt : 1u;
}
__device__ __forceinline__ void xcd_barrier(const XcdBarrier& b) {
    asm volatile("s_waitcnt vmcnt(0)" ::: "memory");
    __syncthreads();
    if (threadIdx.x == 0) {
        unsigned* bar = b.bar;
        __builtin_amdgcn_s_waitcnt(0);
        unsigned nloc = b.st[0], nx = b.st[1];
        if (nloc == 0u) { xcd_barrier_complete(bar, b.x, nloc, nx); b.st[0] = nloc; b.st[1] = nx; }
        const unsigned old = xb_add(&bar[XB_XSUB(b.x)], 1u);
        const unsigned gen = old / nloc;
        if (old + 1u == (gen + 1u) * nloc) {
            __builtin_amdgcn_fence(__ATOMIC_RELEASE, "agent");
            asm volatile("s_waitcnt vmcnt(0)" ::: "memory");
            const unsigned og = xb_add(&bar[XB_TOP], 1u);
            const unsigned tg = og / nx;
            if (og + 1u == (tg + 1u) * nx) xb_add(&bar[XB_TOPGEN], 1u);
            else XB_SPIN(xb_ld(&bar[XB_TOPGEN]) == tg, bar);
            __builtin_amdgcn_fence(__ATOMIC_ACQUIRE, "agent");
            xb_add(&bar[XB_XGEN(b.x)], 1u);
            asm volatile("s_waitcnt vmcnt(0)" ::: "memory");
        } else {
            XB_SPIN(xb_ld(&bar[XB_XGEN(b.x)]) == gen, bar);
            __builtin_amdgcn_fence(__ATOMIC_ACQUIRE, "agent");
            asm volatile("s_waitcnt vmcnt(0)" ::: "memory");
        }
    }
    __syncthreads();
}

constexpr int RING_OFF = 0, RING_BYTES = 131072;
constexpr int LDSCTL_OFF = RING_BYTES, MISC_OFF = LDSCTL_OFF + 320;
constexpr int LDS_BYTES = 147456;
constexpr int NWAVES = 8;
constexpr int CW_BAR = 4096;

struct Frame {
    LAS unsigned char* lds;
    volatile LAS unsigned* MISC;
    int tid, lane, wave, vcu, G;
    const float* in[20]; float* out; unsigned char* ws;
};
__device__ __forceinline__ void p0_transpose_item(const float* W, int ldw, bf16* WT, int ldt, int koff, LAS float* scr, int k0, int n0, int scol0, int nvalid, int lane) {
    const int li = lane & 31; const bool ok = li < nvalid;
#pragma unroll 8
    for (int i = 0; i < 32; ++i) { const int kk = 2 * i + (lane >> 5); scr[kk * 33 + li] = ok ? W[(size_t)(k0 + kk) * ldw + scol0 + li] : 0.f; }
    LDS_WAIT(); asm volatile("" ::: "memory");
    const int c = lane & 7;
#pragma unroll
    for (int j = 0; j < 4; ++j) { const int n = (lane >> 3) + 8 * j; const LAS float* s = scr + (8 * c) * 33 + n;
        v4u o; o.x = pk2(s[0 * 33], s[1 * 33]); o.y = pk2(s[2 * 33], s[3 * 33]); o.z = pk2(s[4 * 33], s[5 * 33]); o.w = pk2(s[6 * 33], s[7 * 33]);
        *(GAS v4u*)(WT + (size_t)(n0 + n) * ldt + koff + k0 + 8 * c) = o; }
    LDS_WAIT(); asm volatile("" ::: "memory");
}
__device__ __forceinline__ void win_map(int n0, int& scol0, int& nvalid) {
    nvalid = 32;
    if (n0 < 1536) scol0 = n0;
    else if (n0 < 4096) scol0 = n0 + 128;
    else if (n0 < 6144) scol0 = n0 + 136;
    else if (n0 < 6272) scol0 = n0 - 6144 + 1536;
    else if (n0 == 6272) { scol0 = 4224; nvalid = 8; }
    else { scol0 = 0; nvalid = 0; }
}
__device__ __forceinline__ void p0_prologue(Frame& F) {
    LAS float* scr = (LAS float*)(F.lds + RING_OFF + F.wave * 16384);
    const int gw = F.vcu * NWAVES + F.wave, NGW = F.G * NWAVES;
    bf16* WinT = (bf16*)(F.ws + WS_WINT); bf16* Wab = (bf16*)(F.ws + WS_WAB); bf16* WoutT = (bf16*)(F.ws + WS_WOUT);
    constexpr int I_IN = 16 * 200, I_AB = 8 * 32, I_OUT = 16 * 32;
    constexpr int NITEMS = I_IN + 2 * I_AB + I_OUT;
    for (int it = gw; it < NITEMS; it += NGW) {
        int r = it;
        if (r < I_IN) { const int kb = r / 200, nb = r % 200; int sc, nv; win_map(32 * nb, sc, nv); p0_transpose_item(F.in[2], IN_COLS, WinT, 1024, 0, scr, 64 * kb, 32 * nb, sc, nv, F.lane); continue; } r -= I_IN;
        if (r < I_AB) { const int kb = r / 32, nb = r % 32; p0_transpose_item(F.in[16], 1024, Wab, 1024, 0, scr, 64 * kb, 32 * nb, 32 * nb, 32, F.lane); continue; } r -= I_AB;
        if (r < I_AB) { const int kb = r / 32, nb = r % 32; p0_transpose_item(F.in[17], 1024, Wab, 1024, 512, scr, 64 * kb, 32 * nb, 32 * nb, 32, F.lane); continue; } r -= I_AB;
        { const int kb = r / 32, nb = r % 32; p0_transpose_item(F.in[18], 1024, WoutT, 1024, 0, scr, 64 * kb, 32 * nb, 32 * nb, 32, F.lane); }
    }
    bf16* Acomb = (bf16*)(F.ws + WS_ACOMB);
    const GAS f32x4* gp = (const GAS f32x4*)F.in[1] + F.lane;
    f32x4 g[4];
#pragma unroll
    for (int j = 0; j < 4; ++j) g[j] = gp[64 * j];
    for (int m = gw; m < T; m += NGW) {
        const GAS f32x4* xr = (const GAS f32x4*)(F.in[0] + (size_t)m * DM) + F.lane;
        f32x4 v[4]; float s = 0.f;
#pragma unroll
        for (int j = 0; j < 4; ++j) { v[j] = xr[64 * j]; s += (v[j].x * v[j].x + v[j].y * v[j].y) + (v[j].z * v[j].z + v[j].w * v[j].w); }
        const float rstd = 1.f / sqrtf(wave_sum(s) * (1.f / DM) + RMS_EPS);
        GAS unsigned long long* o8 = (GAS unsigned long long*)(Acomb + (size_t)m * ACOMB_LD) + F.lane;
#pragma unroll
        for (int j = 0; j < 4; ++j) o8[64 * j] = (unsigned long long)pk2(v[j].x * rstd * g[j].x, v[j].y * rstd * g[j].y) | ((unsigned long long)pk2(v[j].z * rstd * g[j].z, v[j].w * rstd * g[j].w) << 32);
    }
}

struct SchedP1 {
    int c, G; const char* A; const char* B;
    __device__ __forceinline__ bool next(int i, pg8::Unit& u) const {
        constexpr int nM = 64, nN = 17, nwg = nM * nN, NX = 8, WGM = 8;
        const int L = i * G + c; if (L >= nwg) return false;
        int wgid = L; { const int q = nwg / NX, r = nwg % NX, xcd = wgid % NX, off = wgid / NX; wgid = (xcd < r ? xcd * (q + 1) : r * (q + 1) + (xcd - r) * q) + off; }
        const int nig = WGM * nN, gid = wgid / nig, fm = gid * WGM;
        u.pm = fm + ((wgid % nig) % WGM); int pn = (wgid % nig) / WGM; u.pn = pn == 16 ? 24 : pn; u.kind = 0; u.nt = 16;
        u.a = A + (size_t)u.pm * 256 * ACOMB_LD * 2; u.b = B + (size_t)u.pn * 256 * 1024 * 2; return true;
    }
};
struct EpiP1 {
    bf16* UA; bf16* UB; float* US;
    __device__ __forceinline__ void operator()(const f32x4 (&acc)[2][2][4][2], const pg8::Unit& u, int wr, int wc, int fr, int fq) const {
        const int row0 = u.pm * 256 + wr * 64 + fr;
        if (u.pn < 16) {
            bf16* base = (u.pn < 8 ? UA + u.pn * 256 : UB + (u.pn - 8) * 256) + wc * 32 + 8 * fq;
#pragma unroll
            for (int ai = 0; ai < 2; ++ai)
#pragma unroll
                for (int m = 0; m < 4; ++m) { bf16* rowp = base + (size_t)(row0 + ai * 128 + m * 16) * U_LD;
#pragma unroll
                    for (int bj = 0; bj < 2; ++bj) { const f32x4 v0 = acc[ai][bj][m][0], v1 = acc[ai][bj][m][1];
                        pg8::u32x4 w; w.x = pg8::cvt_pk_bf16(v0[0], v0[1]); w.y = pg8::cvt_pk_bf16(v0[2], v0[3]); w.z = pg8::cvt_pk_bf16(v1[0], v1[1]); w.w = pg8::cvt_pk_bf16(v1[2], v1[3]);
                        *(pg8::u32x4*)(rowp + bj * 128) = w; } }
        } else {
            float* base = US + wc * 32 + 8 * fq;
#pragma unroll
            for (int ai = 0; ai < 2; ++ai)
#pragma unroll
                for (int m = 0; m < 4; ++m) { float* rowp = base + (size_t)(row0 + ai * 128 + m * 16) * 256;
#pragma unroll
                    for (int bj = 0; bj < 2; ++bj) { *(f32x4*)(rowp + bj * 128) = acc[ai][bj][m][0]; *(f32x4*)(rowp + bj * 128 + 4) = acc[ai][bj][m][1]; } }
        }
    }
};

__device__ __forceinline__ float softplusf_(float x) { return fmaxf(x, 0.f) + log1pf(__expf(-fabsf(x))); }
__device__ __forceinline__ void p2_prep(Frame& F) {
    const int gw = F.vcu * NWAVES + F.wave, lane = F.lane;
    const float* US = (const float*)(F.ws + WS_US);
    const float* mu = F.in[3];
    {
        LAS float* sw = (LAS float*)(F.lds + RING_OFF + F.wave * 4096);
        LAS float* sa = sw + 512;
        const int m0 = 8 * gw;
        const float muw = mu[1536 + lane], mua = mu[1600 + lane];
#pragma unroll
        for (int r = 0; r < 8; ++r) { const int m = m0 + r; const bool first = (m % SEQ) == 0;
            const float cw = US[(size_t)m * 256 + lane], ca = US[(size_t)m * 256 + 64 + lane];
            const float pw = first ? 0.f : US[(size_t)(m - 1) * 256 + lane], pa = first ? 0.f : US[(size_t)(m - 1) * 256 + 64 + lane];
            sw[r * 64 + lane] = tanhf(cw + (pw - cw) * muw); sa[r * 64 + lane] = ca + (pa - ca) * mua; }
        LDS_WAIT(); asm volatile("" ::: "memory");
        float aw[8][8], aa[8][8];
#pragma unroll
        for (int r = 0; r < 8; ++r)
#pragma unroll
            for (int c = 0; c < 8; ++c) { aw[r][c] = 0.f; aa[r][c] = 0.f; }
        const float* wup = F.in[4] + 8 * lane; const float* aup = F.in[6] + 8 * lane;
#pragma unroll 2
        for (int j = 0; j < 64; ++j) {
            const f32x4 w0 = *(const f32x4*)(wup + j * 512), w1 = *(const f32x4*)(wup + j * 512 + 4);
            const f32x4 a0 = *(const f32x4*)(aup + j * 512), a1 = *(const f32x4*)(aup + j * 512 + 4);
#pragma unroll
            for (int r = 0; r < 8; ++r) { const float t = sw[r * 64 + j], d = sa[r * 64 + j];
#pragma unroll
                for (int c = 0; c < 4; ++c) { aw[r][c] += t * w0[c]; aw[r][4 + c] += t * w1[c]; aa[r][c] += d * a0[c]; aa[r][4 + c] += d * a1[c]; } }
        }
        float* DEC = F.out; float* LR = F.out + (size_t)T * 512;
        float w0v[8], a0v[8];
#pragma unroll
        for (int c = 0; c < 8; ++c) { w0v[c] = F.in[5][8 * lane + c]; a0v[c] = F.in[7][8 * lane + c]; }
#pragma unroll
        for (int r = 0; r < 8; ++r) { f32x4 d0, d1, l0, l1;
#pragma unroll
            for (int c = 0; c < 8; ++c) { const float z = w0v[c] + aw[r][c]; const float w = -softplusf_(-z) - 0.5f; const float dec = __expf(-__expf(w)); const float lr = sigmoidf_(a0v[c] + aa[r][c]);
                if (c < 4) { d0[c] = dec; l0[c] = lr; } else { d1[c - 4] = dec; l1[c - 4] = lr; } }
            float* dp = DEC + (size_t)(m0 + r) * 512 + 8 * lane; float* lp = LR + (size_t)(m0 + r) * 512 + 8 * lane;
            *(f32x4*)dp = d0; *(f32x4*)(dp + 4) = d1; *(f32x4*)lp = l0; *(f32x4*)(lp + 4) = l1; }
        LDS_WAIT(); asm volatile("" ::: "memory");
    }
    {
        bf16* UB = (bf16*)(F.ws + WS_UB);
        const int d0 = (lane & 7) * 8;
        float gq[8], gk[8];
#pragma unroll
        for (int e = 0; e < 8; ++e) { gq[e] = F.in[14][d0 + e] * C2; gk[e] = F.in[15][d0 + e]; }
        for (int tsk = gw; tsk < 2 * T; tsk += F.G * NWAVES) {
            const int m = tsk >> 1, which = tsk & 1;
            GAS v4u* p = (GAS v4u*)(UB + (size_t)m * U_LD + which * 512) + lane;
            const v4u w = *p;
            float x[8] = {bflo(w.x), bfhi(w.x), bflo(w.y), bfhi(w.y), bflo(w.z), bfhi(w.z), bflo(w.w), bfhi(w.w)};
            float s = 0.f;
#pragma unroll
            for (int e = 0; e < 8; ++e) s += x[e] * x[e];
            s += __shfl_xor(s, 1); s += __shfl_xor(s, 2); s += __shfl_xor(s, 4);
            const float rs = 1.f / sqrtf(s * (1.f / 64.f) + RMS_EPS);
#pragma unroll
            for (int e = 0; e < 8; ++e) x[e] = x[e] * rs * (which ? gk[e] : gq[e]);
            v4u o; o.x = pk2(x[0], x[1]); o.y = pk2(x[2], x[3]); o.z = pk2(x[4], x[5]); o.w = pk2(x[6], x[7]);
            *p = o;
        }
    }
    if (gw < 64) {
        const int b = gw >> 3, h = gw & 7; const float fb = F.in[13][h];
        float* G2 = (float*)(F.ws + WS_G2) + (size_t)gw * SEQ + 32 * lane;
        float v[32]; float run = 0.f;
#pragma unroll
        for (int i = 0; i < 32; ++i) { const float x = US[(size_t)(b * SEQ + 32 * lane + i) * 256 + 128 + h] + fb; run += -softplusf_(-x) * LOG2E; v[i] = run; }
        float tot = run, ex = run;
#pragma unroll
        for (int o = 1; o < 64; o <<= 1) { const float n = __shfl_up(ex, o); if (lane >= o) ex += n; }
        ex -= tot;
#pragma unroll
        for (int i = 0; i < 32; i += 4) *(f32x4*)(G2 + i) = (f32x4){v[i] + ex, v[i + 1] + ex, v[i + 2] + ex, v[i + 3] + ex};
    }
}
__device__ __forceinline__ int crow(int r, int hi) { return (r & 3) + 8 * (r >> 2) + 4 * hi; }
__device__ __forceinline__ s16x4 vtr(const LAS char* p) { typedef short v4i16_t __attribute__((ext_vector_type(4))); return __builtin_bit_cast(s16x4, __builtin_amdgcn_ds_read_tr16_b64_v4i16((LAS v4i16_t*)p)); }
__device__ __forceinline__ unsigned cvtpk_s(float lo, float hi) { typedef __bf16 bf16x2_t __attribute__((ext_vector_type(2))); f32x2 v = {lo, hi}; bf16x2_t b = __builtin_convertvector(v, bf16x2_t); return __builtin_bit_cast(unsigned, b); }

constexpr int AT_K = 0, AT_V = 8192, AT_BIAS = 16384, AT_WS = 16640, AT_OST = 20480;

__device__ __forceinline__ void attn_unit(Frame& F, int b, int h, int qb) {
    const int tid = F.tid, lane = F.lane, r32 = lane & 31, hi = lane >> 5, wid = F.wave;
    const bf16* UB = (const bf16*)(F.ws + WS_UB);
    const float* G2 = (const float*)(F.ws + WS_G2) + (size_t)(b * NH + h) * SEQ;
    bf16* Acomb = (bf16*)(F.ws + WS_ACOMB);
    LAS char* lds = (LAS char*)F.lds;
    const long rowbase = (long)b * SEQ; const int q0 = qb * 256; const int qrow = q0 + wid * 32 + r32;
    const bf16* Qw = UB + (rowbase + q0 + wid * 32) * U_LD + h * 64;
    bf16x8 qr[4];
#pragma unroll
    for (int d0 = 0; d0 < 4; ++d0) qr[d0] = *(const bf16x8*)(Qw + (long)r32 * U_LD + d0 * 16 + hi * 8);
    const float gq = G2[qrow];
    float m_run = -1e30f, l_run = 0.f; f32x16 o[2]; o[0] = f32x16{}; o[1] = f32x16{};
    LAS float* wsf = (LAS float*)(lds + AT_WS) + wid * 64;
    LAS float* biasl = (LAS float*)(lds + AT_BIAS);
    const int NT = (q0 + 256) / 64;
    const int kvl = tid >> 3, ch = tid & 7;
    const LAS char* kp0 = lds + AT_K + hi * 1024 + r32 * 16;
    const LAS char* vp0 = lds + AT_V + ((lane >> 4) & 1) * 32 + (lane & 3) * 8 + (4 * hi + ((lane & 15) >> 2)) * 64;
    for (int t = 0; t < NT; ++t) {
        __syncthreads();
        { const bf16* src = UB + (rowbase + 64 * t + kvl) * U_LD + h * 64 + 8 * ch;
          const v4u kx = *(const v4u*)(src + 512), vx = *(const v4u*)(src + 1024);
          *(LAS v4u*)(lds + AT_K + ch * 1024 + kvl * 16) = kx;
          *(LAS v4u*)(lds + AT_V + (ch >> 2) * 4096 + kvl * 64 + (ch & 3) * 16) = vx;
          if (tid < 64) biasl[tid] = G2[64 * t + tid]; }
        __syncthreads();
        if (64 * t > q0 + wid * 32 + 31) continue;
        f32x16 p0 = f32x16{}, p1 = f32x16{};
#pragma unroll
        for (int d0 = 0; d0 < 4; ++d0) {
            const bf16x8 b0 = *(const LAS bf16x8*)(kp0 + d0 * 2048), b1 = *(const LAS bf16x8*)(kp0 + d0 * 2048 + 512);
            p0 = __builtin_amdgcn_mfma_f32_32x32x16_bf16(b0, qr[d0], p0, 0, 0, 0);
            p1 = __builtin_amdgcn_mfma_f32_32x32x16_bf16(b1, qr[d0], p1, 0, 0, 0);
        }
        float rm = -INFINITY;
#pragma unroll
        for (int g4 = 0; g4 < 4; ++g4) {
            const f32x4 gk0 = *(const LAS f32x4*)(biasl + 8 * g4 + 4 * hi), gk1 = *(const LAS f32x4*)(biasl + 32 + 8 * g4 + 4 * hi);
#pragma unroll
            for (int i = 0; i < 4; ++i) { const int r = 4 * g4 + i; const int key = 64 * t + crow(r, hi);
                float x0 = p0[r] + (gq - gk0[i]), x1 = p1[r] + (gq - gk1[i]);
                if (key > qrow) x0 = -INFINITY; if (key + 32 > qrow) x1 = -INFINITY;
                p0[r] = x0; p1[r] = x1; rm = fmaxf(rm, fmaxf(x0, x1)); }
        }
        { auto rr = __builtin_amdgcn_permlane32_swap(__float_as_uint(rm), __float_as_uint(rm), false, false); rm = fmaxf(__uint_as_float(rr[0]), __uint_as_float(rr[1])); }
        const float m_new = fmaxf(m_run, rm);
        const float alpha = __builtin_amdgcn_exp2f(m_run - m_new);
        m_run = m_new;
        float ls = 0.f;
#pragma unroll
        for (int r = 0; r < 16; ++r) { p0[r] = __builtin_amdgcn_exp2f(p0[r] - m_new); p1[r] = __builtin_amdgcn_exp2f(p1[r] - m_new); ls += p0[r] + p1[r]; }
        l_run = l_run * alpha + ls;
        if (hi == 0) wsf[r32] = alpha;
        v4u pw0, pw1, pw2, pw3;
        pw0 = (v4u){cvtpk_s(p0[0], p0[1]), cvtpk_s(p0[2], p0[3]), cvtpk_s(p0[4], p0[5]), cvtpk_s(p0[6], p0[7])};
        pw1 = (v4u){cvtpk_s(p0[8], p0[9]), cvtpk_s(p0[10], p0[11]), cvtpk_s(p0[12], p0[13]), cvtpk_s(p0[14], p0[15])};
        pw2 = (v4u){cvtpk_s(p1[0], p1[1]), cvtpk_s(p1[2], p1[3]), cvtpk_s(p1[4], p1[5]), cvtpk_s(p1[6], p1[7])};
        pw3 = (v4u){cvtpk_s(p1[8], p1[9]), cvtpk_s(p1[10], p1[11]), cvtpk_s(p1[12], p1[13]), cvtpk_s(p1[14], p1[15])};
        LDS_WAIT();
#pragma unroll
        for (int r = 0; r < 16; ++r) { const float a = wsf[crow(r, hi)]; o[0][r] *= a; o[1][r] *= a; }
#pragma unroll
        for (int d0 = 0; d0 < 2; ++d0) {
#define AT_PV(ks, PW) { const s16x4 lo = vtr(vp0 + d0 * 4096 + ks * 1024), hh = vtr(vp0 + d0 * 4096 + ks * 1024 + 512); \
              const bf16x8 vf = (bf16x8){lo[0], lo[1], lo[2], lo[3], hh[0], hh[1], hh[2], hh[3]}; \
              o[d0] = __builtin_amdgcn_mfma_f32_32x32x16_bf16(__builtin_bit_cast(bf16x8, PW), vf, o[d0], 0, 0, 0); }
            AT_PV(0, pw0) AT_PV(1, pw1) AT_PV(2, pw2) AT_PV(3, pw3)
#undef AT_PV
        }
    }
    { auto rr = __builtin_amdgcn_permlane32_swap(__float_as_uint(l_run), __float_as_uint(l_run), false, false); l_run = __uint_as_float(rr[0]) + __uint_as_float(rr[1]); }
    if (hi == 0) wsf[32 + r32] = l_run;
    LDS_WAIT();
    bf16* stg = (bf16*)(F.lds + AT_OST) + wid * 2048;
    LAS bf16* stgl = (LAS bf16*)(lds + AT_OST) + wid * 2048;
#pragma unroll
    for (int r = 0; r < 16; ++r) { const int orow = crow(r, hi); const float rl = 1.0f / wsf[32 + orow];
#pragma unroll
        for (int d0 = 0; d0 < 2; ++d0) stgl[orow * 64 + d0 * 32 + r32] = (bf16)f2bf(o[d0][r] * rl); }
    LDS_WAIT();
    (void)stg;
#pragma unroll
    for (int i = 0; i < 4; ++i) { const int row = i * 8 + (lane >> 3), c8 = lane & 7;
        const v4u v = *(const LAS v4u*)(stgl + row * 64 + c8 * 8);
        const long grow = rowbase + q0 + wid * 32 + row;
        const v4u gt = *(const v4u*)(UB + grow * U_LD + 1536 + h * 64 + c8 * 8);
        v4u ov;
        ov.x = pk2(bflo(v.x) * siluf_(bflo(gt.x)), bfhi(v.x) * siluf_(bfhi(gt.x)));
        ov.y = pk2(bflo(v.y) * siluf_(bflo(gt.y)), bfhi(v.y) * siluf_(bfhi(gt.y)));
        ov.z = pk2(bflo(v.z) * siluf_(bflo(gt.z)), bfhi(v.z) * siluf_(bfhi(gt.z)));
        ov.w = pk2(bflo(v.w) * siluf_(bflo(gt.w)), bfhi(v.w) * siluf_(bfhi(gt.w)));
        *(v4u*)(Acomb + grow * ACOMB_LD + ZB_OFF + h * 64 + c8 * 8) = ov; }
}
__device__ __forceinline__ void p3_attention(Frame& F) {
    const int bh = F.vcu >> 2, s = F.vcu & 3;
    attn_unit(F, bh >> 3, bh & 7, s);
    __syncthreads();
    attn_unit(F, bh >> 3, bh & 7, 7 - s);
}
template <int Q> __device__ __forceinline__ float bcq(float x) { return __builtin_bit_cast(float, __builtin_amdgcn_mov_dpp(__builtin_bit_cast(int, x), 0x150 + Q, 0xf, 0xf, true)); }

__device__ __forceinline__ void p4_scan_a(Frame& F) {
    const int lane = F.lane, q16 = lane & 15;
    const int id = F.vcu * NWAVES + F.wave;
    const int b = id >> 8, h = (id >> 5) & 7, c = id & 31;
    const bf16* UA = (const bf16*)(F.ws + WS_UA);
    const float* DEC = F.out; const float* LR = F.out + (size_t)T * 512;
    float* Gm = (float*)(F.ws + WS_UB); float* Hm = Gm + (size_t)2048 * 4096;
    bf16* Rbar = (bf16*)(F.ws + WS_US); bf16* Yloc = (bf16*)(F.ws + WS_YLOC);
    float* BON = (float*)(F.ws + WS_BONUS);
    const float* mu = F.in[3];
    const int ch0 = h * 64 + 4 * q16;
    f32x4 mu_r = *(const f32x4*)(mu + ch0), mu_k = *(const f32x4*)(mu + 512 + ch0), kkc = *(const f32x4*)(F.in[8] + ch0), kac = *(const f32x4*)(F.in[9] + ch0), rkc = *(const f32x4*)(F.in[10] + ch0);
    const float mu_v = mu[1024 + h * 64 + lane];
    const long m0 = (long)b * SEQ + c * 64;
    float sL[64], sG[64];
#pragma unroll
    for (int j = 0; j < 64; ++j) { sL[j] = 0.f; sG[j] = (j == lane) ? 1.f : 0.f; }
    f32x4 pr = {0.f, 0.f, 0.f, 0.f}, pk = {0.f, 0.f, 0.f, 0.f}; float pv = 0.f;
    if (c > 0) { const bf16* up = UA + (m0 - 1) * U_LD; const v2u a = *(const v2u*)(up + ch0), k = *(const v2u*)(up + 512 + ch0);
        pr = (f32x4){bflo(a.x), bfhi(a.x), bflo(a.y), bfhi(a.y)}; pk = (f32x4){bflo(k.x), bfhi(k.x), bflo(k.y), bfhi(k.y)}; pv = bf2f(up[1024 + h * 64 + lane]); }
    for (int t = 0; t < 64; ++t) {
        const long m = m0 + t;
        const bf16* up = UA + m * U_LD;
        const v2u ua = *(const v2u*)(up + ch0), uk = *(const v2u*)(up + 512 + ch0);
        const float cv = bf2f(up[1024 + h * 64 + lane]);
        const f32x4 lr = *(const f32x4*)(LR + m * 512 + ch0), wv = *(const f32x4*)(DEC + m * 512 + ch0);
        const f32x4 cr = (f32x4){bflo(ua.x), bfhi(ua.x), bflo(ua.y), bfhi(ua.y)}, ck = (f32x4){bflo(uk.x), bfhi(uk.x), bflo(uk.y), bfhi(uk.y)};
        f32x4 rv, kx, av, bv, km;
        float ss = 0.f, bon = 0.f;
#pragma unroll
        for (int e = 0; e < 4; ++e) { rv[e] = cr[e] + (pr[e] - cr[e]) * mu_r[e]; kx[e] = ck[e] + (pk[e] - ck[e]) * mu_k[e]; const float kk = kx[e] * kkc[e]; av[e] = kk; ss += kk * kk; }
        ss = row16_sum(ss);
        const float inv = 1.0f / fmaxf(sqrtf(ss), 1e-12f);
#pragma unroll
        for (int e = 0; e < 4; ++e) { av[e] = -av[e] * inv; bv[e] = -av[e] * lr[e]; km[e] = kx[e] * (1.0f + (lr[e] - 1.0f) * kac[e]); bon += rv[e] * km[e] * rkc[e]; }
        bon = row16_sum(bon);
        const float vi = cv + (pv - cv) * mu_v;
        pr = cr; pk = ck; pv = cv;
        if (lane == 0) BON[m * 8 + h] = bon;
        float saL0 = 0.f, saL1 = 0.f, saG0 = 0.f, saG1 = 0.f;
#define SA_BLK(Q) { const float a0 = bcq<Q>(av[0]), a1 = bcq<Q>(av[1]), a2 = bcq<Q>(av[2]), a3 = bcq<Q>(av[3]); \
            saL0 = fmaf(sL[4 * Q], a0, saL0); saG0 = fmaf(sG[4 * Q], a0, saG0); saL1 = fmaf(sL[4 * Q + 1], a1, saL1); saG1 = fmaf(sG[4 * Q + 1], a1, saG1); \
            saL0 = fmaf(sL[4 * Q + 2], a2, saL0); saG0 = fmaf(sG[4 * Q + 2], a2, saG0); saL1 = fmaf(sL[4 * Q + 3], a3, saL1); saG1 = fmaf(sG[4 * Q + 3], a3, saG1); }
        SA_BLK(0) SA_BLK(1) SA_BLK(2) SA_BLK(3) SA_BLK(4) SA_BLK(5) SA_BLK(6) SA_BLK(7) SA_BLK(8) SA_BLK(9) SA_BLK(10) SA_BLK(11) SA_BLK(12) SA_BLK(13) SA_BLK(14) SA_BLK(15)
#undef SA_BLK
        const float saL = saL0 + saL1, saG = saG0 + saG1;
        float yL0 = 0.f, yL1 = 0.f, yG0 = 0.f, yG1 = 0.f;
#define UP_ONE(Q, E, YL, YG) { const float w_ = bcq<Q>(wv[E]), b_ = bcq<Q>(bv[E]), k_ = bcq<Q>(km[E]), r_ = bcq<Q>(rv[E]); \
            sL[4 * Q + E] = fmaf(sL[4 * Q + E], w_, fmaf(saL, b_, vi * k_)); sG[4 * Q + E] = fmaf(sG[4 * Q + E], w_, saG * b_); \
            YL = fmaf(sL[4 * Q + E], r_, YL); YG = fmaf(sG[4 * Q + E], r_, YG); }
#define UP_BLK(Q) UP_ONE(Q, 0, yL0, yG0) UP_ONE(Q, 1, yL1, yG1) UP_ONE(Q, 2, yL0, yG0) UP_ONE(Q, 3, yL1, yG1)
        UP_BLK(0) UP_BLK(1) UP_BLK(2) UP_BLK(3) UP_BLK(4) UP_BLK(5) UP_BLK(6) UP_BLK(7) UP_BLK(8) UP_BLK(9) UP_BLK(10) UP_BLK(11) UP_BLK(12) UP_BLK(13) UP_BLK(14) UP_BLK(15)
#undef UP_BLK
#undef UP_ONE
        Yloc[m * 512 + h * 64 + lane] = (bf16)f2bf(yL0 + yL1);
        Rbar[m * 512 + h * 64 + lane] = (bf16)f2bf(yG0 + yG1);
    }
    float* hp = Hm + (size_t)id * 4096 + lane * 64; float* gp = Gm + (size_t)id * 4096 + lane * 64;
#pragma unroll
    for (int j = 0; j < 64; j += 4) { *(f32x4*)(hp + j) = (f32x4){sL[j], sL[j + 1], sL[j + 2], sL[j + 3]}; *(f32x4*)(gp + j) = (f32x4){sG[j], sG[j + 1], sG[j + 2], sG[j + 3]}; }
}

__device__ __forceinline__ void p5_scan_b(Frame& F) {
    const int bh = F.vcu >> 2, i0 = (F.vcu & 3) * 16, tid = F.tid;
    const float* Gm = (const float*)(F.ws + WS_UB); const float* Hm = Gm + (size_t)2048 * 4096;
    float* Sst = F.out;
    LAS float* Ss = (LAS float*)(F.lds + RING_OFF);
    LAS float* Gs = Ss + 1024;
    const int i = tid >> 5, jq = tid & 31;
    float s0 = 0.f, s1 = 0.f;
    const int id0 = ((bh >> 3) << 8) | ((bh & 7) << 5);
    for (int c = 0; c < 32; ++c) {
        const size_t base = (size_t)(id0 + c) * 4096;
        *(f32x2*)(Sst + base + (size_t)(i0 + i) * 64 + 2 * jq) = (f32x2){s0, s1};
        if (c == 31) break;
        *(LAS f32x2*)(Ss + i * 64 + 2 * jq) = (f32x2){s0, s1};
#pragma unroll
        for (int k = 0; k < 2; ++k) *(LAS f32x4*)(Gs + (k * 512 + tid) * 4) = *(const f32x4*)(Gm + base + (size_t)(k * 512 + tid) * 4);
        const f32x2 hv = *(const f32x2*)(Hm + base + (size_t)(i0 + i) * 64 + 2 * jq);
        __syncthreads();
        float a0 = hv.x, a1 = hv.y;
#pragma unroll 16
        for (int m = 0; m < 64; ++m) { const float sv = Ss[i * 64 + m]; const f32x2 g = *(const LAS f32x2*)(Gs + m * 64 + 2 * jq); a0 = fmaf(sv, g.x, a0); a1 = fmaf(sv, g.y, a1); }
        s0 = a0; s1 = a1;
        __syncthreads();
    }
}

__device__ __forceinline__ void p6_scan_c(Frame& F) {
    const int lane = F.lane, fr = lane & 15, fq = lane >> 4;
    const int id = F.vcu * NWAVES + F.wave;
    const int b = id >> 8, h = (id >> 5) & 7, c = id & 31;
    const bf16* UA = (const bf16*)(F.ws + WS_UA);
    const bf16* Rbar = (const bf16*)(F.ws + WS_US); const bf16* Yloc = (const bf16*)(F.ws + WS_YLOC);
    const float* BON = (const float*)(F.ws + WS_BONUS);
    const float* Sst = F.out + (size_t)id * 4096;
    bf16* Acomb = (bf16*)(F.ws + WS_ACOMB);
    const float* mu = F.in[3];
    const long m0 = (long)b * SEQ + c * 64;
    bf16x8 bfr[4][2];
#pragma unroll
    for (int it = 0; it < 4; ++it)
#pragma unroll
        for (int ks = 0; ks < 2; ++ks) { const float* p = Sst + (16 * it + fr) * 64 + 32 * ks + 8 * fq; const f32x4 x0 = *(const f32x4*)p, x1 = *(const f32x4*)(p + 4);
            v4u w; w.x = pk2(x0[0], x0[1]); w.y = pk2(x0[2], x0[3]); w.z = pk2(x1[0], x1[1]); w.w = pk2(x1[2], x1[3]); bfr[it][ks] = __builtin_bit_cast(bf16x8, w); }
    float lw[4], lb[4], muv[4], mug[4];
#pragma unroll
    for (int it = 0; it < 4; ++it) { const int ch = h * 64 + 16 * it + fr; lw[it] = F.in[11][ch]; lb[it] = F.in[12][ch]; muv[it] = mu[1024 + ch]; mug[it] = mu[1664 + ch]; }
#pragma unroll 1
    for (int tt = 0; tt < 4; ++tt) {
        f32x4 acc[4];
        bf16x8 afr[2];
#pragma unroll
        for (int ks = 0; ks < 2; ++ks) afr[ks] = *(const bf16x8*)(Rbar + (m0 + 16 * tt + fr) * 512 + h * 64 + 32 * ks + 8 * fq);
#pragma unroll
        for (int it = 0; it < 4; ++it) { acc[it] = (f32x4){0.f, 0.f, 0.f, 0.f};
#pragma unroll
            for (int ks = 0; ks < 2; ++ks) acc[it] = __builtin_amdgcn_mfma_f32_16x16x32_bf16(afr[ks], bfr[it][ks], acc[it], 0, 0, 0); }
#pragma unroll
        for (int rg = 0; rg < 4; ++rg) {
            const long m = m0 + 16 * tt + 4 * fq + rg; const bool first = (m % SEQ) == 0;
            float y[4]; float s = 0.f;
#pragma unroll
            for (int it = 0; it < 4; ++it) { y[it] = acc[it][rg] + bf2f(Yloc[m * 512 + h * 64 + 16 * it + fr]); s += y[it]; }
            const float mean = row16_sum(s) * (1.f / 64.f); float q = 0.f;
#pragma unroll
            for (int it = 0; it < 4; ++it) { y[it] -= mean; q += y[it] * y[it]; }
            const float rstd = 1.0f / sqrtf(row16_sum(q) * (1.f / 64.f) + LNX_EPS);
            const float bs = BON[m * 8 + h];
#pragma unroll
            for (int it = 0; it < 4; ++it) { const int ch = h * 64 + 16 * it + fr;
                const float cv = bf2f(UA[m * U_LD + 1024 + ch]), cg = bf2f(UA[m * U_LD + 1536 + ch]);
                const float pv = first ? 0.f : bf2f(UA[(m - 1) * U_LD + 1024 + ch]), pg = first ? 0.f : bf2f(UA[(m - 1) * U_LD + 1536 + ch]);
                const float vv = cv + (pv - cv) * muv[it], gg = cg + (pg - cg) * mug[it];
                const float z = (y[it] * rstd * lw[it] + lb[it] + bs * vv) * siluf_(gg);
                Acomb[m * ACOMB_LD + ZA_OFF + ch] = (bf16)f2bf(z); }
        }
    }
}
struct SchedP7 {
    int pm, pn; const char* Acomb; const char* WinT; const char* Wab;
    __device__ __forceinline__ bool next(int i, pg8::Unit& u) const {
        if (i >= 4) return false;
        u.pm = pm; u.pn = pn; u.kind = i;
        const char* arow = Acomb + (size_t)pm * 256 * ACOMB_LD * 2;
        if (i == 0)      { u.nt = 16; u.a = arow;                 u.b = WinT + (size_t)(4096 + pn * 256) * 1024 * 2; }
        else if (i == 1) { u.nt = 8;  u.a = arow + ZA_OFF * 2;    u.b = Wab + (size_t)(pn * 256) * 1024 * 2; }
        else if (i == 2) { u.nt = 16; u.a = arow;                 u.b = WinT + (size_t)(5120 + pn * 256) * 1024 * 2; }
        else             { u.nt = 8;  u.a = arow + ZB_OFF * 2;    u.b = Wab + (size_t)(pn * 256) * 1024 * 2 + 512 * 2; }
        return true;
    }
};
struct EpiP7 {
    f32x4* SG; f32x4* TMP; bf16* merged;
    __device__ __forceinline__ void operator()(const f32x4 (&acc)[2][2][4][2], const pg8::Unit& u, int wr, int wc, int fr, int fq) const {
        const int tid = threadIdx.x;
        f32x4* SG = this->SG; f32x4* TMP = this->TMP;
        asm volatile("" : "+s"(SG), "+s"(TMP));
        if (u.kind == 0 || u.kind == 2) {
#pragma unroll
            for (int ai = 0; ai < 2; ++ai)
#pragma unroll
                for (int bj = 0; bj < 2; ++bj)
#pragma unroll
                    for (int m = 0; m < 4; ++m)
#pragma unroll
                        for (int n = 0; n < 2; ++n) { const f32x4 v = acc[ai][bj][m][n]; f32x4* p = SG + (((((ai * 2 + bj) * 4 + m) * 2 + n)) << 9);
                            p[tid] = (f32x4){sigmoidf_(v[0]), sigmoidf_(v[1]), sigmoidf_(v[2]), sigmoidf_(v[3])}; asm volatile("" ::: "memory"); }
        } else if (u.kind == 1) {
#pragma unroll
            for (int ai = 0; ai < 2; ++ai)
#pragma unroll
                for (int bj = 0; bj < 2; ++bj)
#pragma unroll
                    for (int m = 0; m < 4; ++m)
#pragma unroll
                        for (int n = 0; n < 2; ++n) { const int ix = ((((ai * 2 + bj) * 4 + m) * 2 + n) << 9); const f32x4* ps = SG + ix; f32x4* pt = TMP + ix; pt[tid] = ps[tid] * acc[ai][bj][m][n]; if (n == 1) asm volatile("" ::: "memory"); }
        } else {
            const int row0 = u.pm * 256 + wr * 64 + fr; bf16* base = merged + u.pn * 256 + wc * 32 + 8 * fq;
#pragma unroll
            for (int ai = 0; ai < 2; ++ai)
#pragma unroll
                for (int m = 0; m < 4; ++m) { bf16* rowp = base + (size_t)(row0 + ai * 128 + m * 16) * 1024;
#pragma unroll
                    for (int bj = 0; bj < 2; ++bj) { const int ix = (((ai * 2 + bj) * 4 + m) * 2) << 9; const f32x4* ps = SG + ix; const f32x4* pt = TMP + ix;
                        const f32x4 v0 = pt[tid] + ps[tid] * acc[ai][bj][m][0], v1 = pt[512 + tid] + ps[512 + tid] * acc[ai][bj][m][1];
                        pg8::u32x4 w; w.x = pg8::cvt_pk_bf16(v0[0], v0[1]); w.y = pg8::cvt_pk_bf16(v0[2], v0[3]); w.z = pg8::cvt_pk_bf16(v1[0], v1[1]); w.w = pg8::cvt_pk_bf16(v1[2], v1[3]);
                        *(pg8::u32x4*)(rowp + bj * 128) = w; asm volatile("" ::: "memory"); } }
        }
    }
};
struct SchedP8 {
    int pm, pn; const char* A; const char* B;
    __device__ __forceinline__ bool next(int i, pg8::Unit& u) const {
        if (i >= 1) return false;
        u.pm = pm; u.pn = pn; u.kind = 0; u.nt = 16; u.a = A + (size_t)pm * 256 * 1024 * 2; u.b = B + (size_t)pn * 256 * 1024 * 2; return true;
    }
};
struct EpiP8 {
    const float* x; float* out;
    __device__ __forceinline__ void operator()(const f32x4 (&acc)[2][2][4][2], const pg8::Unit& u, int wr, int wc, int fr, int fq) const {
        const int row0 = u.pm * 256 + wr * 64 + fr; const int col0 = u.pn * 256 + wc * 32 + 8 * fq;
#pragma unroll
        for (int ai = 0; ai < 2; ++ai)
#pragma unroll
            for (int m = 0; m < 4; ++m) { const size_t off = (size_t)(row0 + ai * 128 + m * 16) * DM + col0;
#pragma unroll
                for (int bj = 0; bj < 2; ++bj) { const f32x4 x0 = *(const f32x4*)(x + off + bj * 128), x1 = *(const f32x4*)(x + off + bj * 128 + 4);
                    *(f32x4*)(out + off + bj * 128) = x0 + acc[ai][bj][m][0]; *(f32x4*)(out + off + bj * 128 + 4) = x1 + acc[ai][bj][m][1]; } }
    }
};
__device__ __forceinline__ void p9_final_norm(Frame& F) {
    const int gw = F.vcu * NWAVES + F.wave, NGW = F.G * NWAVES;
    const GAS f32x4* gp = (const GAS f32x4*)F.in[19] + F.lane;
    f32x4 g[4];
#pragma unroll
    for (int j = 0; j < 4; ++j) g[j] = gp[64 * j];
    for (int m = gw; m < T; m += NGW) {
        GAS f32x4* xr = (GAS f32x4*)(F.out + (size_t)m * DM) + F.lane;
        f32x4 v[4]; float s = 0.f;
#pragma unroll
        for (int j = 0; j < 4; ++j) { v[j] = xr[64 * j]; s += (v[j].x * v[j].x + v[j].y * v[j].y) + (v[j].z * v[j].z + v[j].w * v[j].w); }
        const float rstd = 1.f / sqrtf(wave_sum(s) * (1.f / DM) + RMS_EPS);
#pragma unroll
        for (int j = 0; j < 4; ++j) xr[64 * j] = v[j] * rstd * g[j];
    }
}

constexpr int N_PHASES = 10;
struct Args { const float* in[20]; float* out; unsigned char* ws; int ph_lo, ph_hi; };
__global__ void __launch_bounds__(NWAVES * 64, 2) hybrid_fwd(Args args) {
    extern __shared__ __attribute__((aligned(16))) unsigned char lds[];
    Frame F;
    F.lds = (LAS unsigned char*)lds;
    F.MISC = (volatile LAS unsigned*)(F.lds + MISC_OFF);
    F.tid = threadIdx.x; F.lane = F.tid & 63; F.wave = __builtin_amdgcn_readfirstlane(F.tid >> 6);
    F.G = gridDim.x; { const int bx = blockIdx.x; F.vcu = (bx % 8) * (F.G / 8) + bx / 8; }
#pragma unroll
    for (int i = 0; i < 20; ++i) F.in[i] = args.in[i];
    F.out = args.out; F.ws = args.ws;
    unsigned char* ws = args.ws;
    for (int u = F.tid; u < (LDS_BYTES - LDSCTL_OFF) / 4; u += NWAVES * 64) ((LAS unsigned*)(F.lds + LDSCTL_OFF))[u] = 0u;
    __syncthreads();
    const int lo = args.ph_lo, hi = args.ph_hi;
    const bool multi = (hi - lo) > 1;
    XcdBarrier bar; bar.bar = (unsigned*)(ws + WS_CTL) + CW_BAR; bar.x = 0; bar.st = nullptr;
    if (multi) bar = xcd_barrier_post((unsigned*)(ws + WS_CTL) + CW_BAR, F.MISC + 8);
#ifndef PH_MASK
#define PH_MASK 0x3ff
#endif
#define IN(k) (((PH_MASK >> (k)) & 1) && lo <= (k) && (k) < hi)
#define SEAM(k) do { if (IN(k) && IN((k) + 1)) xcd_barrier(bar); } while (0)
    if (IN(0)) { p0_prologue(F); SEAM(0); }
    if (IN(1)) {
        SchedP1 S{(int)blockIdx.x, F.G, (const char*)(ws + WS_ACOMB), (const char*)(ws + WS_WINT)};
        EpiP1 E{(bf16*)(ws + WS_UA), (bf16*)(ws + WS_UB), (float*)(ws + WS_US)};
        pg8::gemm_phase(F.lds + RING_OFF, ACOMB_LD, 1024, S, E);
        SEAM(1);
    }
    if (IN(2)) { p2_prep(F); SEAM(2); }
    if (IN(3)) { p3_attention(F); SEAM(3); }
    if (IN(4)) { p4_scan_a(F); SEAM(4); }
    if (IN(5)) { p5_scan_b(F); SEAM(5); }
    if (IN(6)) { p6_scan_c(F); SEAM(6); }
    const int pm = F.vcu >> 2, pn = F.vcu & 3;
    if (IN(7)) {
        SchedP7 S{pm, pn, (const char*)(ws + WS_ACOMB), (const char*)(ws + WS_WINT), (const char*)(ws + WS_WAB)};
        EpiP7 E{(f32x4*)(ws + WS_UA) + (size_t)blockIdx.x * 16384, (f32x4*)(ws + WS_UB) + (size_t)blockIdx.x * 16384, (bf16*)(ws + WS_MERGED)};
        pg8::gemm_phase(F.lds + RING_OFF, ACOMB_LD, 1024, S, E);
        SEAM(7);
    }
    if (IN(8)) {
        SchedP8 S{pm, pn, (const char*)(ws + WS_MERGED), (const char*)(ws + WS_WOUT)};
        EpiP8 E{F.in[0], F.out};
        pg8::gemm_phase(F.lds + RING_OFF, 1024, 1024, S, E);
        SEAM(8);
    }
    if (IN(9)) { p9_final_norm(F); }
#undef IN
#undef SEAM
}

#ifndef MK_N_LAUNCHES
#define MK_N_LAUNCHES 1
#endif
extern "C" void kernel_launch(void* const* d_in, const int* in_sizes, int n_in, void* d_out, int out_size, void* d_ws, size_t ws_size, hipStream_t stream) {
    static int grid = 0;
    if (grid == 0) {
        if (n_in != 20 || in_sizes[0] != T * DM || out_size != T * DM || ws_size < WS_END) { fprintf(stderr, "kernel_launch: unexpected shapes (n_in %d, in0 %d, out %d, ws %zu); nothing launched\n", n_in, n_in > 0 ? in_sizes[0] : -1, out_size, ws_size); grid = -1; return; }
        int dev = 0, cus = 0, per_cu = 0;
        if (hipGetDevice(&dev) != hipSuccess || hipDeviceGetAttribute(&cus, hipDeviceAttributeMultiprocessorCount, dev) != hipSuccess) { grid = -1; return; }
        if (hipFuncSetAttribute((const void*)hybrid_fwd, hipFuncAttributeMaxDynamicSharedMemorySize, LDS_BYTES) != hipSuccess) { fprintf(stderr, "kernel_launch: hipFuncSetAttribute failed\n"); grid = -1; return; }
        if (hipOccupancyMaxActiveBlocksPerMultiprocessor(&per_cu, (const void*)hybrid_fwd, NWAVES * 64, LDS_BYTES) != hipSuccess || per_cu < 1) fprintf(stderr, "kernel_launch: note: occupancy query reports %d workgroups per CU\n", per_cu);
        (void)hipGetLastError();
        grid = 256;
        if (cus != 256) fprintf(stderr, "kernel_launch: device reports %d CUs; this kernel is built for 256\n", cus);
    }
    if (grid < 0) return;
    (void)hipMemsetAsync((char*)d_ws + WS_CTL, 0, CTL_ZERO_BYTES, stream);
    Args a{};
    for (int i = 0; i < 20; ++i) a.in[i] = (const float*)d_in[i];
    a.out = (float*)d_out; a.ws = (unsigned char*)d_ws;
    if (MK_N_LAUNCHES == 1) { a.ph_lo = 0; a.ph_hi = N_PHASES; hipLaunchKernelGGL(hybrid_fwd, dim3(grid), dim3(NWAVES * 64), LDS_BYTES, stream, a); }
    else for (int p = 0; p < N_PHASES; ++p) { a.ph_lo = p; a.ph_hi = p + 1; hipLaunchKernelGGL(hybrid_fwd, dim3(grid), dim3(NWAVES * 64), LDS_BYTES, stream, a); }
}
```

```cpp
#include <hip/hip_runtime.h>
#include <hip/hip_bf16.h>
#include <cstdio>
#include <cstdint>
#include <cmath>

#define GAS __attribute__((address_space(1)))
#define LAS __attribute__((address_space(3)))
typedef unsigned short bf16;
typedef unsigned v4u __attribute__((ext_vector_type(4)));
typedef unsigned v2u __attribute__((ext_vector_type(2)));
typedef float f32x2 __attribute__((ext_vector_type(2)));
typedef float f32x4 __attribute__((ext_vector_type(4)));
typedef float f32x16 __attribute__((ext_vector_type(16)));
typedef short bf16x8 __attribute__((ext_vector_type(8)));
typedef short s16x4 __attribute__((ext_vector_type(4)));

constexpr int NB = 8, SEQ = 2048, DM = 1024, T = NB * SEQ, NH = 8, HD = 64;
constexpr int IN_COLS = 6280, NPAD = 6400;
constexpr float RMS_EPS = 1e-6f, LNX_EPS = 64e-5f;
constexpr float LOG2E = 1.4426950408889634f;
constexpr float C2 = 0.125f * LOG2E;

constexpr size_t MiB = 1u << 20;
constexpr size_t WS_CTL = 0, CTL_ZERO_BYTES = 64 * 1024;
constexpr size_t WS_WINT = 1 * MiB;
constexpr size_t WS_WAB = 14 * MiB;
constexpr size_t WS_WOUT = 16 * MiB;
constexpr size_t WS_G2 = 19 * MiB;
constexpr size_t WS_BONUS = 19 * MiB + 512 * 1024;
constexpr size_t WS_ACOMB = 20 * MiB;
constexpr size_t WS_UA = 84 * MiB;
constexpr size_t WS_UB = 148 * MiB;
constexpr size_t WS_US = 212 * MiB;
constexpr size_t WS_YLOC = 228 * MiB;
constexpr size_t WS_MERGED = 212 * MiB;
constexpr size_t WS_END = 256 * MiB;
constexpr int ACOMB_LD = 2048, U_LD = 2048;
constexpr int ZA_OFF = 1024, ZB_OFF = 1536;

#define RLX_AGENT __ATOMIC_RELAXED, __HIP_MEMORY_SCOPE_AGENT
#define LDS_WAIT() asm volatile("s_waitcnt lgkmcnt(0)" ::: "memory")
#define VM_WAIT() asm volatile("s_waitcnt vmcnt(0)" ::: "memory")

__device__ __forceinline__ unsigned f2bf(float f) { unsigned u = __builtin_bit_cast(unsigned, f); return (u + 0x7fffu + ((u >> 16) & 1u)) >> 16; }
__device__ __forceinline__ unsigned pk2(float lo, float hi) { return f2bf(lo) | (f2bf(hi) << 16); }
__device__ __forceinline__ float bf2f(unsigned b) { return __builtin_bit_cast(float, b << 16); }
__device__ __forceinline__ float bflo(unsigned w) { return __builtin_bit_cast(float, w << 16); }
__device__ __forceinline__ float bfhi(unsigned w) { return __builtin_bit_cast(float, w & 0xffff0000u); }
__device__ __forceinline__ float sigmoidf_(float x) { return 1.0f / (1.0f + __expf(-x)); }
__device__ __forceinline__ float siluf_(float x) { return x / (1.0f + __expf(-x)); }
__device__ __forceinline__ float wave_sum(float v) {
#pragma unroll
    for (int o = 1; o < 64; o <<= 1) v += __shfl_xor(v, o);
    return v;
}
template <int CTRL> __device__ __forceinline__ float dppf(float x) { return __builtin_bit_cast(float, __builtin_amdgcn_mov_dpp(__builtin_bit_cast(int, x), CTRL, 0xf, 0xf, true)); }
__device__ __forceinline__ float row16_sum(float v) { v += dppf<0x128>(v); v += dppf<0x124>(v); v += dppf<0x122>(v); v += dppf<0x121>(v); return v; }
namespace pg8 {
#define PG8_LAS __attribute__((address_space(3)))
typedef unsigned short bf16_t;
typedef unsigned u32x4 __attribute__((ext_vector_type(4)));
constexpr int BM = 256, BK = 64, HALF = 128, HTB = HALF * BK * 2  , STAGE_BYTES = 8 * HTB;

__host__ __device__ __forceinline__ int lds_byte(int r, int c) { const int st = (r >> 4) * 2 + (c >> 5), rr = r & 15, cc = c & 31, ob = rr * 64 + cc * 2; return st * 1024 + (ob ^ (((ob >> 9) & 1) << 5)); }
__host__ __device__ __forceinline__ void stage_rc(int b, int& R, int& C) { const int st = b / 1024, sb = b % 1024, swz = sb ^ (((sb >> 9) & 1) << 5); R = (st >> 1) * 16 + swz / 64; C = (st & 1) * 32 + (swz % 64) / 2; }
__host__ __device__ __forceinline__ int perm32(int rho) { const int n = rho >> 4, i = rho & 15; return 8 * (i >> 2) + 4 * n + (i & 3); }

struct Unit { int pm, pn, kind, nt; const char* a; const char* b; };

__device__ __forceinline__ unsigned cvt_pk_bf16(float lo, float hi) { unsigned r; asm volatile("v_cvt_pk_bf16_f32 %0, %1, %2" : "=v"(r) : "v"(lo), "v"(hi)); return r; }

template <class Epi, class Sched>
__device__ __forceinline__ void gemm_phase(PG8_LAS unsigned char* lds, const int lda, const int ldb, const Sched& S, const Epi& E) {
    int tid = threadIdx.x; asm volatile("" : "+v"(tid));
    const int wid = __builtin_amdgcn_readfirstlane(tid >> 6), lane = tid & 63, wr = wid >> 2, wc = wid & 3, fr = lane & 15, fq = lane >> 4;
    unsigned voffA[2], voffB[2];
#pragma unroll
    for (int i = 0; i < 2; ++i) { int R, C; stage_rc(tid * 16 + i * 8192, R, C); const int Rb = (R & ~31) + perm32(R & 31);
        voffA[i] = (unsigned)(R * lda + C) * 2u; voffB[i] = (unsigned)(Rb * ldb + C) * 2u; }
    const size_t kstep = (size_t)(BK * 2);
    const size_t hstepA = (size_t)HALF * lda * 2, hstepB = (size_t)HALF * ldb * 2;
    const unsigned ldsw = (unsigned)wid * 1024u;
    const int aoff = lds_byte(wr * 64 + fr, fq * 8), boff = lds_byte(wc * 32 + fr, fq * 8);
#define PG8_SA(b, h) (((b) * 2 + (h)) * HTB)
#define PG8_SB(b, h) ((4 + (b) * 2 + (h)) * HTB)
#define PG8_STAGE(bufoff, gbase, voff) do { _Pragma("unroll") for (int _i = 0; _i < 2; ++_i) \
        __builtin_amdgcn_global_load_lds((const unsigned*)((const char*)(gbase) + (voff)[_i]), (PG8_LAS unsigned*)(lds + (bufoff) + ldsw + _i * 8192), 16, 0, 0); } while (0)
#define PG8_LDA(dst, b, h) do { _Pragma("unroll") for (int m = 0; m < 4; ++m) _Pragma("unroll") for (int k = 0; k < 2; ++k) dst[m][k] = *(const PG8_LAS bf16x8*)(lds + PG8_SA(b, h) + aoff + m * 2048 + k * 1024); } while (0)
#define PG8_LDB(dst, b, h) do { _Pragma("unroll") for (int n = 0; n < 2; ++n) _Pragma("unroll") for (int k = 0; k < 2; ++k) dst[n][k] = *(const PG8_LAS bf16x8*)(lds + PG8_SB(b, h) + boff + n * 2048 + k * 1024); } while (0)
#define PG8_MMA(ai, bj, At, Bt) do { __builtin_amdgcn_s_setprio(1); _Pragma("unroll") for (int m = 0; m < 4; ++m) _Pragma("unroll") for (int n = 0; n < 2; ++n) _Pragma("unroll") for (int k = 0; k < 2; ++k) \
        acc[ai][bj][m][n] = __builtin_amdgcn_mfma_f32_16x16x32_bf16(Bt[n][k], At[m][k], acc[ai][bj][m][n], 0, 0, 0); __builtin_amdgcn_s_setprio(0); } while (0)
#define PG8_WAIT_V(n) asm volatile("s_waitcnt vmcnt(" #n ")" ::: "memory")
#define PG8_WAIT_L(n) asm volatile("s_waitcnt lgkmcnt(" #n ")" ::: "memory")
#define PG8_BAR __builtin_amdgcn_s_barrier()
#define PG8_SCHED __builtin_amdgcn_sched_barrier(0)
    Unit cur, nxt; int ui = 0;
    if (!S.next(0, cur)) return;
    f32x4 acc[2][2][4][2];
#pragma unroll
    for (int a = 0; a < 2; ++a)
#pragma unroll
        for (int b = 0; b < 2; ++b)
#pragma unroll
            for (int m = 0; m < 4; ++m)
#pragma unroll
                for (int n = 0; n < 2; ++n) acc[a][b][m][n] = (f32x4){0.f, 0.f, 0.f, 0.f};
    bf16x8 At[4][2], B0[2][2], B1[2][2];
    const char* cA = cur.a; const char* cB = cur.b;
    PG8_STAGE(PG8_SB(0, 0), cB, voffB); PG8_STAGE(PG8_SB(0, 1), cB + hstepB, voffB); PG8_STAGE(PG8_SA(0, 0), cA, voffA); PG8_STAGE(PG8_SA(0, 1), cA + hstepA, voffA);
    if (wr == 1) PG8_BAR;
    PG8_WAIT_V(2); PG8_BAR;
    PG8_STAGE(PG8_SB(1, 0), cB + kstep, voffB); PG8_STAGE(PG8_SA(1, 0), cA + kstep, voffA); PG8_STAGE(PG8_SB(1, 1), cB + hstepB + kstep, voffB);
    PG8_WAIT_V(6); PG8_BAR;
    for (;;) {
        const bool has_next = S.next(ui + 1, nxt);
        const char* nA = has_next ? nxt.a : cA; const char* nB = has_next ? nxt.b : cB;
        const int nt = cur.nt;
        for (int t = 0; t < nt; t += 2) {
            const bool last = (t == nt - 2);
            const char* a1 = cA + (size_t)(t + 1) * kstep;
            const char* a2 = last ? nA : cA + (size_t)(t + 2) * kstep; const char* b2 = last ? nB : cB + (size_t)(t + 2) * kstep;
            const char* a3 = a2 + kstep; const char* b3 = b2 + kstep;
            PG8_LDB(B0, 0, 0); PG8_LDB(B1, 0, 1); PG8_SCHED; PG8_LDA(At, 0, 0); PG8_STAGE(PG8_SA(1, 1), a1 + hstepA, voffA);
            PG8_WAIT_V(8); PG8_WAIT_L(0); PG8_BAR; PG8_MMA(0, 0, At, B0); PG8_MMA(0, 1, At, B1); PG8_BAR; PG8_SCHED;
            PG8_LDA(At, 0, 1); PG8_STAGE(PG8_SB(0, 0), b2, voffB); PG8_STAGE(PG8_SB(0, 1), b2 + hstepB, voffB); PG8_STAGE(PG8_SA(0, 0), a2, voffA);
            PG8_WAIT_V(8); PG8_WAIT_L(0); PG8_BAR; PG8_MMA(1, 0, At, B0); PG8_MMA(1, 1, At, B1); PG8_BAR; PG8_SCHED;
            PG8_LDB(B0, 1, 0); PG8_LDB(B1, 1, 1); PG8_SCHED; PG8_LDA(At, 1, 0); PG8_STAGE(PG8_SA(0, 1), a2 + hstepA, voffA);
            PG8_WAIT_V(8); PG8_WAIT_L(0); PG8_BAR; PG8_MMA(0, 0, At, B0); PG8_MMA(0, 1, At, B1); PG8_BAR; PG8_SCHED;
            PG8_LDA(At, 1, 1); PG8_STAGE(PG8_SB(1, 0), b3, voffB); PG8_STAGE(PG8_SB(1, 1), b3 + hstepB, voffB); PG8_STAGE(PG8_SA(1, 0), a3, voffA);
            PG8_WAIT_V(8); PG8_WAIT_L(0); PG8_BAR; PG8_MMA(1, 0, At, B0); PG8_MMA(1, 1, At, B1); PG8_BAR; PG8_SCHED;
        }
        if (wr == 0) PG8_BAR;
        E(acc, cur, wr, wc, fr, fq);
        if (!has_next) break;
#pragma unroll
        for (int a = 0; a < 2; ++a)
#pragma unroll
            for (int b = 0; b < 2; ++b)
#pragma unroll
                for (int m = 0; m < 4; ++m)
#pragma unroll
                    for (int n = 0; n < 2; ++n) acc[a][b][m][n] = (f32x4){0.f, 0.f, 0.f, 0.f};
        cur = nxt; cA = nA; cB = nB; ++ui;
        if (wr == 1) PG8_BAR;
    }
    PG8_WAIT_V(0);
    PG8_BAR;
#undef PG8_SA
#undef PG8_SB
#undef PG8_STAGE
#undef PG8_LDA
#undef PG8_LDB
#undef PG8_MMA
#undef PG8_WAIT_V
#undef PG8_WAIT_L
#undef PG8_BAR
#undef PG8_SCHED
}
}
typedef GAS unsigned gu32;
#define XB_TMO      128
#define XB_XCNT(j)  (256  + 64 * (j))
#define XB_XSUB(j)  (1280 + 64 * (j))
#define XB_XGEN(j)  (2304 + 64 * (j))
#define XB_TOP      3328
#define XB_TOPGEN   3392
#define XCD_BAR_WORDS 3456
#define XB_SPIN_CAP (1u << 18)
__device__ __forceinline__ unsigned xb_ld(unsigned* p)              { return __hip_atomic_load(p, __ATOMIC_RELAXED, __HIP_MEMORY_SCOPE_AGENT); }
__device__ __forceinline__ unsigned xb_add(unsigned* p, unsigned v) { return __hip_atomic_fetch_add(p, v, __ATOMIC_RELAXED, __HIP_MEMORY_SCOPE_AGENT); }
__device__ __forceinline__ unsigned xb_xcc_id() { return (unsigned)__builtin_amdgcn_s_getreg((3 << 11) | 20) & 0xFu; }
#define XB_SPIN(cond, bar) do { unsigned _sp = 0; while (cond) { __builtin_amdgcn_s_sleep(1); \
    if ((++_sp & 255u) == 0u) { if (xb_ld(&(bar)[XB_TMO])) break; if (_sp > XB_SPIN_CAP) { atomicAdd(&(bar)[XB_TMO], 1u); break; } } } } while (0)
struct XcdBarrier { unsigned* bar; unsigned x; volatile LAS unsigned* st; };
__device__ __forceinline__ XcdBarrier xcd_barrier_post(unsigned* bar, volatile LAS unsigned* st) {
    XcdBarrier b; b.bar = bar; b.x = xb_xcc_id(); b.st = st;
    if (threadIdx.x == 0) (void)xb_add(&bar[XB_XCNT(b.x)], 1u);
    return b;
}
__device__ __forceinline__ void xcd_barrier_complete(unsigned* bar, unsigned x, unsigned& nloc, unsigned& nx) {
    const unsigned G = gridDim.x * gridDim.y * gridDim.z;
    unsigned sum, cnt, mine, sp = 0u;
    for (;;) {
        sum = 0u; cnt = 0u; mine = 0u;
#pragma unroll
        for (unsigned j = 0; j < 16; ++j) { const unsigned c = xb_ld(&bar[XB_XCNT(j)]); sum += c; cnt += (c > 0u) ? 1u : 0u; mine = (j == x) ? c : mine; }
        if (sum == G) break;
        __builtin_amdgcn_s_sleep(1);
        if ((++sp & 255u) == 0u) { if (xb_ld(&bar[XB_TMO])) break; if (sp > XB_SPIN_CAP) { atomicAdd(&bar[XB_TMO], 1u); break; } }
    }
    nloc = mine > 0u ? mine : 1u; nx = cnt > 0u ? cnt : 1u;
}
__device__ __forceinline__ void xcd_barrier(const XcdBarrier& b) {
    asm volatile("s_waitcnt vmcnt(0)" ::: "memory");
    __syncthreads();
    if (threadIdx.x == 0) {
        unsigned* bar = b.bar;
        __builtin_amdgcn_s_waitcnt(0);
        unsigned nloc = b.st[0], nx = b.st[1];
        if (nloc == 0u) { xcd_barrier_complete(bar, b.x, nloc, nx); b.st[0] = nloc; b.st[1] = nx; }
        const unsigned old = xb_add(&bar[XB_XSUB(b.x)], 1u);
        const unsigned gen = old / nloc;
        if (old + 1u == (gen + 1u) * nloc) {
            __builtin_amdgcn_fence(__ATOMIC_RELEASE, "agent");
            asm volatile("s_waitcnt vmcnt(0)" ::: "memory");
            const unsigned og = xb_add(&bar[XB_TOP], 1u);
            const unsigned tg = og / nx;
            if (og + 1u == (tg + 1u) * nx) xb_add(&bar[XB_TOPGEN], 1u);
            else XB_SPIN(xb_ld(&bar[XB_TOPGEN]) == tg, bar);
            __builtin_amdgcn_fence(__ATOMIC_ACQUIRE, "agent");
            xb_add(&bar[XB_XGEN(b.x)], 1u);
            asm volatile("s_waitcnt vmcnt(0)" ::: "memory");
        } else {
            XB_SPIN(xb_ld(&bar[XB_XGEN(b.x)]) == gen, bar);
            __builtin_amdgcn_fence(__ATOMIC_ACQUIRE, "agent");
            asm volatile("s_waitcnt vmcnt(0)" ::: "memory");
        }
    }
    __syncthreads();
}

constexpr int RING_OFF = 0, RING_BYTES = 131072;
constexpr int LDSCTL_OFF = RING_BYTES, MISC_OFF = LDSCTL_OFF + 320;
constexpr int LDS_BYTES = 147456;
constexpr int NWAVES = 8;
constexpr int CW_BAR = 4096;

struct Frame {
    LAS unsigned char* lds;
    volatile LAS unsigned* MISC;
    int tid, lane, wave, vcu, G;
    float* out; unsigned char* ws;
};
typedef __attribute__((address_space(4))) const unsigned char* kargp_t;
__device__ __forceinline__ const float* karg_in(int i) { kargp_t p = (kargp_t)__builtin_amdgcn_kernarg_segment_ptr(); asm volatile("" : "+s"(p)); return *(const float* const __attribute__((address_space(4)))*)(p + 8 * i); }
#define KIN(k) karg_in(k)
__device__ __forceinline__ void p0_transpose_item(const float* W, int ldw, bf16* WT, int ldt, int koff, LAS float* scr, int k0, int n0, int scol0, int nvalid, int lane) {
    const int li = lane & 31; const bool ok = li < nvalid;
#pragma unroll 8
    for (int i = 0; i < 32; ++i) { const int kk = 2 * i + (lane >> 5); scr[kk * 33 + li] = ok ? W[(size_t)(k0 + kk) * ldw + scol0 + li] : 0.f; }
    LDS_WAIT(); asm volatile("" ::: "memory");
    const int c = lane & 7;
#pragma unroll
    for (int j = 0; j < 4; ++j) { const int n = (lane >> 3) + 8 * j; const LAS float* s = scr + (8 * c) * 33 + n;
        v4u o; o.x = pk2(s[0 * 33], s[1 * 33]); o.y = pk2(s[2 * 33], s[3 * 33]); o.z = pk2(s[4 * 33], s[5 * 33]); o.w = pk2(s[6 * 33], s[7 * 33]);
        *(GAS v4u*)(WT + (size_t)(n0 + n) * ldt + koff + k0 + 8 * c) = o; }
    LDS_WAIT(); asm volatile("" ::: "memory");
}
__device__ __forceinline__ void win_map(int n0, int& scol0, int& nvalid) {
    nvalid = 32;
    if (n0 < 1536) scol0 = n0;
    else if (n0 < 4096) scol0 = n0 + 128;
    else if (n0 < 6144) scol0 = n0 + 136;
    else if (n0 < 6272) scol0 = n0 - 6144 + 1536;
    else if (n0 == 6272) { scol0 = 4224; nvalid = 8; }
    else { scol0 = 0; nvalid = 0; }
}
__device__ __forceinline__ void p0_prologue(Frame& F) {
    LAS float* scr = (LAS float*)(F.lds + RING_OFF + F.wave * 16384);
    const int gw = F.vcu * NWAVES + F.wave, NGW = F.G * NWAVES;
    bf16* WinT = (bf16*)(F.ws + WS_WINT); bf16* Wab = (bf16*)(F.ws + WS_WAB); bf16* WoutT = (bf16*)(F.ws + WS_WOUT);
    const float* w_in = KIN(2); const float* w_oa = KIN(16); const float* w_ob = KIN(17); const float* w_o = KIN(18);
    constexpr int I_IN = 16 * 200, I_AB = 8 * 32, I_OUT = 16 * 32;
    constexpr int NITEMS = I_IN + 2 * I_AB + I_OUT;
    for (int it = gw; it < NITEMS; it += NGW) {
        int r = it;
        if (r < I_IN) { const int kb = r / 200, nb = r % 200; int sc, nv; win_map(32 * nb, sc, nv); p0_transpose_item(w_in, IN_COLS, WinT, 1024, 0, scr, 64 * kb, 32 * nb, sc, nv, F.lane); continue; } r -= I_IN;
        if (r < I_AB) { const int kb = r / 32, nb = r % 32; p0_transpose_item(w_oa, 1024, Wab, 1024, 0, scr, 64 * kb, 32 * nb, 32 * nb, 32, F.lane); continue; } r -= I_AB;
        if (r < I_AB) { const int kb = r / 32, nb = r % 32; p0_transpose_item(w_ob, 1024, Wab, 1024, 512, scr, 64 * kb, 32 * nb, 32 * nb, 32, F.lane); continue; } r -= I_AB;
        { const int kb = r / 32, nb = r % 32; p0_transpose_item(w_o, 1024, WoutT, 1024, 0, scr, 64 * kb, 32 * nb, 32 * nb, 32, F.lane); }
    }
    bf16* Acomb = (bf16*)(F.ws + WS_ACOMB);
    const GAS f32x4* gp = (const GAS f32x4*)KIN(1) + F.lane;
    f32x4 g[4];
#pragma unroll
    for (int j = 0; j < 4; ++j) g[j] = gp[64 * j];
    const float* xin = KIN(0);
    for (int m = gw; m < T; m += NGW) {
        const GAS f32x4* xr = (const GAS f32x4*)(xin + (size_t)m * DM) + F.lane;
        f32x4 v[4]; float s = 0.f;
#pragma unroll
        for (int j = 0; j < 4; ++j) { v[j] = xr[64 * j]; s += (v[j].x * v[j].x + v[j].y * v[j].y) + (v[j].z * v[j].z + v[j].w * v[j].w); }
        const float rstd = 1.f / sqrtf(wave_sum(s) * (1.f / DM) + RMS_EPS);
        GAS unsigned long long* o8 = (GAS unsigned long long*)(Acomb + (size_t)m * ACOMB_LD) + F.lane;
#pragma unroll
        for (int j = 0; j < 4; ++j) o8[64 * j] = (unsigned long long)pk2(v[j].x * rstd * g[j].x, v[j].y * rstd * g[j].y) | ((unsigned long long)pk2(v[j].z * rstd * g[j].z, v[j].w * rstd * g[j].w) << 32);
    }
}

struct SchedP1 {
    int c, G; const char* A; const char* B;
    __device__ __forceinline__ bool next(int i, pg8::Unit& u) const {
        constexpr int nM = 64, nN = 17, nwg = nM * nN, NX = 8, WGM = 8;
        const int L = i * G + c; if (L >= nwg) return false;
        int wgid = L; { const int q = nwg / NX, r = nwg % NX, xcd = wgid % NX, off = wgid / NX; wgid = (xcd < r ? xcd * (q + 1) : r * (q + 1) + (xcd - r) * q) + off; }
        const int nig = WGM * nN, gid = wgid / nig, fm = gid * WGM;
        u.pm = fm + ((wgid % nig) % WGM); int pn = (wgid % nig) / WGM; u.pn = pn == 16 ? 24 : pn; u.kind = 0; u.nt = 16;
        u.a = A + (size_t)u.pm * 256 * ACOMB_LD * 2; u.b = B + (size_t)u.pn * 256 * 1024 * 2; return true;
    }
};
struct EpiP1 {
    bf16* UA; bf16* UB; float* US;
    __device__ __forceinline__ void operator()(const f32x4 (&acc)[2][2][4][2], const pg8::Unit& u, int wr, int wc, int fr, int fq) const {
        const int row0 = u.pm * 256 + wr * 64 + fr;
        if (u.pn < 16) {
            bf16* base = (u.pn < 8 ? UA + u.pn * 256 : UB + (u.pn - 8) * 256) + wc * 32 + 8 * fq;
#pragma unroll
            for (int ai = 0; ai < 2; ++ai)
#pragma unroll
                for (int m = 0; m < 4; ++m) { bf16* rowp = base + (size_t)(row0 + ai * 128 + m * 16) * U_LD;
#pragma unroll
                    for (int bj = 0; bj < 2; ++bj) { const f32x4 v0 = acc[ai][bj][m][0], v1 = acc[ai][bj][m][1];
                        pg8::u32x4 w; w.x = pg8::cvt_pk_bf16(v0[0], v0[1]); w.y = pg8::cvt_pk_bf16(v0[2], v0[3]); w.z = pg8::cvt_pk_bf16(v1[0], v1[1]); w.w = pg8::cvt_pk_bf16(v1[2], v1[3]);
                        *(pg8::u32x4*)(rowp + bj * 128) = w; } }
        } else {
            float* base = US + wc * 32 + 8 * fq;
#pragma unroll
            for (int ai = 0; ai < 2; ++ai)
#pragma unroll
                for (int m = 0; m < 4; ++m) { float* rowp = base + (size_t)(row0 + ai * 128 + m * 16) * 256;
#pragma unroll
                    for (int bj = 0; bj < 2; ++bj) { *(f32x4*)(rowp + bj * 128) = acc[ai][bj][m][0]; *(f32x4*)(rowp + bj * 128 + 4) = acc[ai][bj][m][1]; } }
        }
    }
};

__device__ __forceinline__ float softplusf_(float x) { return fmaxf(x, 0.f) + log1pf(__expf(-fabsf(x))); }
#ifndef P2A_REP
#define P2A_REP 1
#endif
template <int PRB> __device__ __forceinline__ void p2_prep(Frame& F) {
    const int gw = F.vcu * NWAVES + F.wave, lane = F.lane;
    const float* US = (const float*)(F.ws + WS_US);
    const float* mu = KIN(3);
    for (int rp = 0; rp < P2A_REP; ++rp) {
        LAS float* sw = (LAS float*)(F.lds + RING_OFF + F.wave * 4096);
        LAS float* sa = sw + 512;
        const int m0 = 8 * gw;
        const float muw = mu[1536 + lane], mua = mu[1600 + lane];
#pragma unroll
        for (int r = 0; r < 8; ++r) { const int m = m0 + r; const bool first = (m % SEQ) == 0;
            const float cw = US[(size_t)m * 256 + lane], ca = US[(size_t)m * 256 + 64 + lane];
            const float pw = first ? 0.f : US[(size_t)(m - 1) * 256 + lane], pa = first ? 0.f : US[(size_t)(m - 1) * 256 + 64 + lane];
            sw[r * 64 + lane] = tanhf(cw + (pw - cw) * muw); sa[r * 64 + lane] = ca + (pa - ca) * mua; }
        LDS_WAIT(); asm volatile("" ::: "memory");
        float aw[8][8], aa[8][8];
#pragma unroll
        for (int r = 0; r < 8; ++r)
#pragma unroll
            for (int c = 0; c < 8; ++c) { aw[r][c] = 0.f; aa[r][c] = 0.f; }
        const float* wup = KIN(4) + 8 * lane; const float* aup = KIN(6) + 8 * lane;
#pragma unroll 2
        for (int j = 0; j < 64; ++j) {
            const f32x4 w0 = *(const f32x4*)(wup + j * 512), w1 = *(const f32x4*)(wup + j * 512 + 4);
            const f32x4 a0 = *(const f32x4*)(aup + j * 512), a1 = *(const f32x4*)(aup + j * 512 + 4);
#pragma unroll
            for (int r = 0; r < 8; ++r) { const float t = sw[r * 64 + j], d = sa[r * 64 + j];
#pragma unroll
                for (int c = 0; c < 4; ++c) { aw[r][c] += t * w0[c]; aw[r][4 + c] += t * w1[c]; aa[r][c] += d * a0[c]; aa[r][4 + c] += d * a1[c]; } }
        }
        float* DEC = PRB ? (float*)(F.ws + WS_UA) : F.out; float* LR = DEC + (size_t)T * 512;
        float w0v[8], a0v[8];
        { const float* w0p = KIN(5); const float* a0p = KIN(7);
#pragma unroll
        for (int c = 0; c < 8; ++c) { w0v[c] = w0p[8 * lane + c]; a0v[c] = a0p[8 * lane + c]; } }
#pragma unroll
        for (int r = 0; r < 8; ++r) { f32x4 d0, d1, l0, l1;
#pragma unroll
            for (int c = 0; c < 8; ++c) { const float z = w0v[c] + aw[r][c]; const float w = -softplusf_(-z) - 0.5f; const float dec = __expf(-__expf(w)); const float lr = sigmoidf_(a0v[c] + aa[r][c]);
                if (c < 4) { d0[c] = dec; l0[c] = lr; } else { d1[c - 4] = dec; l1[c - 4] = lr; } }
            float* dp = DEC + (size_t)(m0 + r) * 512 + 8 * lane; float* lp = LR + (size_t)(m0 + r) * 512 + 8 * lane;
            *(f32x4*)dp = d0; *(f32x4*)(dp + 4) = d1; *(f32x4*)lp = l0; *(f32x4*)(lp + 4) = l1; }
        LDS_WAIT(); asm volatile("" ::: "memory");
    }
    {
        bf16* UB = (bf16*)(F.ws + WS_UB);
        const int d0 = (lane & 7) * 8;
        float gq[8], gk[8];
        { const float* qg = KIN(14); const float* kg = KIN(15);
#pragma unroll
        for (int e = 0; e < 8; ++e) { gq[e] = qg[d0 + e] * C2; gk[e] = kg[d0 + e]; } }
        for (int tsk = gw; tsk < 2 * T; tsk += F.G * NWAVES) {
            const int m = tsk >> 1, which = tsk & 1;
            GAS v4u* p = (GAS v4u*)(UB + (size_t)m * U_LD + which * 512) + lane;
            const v4u w = *p;
            float x[8] = {bflo(w.x), bfhi(w.x), bflo(w.y), bfhi(w.y), bflo(w.z), bfhi(w.z), bflo(w.w), bfhi(w.w)};
            float s = 0.f;
#pragma unroll
            for (int e = 0; e < 8; ++e) s += x[e] * x[e];
            s += __shfl_xor(s, 1); s += __shfl_xor(s, 2); s += __shfl_xor(s, 4);
            const float rs = 1.f / sqrtf(s * (1.f / 64.f) + RMS_EPS);
#pragma unroll
            for (int e = 0; e < 8; ++e) x[e] = x[e] * rs * (which ? gk[e] : gq[e]);
            v4u o; o.x = pk2(x[0], x[1]); o.y = pk2(x[2], x[3]); o.z = pk2(x[4], x[5]); o.w = pk2(x[6], x[7]);
            if (PRB) *((GAS v4u*)((bf16*)(F.ws + WS_UA) + (size_t)m * U_LD + which * 512) + lane) = o; else *p = o;
        }
    }
    if (gw < 64) {
        const int b = gw >> 3, h = gw & 7; const float fb = KIN(13)[h];
        float* G2 = (float*)(F.ws + (PRB ? WS_UB : WS_G2)) + (size_t)gw * SEQ + 32 * lane;
        float v[32]; float run = 0.f;
#pragma unroll
        for (int i = 0; i < 32; ++i) { const float x = US[(size_t)(b * SEQ + 32 * lane + i) * 256 + 128 + h] + fb; run += -softplusf_(-x) * LOG2E; v[i] = run; }
        float tot = run, ex = run;
#pragma unroll
        for (int o = 1; o < 64; o <<= 1) { const float n = __shfl_up(ex, o); if (lane >= o) ex += n; }
        ex -= tot;
#pragma unroll
        for (int i = 0; i < 32; i += 4) *(f32x4*)(G2 + i) = (f32x4){v[i] + ex, v[i + 1] + ex, v[i + 2] + ex, v[i + 3] + ex};
    }
}
__device__ __forceinline__ int crow(int r, int hi) { return (r & 3) + 8 * (r >> 2) + 4 * hi; }
__device__ __forceinline__ s16x4 vtr(const LAS char* p) { typedef short v4i16_t __attribute__((ext_vector_type(4))); return __builtin_bit_cast(s16x4, __builtin_amdgcn_ds_read_tr16_b64_v4i16((LAS v4i16_t*)p)); }
__device__ __forceinline__ unsigned cvtpk_s(float lo, float hi) { typedef __bf16 bf16x2_t __attribute__((ext_vector_type(2))); f32x2 v = {lo, hi}; bf16x2_t b = __builtin_convertvector(v, bf16x2_t); return __builtin_bit_cast(unsigned, b); }

constexpr int AT_K = 0, AT_V = 8192, AT_BIAS = 16384, AT_WS = 16640, AT_OST = 20480;

__device__ __forceinline__ void attn_unit(Frame& F, int b, int h, int qb) {
    const int tid = F.tid, lane = F.lane, r32 = lane & 31, hi = lane >> 5, wid = F.wave;
    const bf16* UB = (const bf16*)(F.ws + WS_UB);
    const float* G2 = (const float*)(F.ws + WS_G2) + (size_t)(b * NH + h) * SEQ;
    bf16* Acomb = (bf16*)(F.ws + WS_ACOMB);
    LAS char* lds = (LAS char*)F.lds;
    const long rowbase = (long)b * SEQ; const int q0 = qb * 256; const int qrow = q0 + wid * 32 + r32;
    const bf16* Qw = UB + (rowbase + q0 + wid * 32) * U_LD + h * 64;
    bf16x8 qr[4];
#pragma unroll
    for (int d0 = 0; d0 < 4; ++d0) qr[d0] = *(const bf16x8*)(Qw + (long)r32 * U_LD + d0 * 16 + hi * 8);
    const float gq = G2[qrow];
    float m_run = -1e30f, l_run = 0.f; f32x16 o[2]; o[0] = f32x16{}; o[1] = f32x16{};
    LAS float* wsf = (LAS float*)(lds + AT_WS) + wid * 64;
    LAS float* biasl = (LAS float*)(lds + AT_BIAS);
    const int NT = (q0 + 256) / 64;
    const int kvl = tid >> 3, ch = tid & 7;
    const LAS char* kp0 = lds + AT_K + hi * 1024 + r32 * 16;
    const LAS char* vp0 = lds + AT_V + ((lane >> 4) & 1) * 32 + (lane & 3) * 8 + (4 * hi + ((lane & 15) >> 2)) * 64;
    for (int t = 0; t < NT; ++t) {
        __syncthreads();
        { const bf16* src = UB + (rowbase + 64 * t + kvl) * U_LD + h * 64 + 8 * ch;
          const v4u kx = *(const v4u*)(src + 512), vx = *(const v4u*)(src + 1024);
          *(LAS v4u*)(lds + AT_K + ch * 1024 + kvl * 16) = kx;
          *(LAS v4u*)(lds + AT_V + (ch >> 2) * 4096 + kvl * 64 + (ch & 3) * 16) = vx;
          if (tid < 64) biasl[tid] = G2[64 * t + tid]; }
        __syncthreads();
        if (64 * t > q0 + wid * 32 + 31) continue;
        f32x16 p0 = f32x16{}, p1 = f32x16{};
#pragma unroll
        for (int d0 = 0; d0 < 4; ++d0) {
            const bf16x8 b0 = *(const LAS bf16x8*)(kp0 + d0 * 2048), b1 = *(const LAS bf16x8*)(kp0 + d0 * 2048 + 512);
            p0 = __builtin_amdgcn_mfma_f32_32x32x16_bf16(b0, qr[d0], p0, 0, 0, 0);
            p1 = __builtin_amdgcn_mfma_f32_32x32x16_bf16(b1, qr[d0], p1, 0, 0, 0);
        }
        float rm = -INFINITY;
#pragma unroll
        for (int g4 = 0; g4 < 4; ++g4) {
            const f32x4 gk0 = *(const LAS f32x4*)(biasl + 8 * g4 + 4 * hi), gk1 = *(const LAS f32x4*)(biasl + 32 + 8 * g4 + 4 * hi);
#pragma unroll
            for (int i = 0; i < 4; ++i) { const int r = 4 * g4 + i; const int key = 64 * t + crow(r, hi);
                float x0 = p0[r] + (gq - gk0[i]), x1 = p1[r] + (gq - gk1[i]);
                if (key > qrow) x0 = -INFINITY; if (key + 32 > qrow) x1 = -INFINITY;
                p0[r] = x0; p1[r] = x1; rm = fmaxf(rm, fmaxf(x0, x1)); }
        }
        { auto rr = __builtin_amdgcn_permlane32_swap(__float_as_uint(rm), __float_as_uint(rm), false, false); rm = fmaxf(__uint_as_float(rr[0]), __uint_as_float(rr[1])); }
        const float m_new = fmaxf(m_run, rm);
        const float alpha = __builtin_amdgcn_exp2f(m_run - m_new);
        m_run = m_new;
        float ls = 0.f;
#pragma unroll
        for (int r = 0; r < 16; ++r) { p0[r] = __builtin_amdgcn_exp2f(p0[r] - m_new); p1[r] = __builtin_amdgcn_exp2f(p1[r] - m_new); ls += p0[r] + p1[r]; }
        l_run = l_run * alpha + ls;
        if (hi == 0) wsf[r32] = alpha;
        v4u pw0, pw1, pw2, pw3;
        pw0 = (v4u){cvtpk_s(p0[0], p0[1]), cvtpk_s(p0[2], p0[3]), cvtpk_s(p0[4], p0[5]), cvtpk_s(p0[6], p0[7])};
        pw1 = (v4u){cvtpk_s(p0[8], p0[9]), cvtpk_s(p0[10], p0[11]), cvtpk_s(p0[12], p0[13]), cvtpk_s(p0[14], p0[15])};
        pw2 = (v4u){cvtpk_s(p1[0], p1[1]), cvtpk_s(p1[2], p1[3]), cvtpk_s(p1[4], p1[5]), cvtpk_s(p1[6], p1[7])};
        pw3 = (v4u){cvtpk_s(p1[8], p1[9]), cvtpk_s(p1[10], p1[11]), cvtpk_s(p1[12], p1[13]), cvtpk_s(p1[14], p1[15])};
        LDS_WAIT();
#pragma unroll
        for (int r = 0; r < 16; ++r) { const float a = wsf[crow(r, hi)]; o[0][r] *= a; o[1][r] *= a; }
#pragma unroll
        for (int d0 = 0; d0 < 2; ++d0) {
#define AT_PV(ks, PW) { const s16x4 lo = vtr(vp0 + d0 * 4096 + ks * 1024), hh = vtr(vp0 + d0 * 4096 + ks * 1024 + 512); \
              const bf16x8 vf = (bf16x8){lo[0], lo[1], lo[2], lo[3], hh[0], hh[1], hh[2], hh[3]}; \
              o[d0] = __builtin_amdgcn_mfma_f32_32x32x16_bf16(__builtin_bit_cast(bf16x8, PW), vf, o[d0], 0, 0, 0); }
            AT_PV(0, pw0) AT_PV(1, pw1) AT_PV(2, pw2) AT_PV(3, pw3)
#undef AT_PV
        }
    }
    { auto rr = __builtin_amdgcn_permlane32_swap(__float_as_uint(l_run), __float_as_uint(l_run), false, false); l_run = __uint_as_float(rr[0]) + __uint_as_float(rr[1]); }
    if (hi == 0) wsf[32 + r32] = l_run;
    LDS_WAIT();
    bf16* stg = (bf16*)(F.lds + AT_OST) + wid * 2048;
    LAS bf16* stgl = (LAS bf16*)(lds + AT_OST) + wid * 2048;
#pragma unroll
    for (int r = 0; r < 16; ++r) { const int orow = crow(r, hi); const float rl = 1.0f / wsf[32 + orow];
#pragma unroll
        for (int d0 = 0; d0 < 2; ++d0) stgl[orow * 64 + d0 * 32 + r32] = (bf16)f2bf(o[d0][r] * rl); }
    LDS_WAIT();
    (void)stg;
#pragma unroll
    for (int i = 0; i < 4; ++i) { const int row = i * 8 + (lane >> 3), c8 = lane & 7;
        const v4u v = *(const LAS v4u*)(stgl + row * 64 + c8 * 8);
        const long grow = rowbase + q0 + wid * 32 + row;
        const v4u gt = *(const v4u*)(UB + grow * U_LD + 1536 + h * 64 + c8 * 8);
        v4u ov;
        ov.x = pk2(bflo(v.x) * siluf_(bflo(gt.x)), bfhi(v.x) * siluf_(bfhi(gt.x)));
        ov.y = pk2(bflo(v.y) * siluf_(bflo(gt.y)), bfhi(v.y) * siluf_(bfhi(gt.y)));
        ov.z = pk2(bflo(v.z) * siluf_(bflo(gt.z)), bfhi(v.z) * siluf_(bfhi(gt.z)));
        ov.w = pk2(bflo(v.w) * siluf_(bflo(gt.w)), bfhi(v.w) * siluf_(bfhi(gt.w)));
        *(v4u*)(Acomb + grow * ACOMB_LD + ZB_OFF + h * 64 + c8 * 8) = ov; }
}
__device__ __forceinline__ void p3_attention(Frame& F) {
    const int bh = F.vcu >> 2, s = F.vcu & 3;
    attn_unit(F, bh >> 3, bh & 7, s);
    __syncthreads();
    attn_unit(F, bh >> 3, bh & 7, 7 - s);
}
template <int Q> __device__ __forceinline__ float bcq(float x) { return __builtin_bit_cast(float, __builtin_amdgcn_mov_dpp(__builtin_bit_cast(int, x), 0x150 + Q, 0xf, 0xf, true)); }

template <int VAR> __device__ __forceinline__ void p4_scan_a(Frame& F) {
    const int lane = F.lane, q16 = lane & 15;
    const int id = F.vcu * NWAVES + F.wave;
    const int b = id >> 8, h = (id >> 5) & 7, c = id & 31;
    const bf16* UA = (const bf16*)(F.ws + WS_UA);
    const float* DEC = F.out; const float* LR = F.out + (size_t)T * 512;
    float* Gm = (float*)(F.ws + WS_UB); float* Hm = Gm + (size_t)2048 * 4096;
    bf16* Rbar = (bf16*)(F.ws + WS_US); bf16* Yloc = (bf16*)(F.ws + WS_YLOC);
    float* BON = (float*)(F.ws + WS_BONUS);
    const float* mu = KIN(3);
    const int ch0 = h * 64 + 4 * q16;
    f32x4 mu_r = *(const f32x4*)(mu + ch0), mu_k = *(const f32x4*)(mu + 512 + ch0), kkc = *(const f32x4*)(KIN(8) + ch0), kac = *(const f32x4*)(KIN(9) + ch0), rkc = *(const f32x4*)(KIN(10) + ch0);
    const float mu_v = mu[1024 + h * 64 + lane];
    const long m0 = (long)b * SEQ + c * 64;
    float sL[64], sG[64];
#pragma unroll
    for (int j = 0; j < 64; ++j) { sL[j] = 0.f; sG[j] = (j == lane) ? 1.f : 0.f; }
    f32x4 pr = {0.f, 0.f, 0.f, 0.f}, pk = {0.f, 0.f, 0.f, 0.f}; float pv = 0.f;
    if (c > 0) { const bf16* up = UA + (m0 - 1) * U_LD; const v2u a = *(const v2u*)(up + ch0), k = *(const v2u*)(up + 512 + ch0);
        pr = (f32x4){bflo(a.x), bfhi(a.x), bflo(a.y), bfhi(a.y)}; pk = (f32x4){bflo(k.x), bfhi(k.x), bflo(k.y), bfhi(k.y)}; pv = bf2f(up[1024 + h * 64 + lane]); }
    v2u n_ua, n_uk; unsigned short n_cv; f32x4 n_lr, n_wv;
    { const bf16* up = UA + m0 * U_LD; n_ua = *(const v2u*)(up + ch0); n_uk = *(const v2u*)(up + 512 + ch0); n_cv = up[1024 + h * 64 + lane];
      n_lr = *(const f32x4*)(LR + m0 * 512 + ch0); n_wv = *(const f32x4*)(DEC + m0 * 512 + ch0); }
    for (int t = 0; t < 64; ++t) {
        const long m = m0 + t;
        const v2u ua = n_ua, uk = n_uk; const float cv = bf2f(n_cv); const f32x4 lr = n_lr, wv = n_wv;
        { const long mn = m0 + (t < 63 ? t + 1 : 63); const bf16* up = UA + mn * U_LD; n_ua = *(const v2u*)(up + ch0); n_uk = *(const v2u*)(up + 512 + ch0); n_cv = up[1024 + h * 64 + lane];
          n_lr = *(const f32x4*)(LR + mn * 512 + ch0); n_wv = *(const f32x4*)(DEC + mn * 512 + ch0); }
        const f32x4 cr = (f32x4){bflo(ua.x), bfhi(ua.x), bflo(ua.y), bfhi(ua.y)}, ck = (f32x4){bflo(uk.x), bfhi(uk.x), bflo(uk.y), bfhi(uk.y)};
        f32x4 rv, kx, av, bv, km;
        float ss = 0.f, bon = 0.f;
#pragma unroll
        for (int e = 0; e < 4; ++e) { rv[e] = cr[e] + (pr[e] - cr[e]) * mu_r[e]; kx[e] = ck[e] + (pk[e] - ck[e]) * mu_k[e]; const float kk = kx[e] * kkc[e]; av[e] = kk; ss += kk * kk; }
        ss = row16_sum(ss);
        const float inv = 1.0f / fmaxf(sqrtf(ss), 1e-12f);
#pragma unroll
        for (int e = 0; e < 4; ++e) { av[e] = -av[e] * inv; bv[e] = -av[e] * lr[e]; km[e] = kx[e] * (1.0f + (lr[e] - 1.0f) * kac[e]); bon += rv[e] * km[e] * rkc[e]; }
        bon = row16_sum(bon);
        const float vi = cv + (pv - cv) * mu_v;
        pr = cr; pk = ck; pv = cv;
        if (lane == 0) BON[m * 8 + h] = bon;
        asm volatile("s_nop 1" : "+v"(av[0]), "+v"(av[1]), "+v"(av[2]), "+v"(av[3]), "+v"(bv[0]), "+v"(bv[1]), "+v"(bv[2]), "+v"(bv[3]));
        asm volatile("s_nop 1" : "+v"(km[0]), "+v"(km[1]), "+v"(km[2]), "+v"(km[3]), "+v"(rv[0]), "+v"(rv[1]), "+v"(rv[2]), "+v"(rv[3]));
        f32x4 wq = wv; asm volatile("s_nop 1" : "+v"(wq[0]), "+v"(wq[1]), "+v"(wq[2]), "+v"(wq[3]));
        float saL0 = 0.f, saL1 = 0.f, saG0 = 0.f, saG1 = 0.f;
#define DFMAC(ACC, BC, X, Q) do { if (VAR == 1) asm("v_fmac_f32_e32 %0, %1, %2" : "+v"(ACC) : "v"(BC), "v"(X)); else asm("v_fmac_f32_dpp %0, %1, %2 row_newbcast:" #Q " row_mask:0xf bank_mask:0xf" : "+v"(ACC) : "v"(BC), "v"(X)); } while (0)
#define DMUL(X, BC, Q) do { if (VAR == 1) asm("v_mul_f32_e32 %0, %1, %0" : "+v"(X) : "v"(BC)); else asm("v_mul_f32_dpp %0, %1, %0 row_newbcast:" #Q " row_mask:0xf bank_mask:0xf" : "+v"(X) : "v"(BC)); } while (0)
#define SA_BLK(Q) { DFMAC(saL0, av[0], sL[4 * Q], Q); DFMAC(saG0, av[0], sG[4 * Q], Q); DFMAC(saL1, av[1], sL[4 * Q + 1], Q); DFMAC(saG1, av[1], sG[4 * Q + 1], Q); \
            DFMAC(saL0, av[2], sL[4 * Q + 2], Q); DFMAC(saG0, av[2], sG[4 * Q + 2], Q); DFMAC(saL1, av[3], sL[4 * Q + 3], Q); DFMAC(saG1, av[3], sG[4 * Q + 3], Q); }
        SA_BLK(0) SA_BLK(1) SA_BLK(2) SA_BLK(3) SA_BLK(4) SA_BLK(5) SA_BLK(6) SA_BLK(7) SA_BLK(8) SA_BLK(9) SA_BLK(10) SA_BLK(11) SA_BLK(12) SA_BLK(13) SA_BLK(14) SA_BLK(15)
#undef SA_BLK
        float saL = saL0 + saL1, saG = saG0 + saG1;
        float yL0 = 0.f, yL1 = 0.f, yG0 = 0.f, yG1 = 0.f;
#define UP_ONE(Q, E, YL, YG) { DMUL(sL[4 * Q + E], wq[E], Q); DMUL(sG[4 * Q + E], wq[E], Q); DFMAC(sL[4 * Q + E], bv[E], saL, Q); DFMAC(sG[4 * Q + E], bv[E], saG, Q); \
            DFMAC(sL[4 * Q + E], km[E], vi, Q); DFMAC(YG, rv[E], sG[4 * Q + E], Q); DFMAC(YL, rv[E], sL[4 * Q + E], Q); }
#define UP_BLK(Q) UP_ONE(Q, 0, yL0, yG0) UP_ONE(Q, 1, yL1, yG1) UP_ONE(Q, 2, yL0, yG0) UP_ONE(Q, 3, yL1, yG1)
        UP_BLK(0) UP_BLK(1) UP_BLK(2) UP_BLK(3) UP_BLK(4) UP_BLK(5) UP_BLK(6) UP_BLK(7) UP_BLK(8) UP_BLK(9) UP_BLK(10) UP_BLK(11) UP_BLK(12) UP_BLK(13) UP_BLK(14) UP_BLK(15)
#undef UP_BLK
#undef UP_ONE
#undef DFMAC
#undef DMUL
        Yloc[m * 512 + h * 64 + lane] = (bf16)f2bf(yL0 + yL1);
        Rbar[m * 512 + h * 64 + lane] = (bf16)f2bf(yG0 + yG1);
    }
    float* hp = Hm + (size_t)id * 4096 + lane * 64; float* gp = Gm + (size_t)id * 4096 + lane * 64;
#pragma unroll
    for (int j = 0; j < 64; j += 4) { *(f32x4*)(hp + j) = (f32x4){sL[j], sL[j + 1], sL[j + 2], sL[j + 3]}; *(f32x4*)(gp + j) = (f32x4){sG[j], sG[j + 1], sG[j + 2], sG[j + 3]}; }
}

template <int PRB> __device__ __forceinline__ void p5_scan_b(Frame& F) {
    const int bh = F.vcu >> 2, i0 = (F.vcu & 3) * 16, lane = F.lane, fr = lane & 15, fq = lane >> 4, n = F.wave;
    const float* Gm = (const float*)(F.ws + WS_UB); const float* Hm = Gm + (size_t)2048 * 4096;
    float* Sst = PRB ? (float*)(F.ws + WS_UA) : F.out;
    LAS float* Ssb = (LAS float*)(F.lds + RING_OFF);
    const int id0 = ((bh >> 3) << 8) | ((bh & 7) << 5);
    if (n < 4) {
        f32x4 st = (f32x4){0.f, 0.f, 0.f, 0.f};
        float gb[16]; f32x4 hv;
        { const float* gp = Gm + (size_t)id0 * 4096 + 16 * n + fr; const float* hp = Hm + (size_t)id0 * 4096 + (size_t)(i0 + 4 * fq) * 64 + 16 * n + fr;
#pragma unroll
          for (int ks = 0; ks < 16; ++ks) gb[ks] = gp[(4 * ks + fq) * 64];
#pragma unroll
          for (int r = 0; r < 4; ++r) hv[r] = hp[r * 64]; }
        for (int c = 0; c < 32; ++c) {
            const size_t base = (size_t)(id0 + c) * 4096;
            { float* sp = Sst + base + (size_t)(i0 + 4 * fq) * 64 + 16 * n + fr;
#pragma unroll
              for (int r = 0; r < 4; ++r) sp[r * 64] = st[r]; }
            if (c == 31) break;
            LAS float* Ss = Ssb + (c & 1) * (16 * 65);
#pragma unroll
            for (int r = 0; r < 4; ++r) Ss[(4 * fq + r) * 65 + 16 * n + fr] = st[r];
            float ga[16]; f32x4 acc = hv;
#pragma unroll
            for (int ks = 0; ks < 16; ++ks) ga[ks] = gb[ks];
            if (c < 30) { const float* gp = Gm + base + 4096 + 16 * n + fr; const float* hp = Hm + base + 4096 + (size_t)(i0 + 4 * fq) * 64 + 16 * n + fr;
#pragma unroll
                for (int ks = 0; ks < 16; ++ks) gb[ks] = gp[(4 * ks + fq) * 64];
#pragma unroll
                for (int r = 0; r < 4; ++r) hv[r] = hp[r * 64]; }
            asm volatile("s_waitcnt lgkmcnt(0)" ::: "memory"); __builtin_amdgcn_s_barrier(); asm volatile("" ::: "memory");
            float av[16];
#pragma unroll
            for (int ks = 0; ks < 16; ++ks) av[ks] = Ss[fr * 65 + 4 * ks + fq];
#pragma unroll
            for (int ks = 0; ks < 16; ++ks) acc = __builtin_amdgcn_mfma_f32_16x16x4f32(av[ks], ga[ks], acc, 0, 0, 0);
            st = acc;
        }
    } else {
        for (int c = 0; c < 31; ++c) { __builtin_amdgcn_s_barrier(); }
    }
    __syncthreads();
}

__device__ __forceinline__ f32x4 bf4(v2u w) { return (f32x4){bflo(w.x), bfhi(w.x), bflo(w.y), bfhi(w.y)}; }
__device__ __forceinline__ float xrow4_sum(float v) {
    v += __shfl_xor(v, 16); v += __shfl_xor(v, 32); return v;
}
__device__ __forceinline__ void p6_scan_c(Frame& F) {
    const int lane = F.lane, fr = lane & 15, fq = lane >> 4;
    const int id = F.vcu * NWAVES + F.wave;
    const int b = id >> 8, h = (id >> 5) & 7, c = id & 31;
    const bf16* UA = (const bf16*)(F.ws + WS_UA);
    const bf16* Rbar = (const bf16*)(F.ws + WS_US); const bf16* Yloc = (const bf16*)(F.ws + WS_YLOC);
    const float* BON = (const float*)(F.ws + WS_BONUS);
    const float* Sst = F.out + (size_t)id * 4096;
    bf16* Acomb = (bf16*)(F.ws + WS_ACOMB);
    const float* mu = KIN(3);
    const long m0 = (long)b * SEQ + c * 64;
    bf16x8 sfr[4][2];
#pragma unroll
    for (int it = 0; it < 4; ++it)
#pragma unroll
        for (int ks = 0; ks < 2; ++ks) { const float* p = Sst + (16 * it + fr) * 64 + 32 * ks + 8 * fq; const f32x4 x0 = *(const f32x4*)p, x1 = *(const f32x4*)(p + 4);
            v4u w; w.x = pk2(x0[0], x0[1]); w.y = pk2(x0[2], x0[3]); w.z = pk2(x1[0], x1[1]); w.w = pk2(x1[2], x1[3]); sfr[it][ks] = __builtin_bit_cast(bf16x8, w); }
    f32x4 lw[4], lb[4], muv[4], mug[4];
    const float* lnw = KIN(11); const float* lnb = KIN(12);
#pragma unroll
    for (int it = 0; it < 4; ++it) { const int ch = h * 64 + 16 * it + 4 * fq; lw[it] = *(const f32x4*)(lnw + ch); lb[it] = *(const f32x4*)(lnb + ch); muv[it] = *(const f32x4*)(mu + 1024 + ch); mug[it] = *(const f32x4*)(mu + 1664 + ch); }
    struct Ld { bf16x8 rfr[2]; v2u yl[4], cv[4], cg[4], pv[4], pg[4]; float bs; };
    auto load = [&](int tt, Ld& L) {
        const long m = m0 + 16 * tt + fr; const long mp = (m % SEQ) == 0 ? m : m - 1;
#pragma unroll
        for (int ks = 0; ks < 2; ++ks) L.rfr[ks] = *(const bf16x8*)(Rbar + m * 512 + h * 64 + 32 * ks + 8 * fq);
        L.bs = BON[m * 8 + h];
#pragma unroll
        for (int it = 0; it < 4; ++it) { const int ch = h * 64 + 16 * it + 4 * fq;
            L.yl[it] = *(const v2u*)(Yloc + m * 512 + ch);
            L.cv[it] = *(const v2u*)(UA + m * U_LD + 1024 + ch); L.cg[it] = *(const v2u*)(UA + m * U_LD + 1536 + ch);
            L.pv[it] = *(const v2u*)(UA + mp * U_LD + 1024 + ch); L.pg[it] = *(const v2u*)(UA + mp * U_LD + 1536 + ch); }
    };
    auto compute = [&](int tt, const Ld& L) {
        const long m = m0 + 16 * tt + fr; const bool first = (m % SEQ) == 0;
        f32x4 y[4]; float s = 0.f;
#pragma unroll
        for (int it = 0; it < 4; ++it) { f32x4 acc = (f32x4){0.f, 0.f, 0.f, 0.f};
#pragma unroll
            for (int ks = 0; ks < 2; ++ks) acc = __builtin_amdgcn_mfma_f32_16x16x32_bf16(sfr[it][ks], L.rfr[ks], acc, 0, 0, 0);
            y[it] = acc + bf4(L.yl[it]); s += (y[it][0] + y[it][1]) + (y[it][2] + y[it][3]); }
        const float mean = xrow4_sum(s) * (1.f / 64.f); float q = 0.f;
#pragma unroll
        for (int it = 0; it < 4; ++it) { y[it] = y[it] - mean; q += (y[it][0] * y[it][0] + y[it][1] * y[it][1]) + (y[it][2] * y[it][2] + y[it][3] * y[it][3]); }
        const float rstd = 1.0f / sqrtf(xrow4_sum(q) * (1.f / 64.f) + LNX_EPS);
#pragma unroll
        for (int it = 0; it < 4; ++it) { const int ch = h * 64 + 16 * it + 4 * fq;
            const f32x4 cv = bf4(L.cv[it]), cg = bf4(L.cg[it]);
            f32x4 pv = bf4(L.pv[it]), pg = bf4(L.pg[it]);
            if (first) { pv = (f32x4){0.f, 0.f, 0.f, 0.f}; pg = pv; }
            const f32x4 vv = cv + (pv - cv) * muv[it], gg = cg + (pg - cg) * mug[it];
            f32x4 z = y[it] * rstd * lw[it] + lb[it] + L.bs * vv;
            z = (f32x4){z[0] * siluf_(gg[0]), z[1] * siluf_(gg[1]), z[2] * siluf_(gg[2]), z[3] * siluf_(gg[3])};
            *(v2u*)(Acomb + m * ACOMB_LD + ZA_OFF + ch) = (v2u){pk2(z[0], z[1]), pk2(z[2], z[3])}; }
    };
    Ld LA, LB;
    load(0, LA); load(1, LB);
    compute(0, LA); load(2, LA);
    compute(1, LB); load(3, LB);
    compute(2, LA); compute(3, LB);
}
struct SchedP7 {
    int pm, pn; const char* Acomb; const char* WinT; const char* Wab;
    __device__ __forceinline__ bool next(int i, pg8::Unit& u) const {
        if (i >= 4) return false;
        u.pm = pm; u.pn = pn; u.kind = i;
        const char* arow = Acomb + (size_t)pm * 256 * ACOMB_LD * 2;
        if (i == 0)      { u.nt = 16; u.a = arow;                 u.b = WinT + (size_t)(4096 + pn * 256) * 1024 * 2; }
        else if (i == 1) { u.nt = 8;  u.a = arow + ZA_OFF * 2;    u.b = Wab + (size_t)(pn * 256) * 1024 * 2; }
        else if (i == 2) { u.nt = 16; u.a = arow;                 u.b = WinT + (size_t)(5120 + pn * 256) * 1024 * 2; }
        else             { u.nt = 8;  u.a = arow + ZB_OFF * 2;    u.b = Wab + (size_t)(pn * 256) * 1024 * 2 + 512 * 2; }
        return true;
    }
};
struct EpiP7 {
    f32x4* SG; f32x4* TMP; bf16* merged;
    __device__ __forceinline__ void operator()(const f32x4 (&acc)[2][2][4][2], const pg8::Unit& u, int wr, int wc, int fr, int fq) const {
        const int tid = threadIdx.x;
        f32x4* SG = this->SG; f32x4* TMP = this->TMP;
        asm volatile("" : "+s"(SG), "+s"(TMP));
        if (u.kind == 0 || u.kind == 2) {
#pragma unroll
            for (int ai = 0; ai < 2; ++ai)
#pragma unroll
                for (int bj = 0; bj < 2; ++bj)
#pragma unroll
                    for (int m = 0; m < 4; ++m)
#pragma unroll
                        for (int n = 0; n < 2; ++n) { const f32x4 v = acc[ai][bj][m][n]; f32x4* p = SG + (((((ai * 2 + bj) * 4 + m) * 2 + n)) << 9);
                            p[tid] = (f32x4){sigmoidf_(v[0]), sigmoidf_(v[1]), sigmoidf_(v[2]), sigmoidf_(v[3])}; asm volatile("" ::: "memory"); }
        } else if (u.kind == 1) {
#pragma unroll
            for (int ai = 0; ai < 2; ++ai)
#pragma unroll
                for (int bj = 0; bj < 2; ++bj)
#pragma unroll
                    for (int m = 0; m < 4; ++m)
#pragma unroll
                        for (int n = 0; n < 2; ++n) { const int ix = ((((ai * 2 + bj) * 4 + m) * 2 + n) << 9); const f32x4* ps = SG + ix; f32x4* pt = TMP + ix; pt[tid] = ps[tid] * acc[ai][bj][m][n]; if (n == 1) asm volatile("" ::: "memory"); }
        } else {
            const int row0 = u.pm * 256 + wr * 64 + fr; bf16* base = merged + u.pn * 256 + wc * 32 + 8 * fq;
#pragma unroll
            for (int ai = 0; ai < 2; ++ai)
#pragma unroll
                for (int m = 0; m < 4; ++m) { bf16* rowp = base + (size_t)(row0 + ai * 128 + m * 16) * 1024;
#pragma unroll
                    for (int bj = 0; bj < 2; ++bj) { const int ix = (((ai * 2 + bj) * 4 + m) * 2) << 9; const f32x4* ps = SG + ix; const f32x4* pt = TMP + ix;
                        const f32x4 v0 = pt[tid] + ps[tid] * acc[ai][bj][m][0], v1 = pt[512 + tid] + ps[512 + tid] * acc[ai][bj][m][1];
                        pg8::u32x4 w; w.x = pg8::cvt_pk_bf16(v0[0], v0[1]); w.y = pg8::cvt_pk_bf16(v0[2], v0[3]); w.z = pg8::cvt_pk_bf16(v1[0], v1[1]); w.w = pg8::cvt_pk_bf16(v1[2], v1[3]);
                        *(pg8::u32x4*)(rowp + bj * 128) = w; asm volatile("" ::: "memory"); } }
        }
    }
};
struct SchedP8 {
    int pm, pn; const char* A; const char* B;
    __device__ __forceinline__ bool next(int i, pg8::Unit& u) const {
        if (i >= 1) return false;
        u.pm = pm; u.pn = pn; u.kind = 0; u.nt = 16; u.a = A + (size_t)pm * 256 * 1024 * 2; u.b = B + (size_t)pn * 256 * 1024 * 2; return true;
    }
};
struct EpiP8 {
    const float* x; float* out;
    __device__ __forceinline__ void operator()(const f32x4 (&acc)[2][2][4][2], const pg8::Unit& u, int wr, int wc, int fr, int fq) const {
        const int row0 = u.pm * 256 + wr * 64 + fr; const int col0 = u.pn * 256 + wc * 32 + 8 * fq;
#pragma unroll
        for (int ai = 0; ai < 2; ++ai)
#pragma unroll
            for (int m = 0; m < 4; ++m) { const size_t off = (size_t)(row0 + ai * 128 + m * 16) * DM + col0;
#pragma unroll
                for (int bj = 0; bj < 2; ++bj) { const f32x4 x0 = *(const f32x4*)(x + off + bj * 128), x1 = *(const f32x4*)(x + off + bj * 128 + 4);
                    *(f32x4*)(out + off + bj * 128) = x0 + acc[ai][bj][m][0]; *(f32x4*)(out + off + bj * 128 + 4) = x1 + acc[ai][bj][m][1]; } }
    }
};
__device__ __forceinline__ void p9_final_norm(Frame& F) {
    const int gw = F.vcu * NWAVES + F.wave, NGW = F.G * NWAVES;
    const GAS f32x4* gp = (const GAS f32x4*)KIN(19) + F.lane;
    f32x4 g[4];
#pragma unroll
    for (int j = 0; j < 4; ++j) g[j] = gp[64 * j];
    for (int m = gw; m < T; m += NGW) {
        GAS f32x4* xr = (GAS f32x4*)(F.out + (size_t)m * DM) + F.lane;
        f32x4 v[4]; float s = 0.f;
#pragma unroll
        for (int j = 0; j < 4; ++j) { v[j] = xr[64 * j]; s += (v[j].x * v[j].x + v[j].y * v[j].y) + (v[j].z * v[j].z + v[j].w * v[j].w); }
        const float rstd = 1.f / sqrtf(wave_sum(s) * (1.f / DM) + RMS_EPS);
#pragma unroll
        for (int j = 0; j < 4; ++j) xr[64 * j] = v[j] * rstd * g[j];
    }
}

constexpr int N_PHASES = 10;
struct Args { const float* in[20]; float* out; unsigned char* ws; int ph_lo, ph_hi, variant, pad; };
__global__ void __launch_bounds__(NWAVES * 64, 2) hybrid_fwd(Args args) {
    extern __shared__ __attribute__((aligned(16))) unsigned char lds[];
    Frame F;
    F.lds = (LAS unsigned char*)lds;
    F.MISC = (volatile LAS unsigned*)(F.lds + MISC_OFF);
    F.tid = threadIdx.x; F.lane = F.tid & 63; F.wave = __builtin_amdgcn_readfirstlane(F.tid >> 6);
    F.G = gridDim.x; { const int bx = blockIdx.x; F.vcu = (bx % 8) * (F.G / 8) + bx / 8; }
    F.out = args.out; F.ws = args.ws;
    unsigned char* ws = args.ws;
    for (int u = F.tid; u < (LDS_BYTES - LDSCTL_OFF) / 4; u += NWAVES * 64) ((LAS unsigned*)(F.lds + LDSCTL_OFF))[u] = 0u;
    __syncthreads();
    const int lo = args.ph_lo, hi = args.ph_hi;
    const bool multi = (hi - lo) > 1;
    XcdBarrier bar; bar.bar = (unsigned*)(ws + WS_CTL) + CW_BAR; bar.x = 0; bar.st = nullptr;
    if (multi) bar = xcd_barrier_post((unsigned*)(ws + WS_CTL) + CW_BAR, F.MISC + 8);
#ifndef PH_MASK
#define PH_MASK 0x3ff
#endif
#define IN(k) (((PH_MASK >> (k)) & 1) && lo <= (k) && (k) < hi)
#define SEAM(k) do { if (IN(k) && IN((k) + 1)) xcd_barrier(bar); } while (0)
#ifndef RPT_MASK
#define RPT_MASK 0
#endif
#define NREP(k) (((RPT_MASK >> (k)) & 1) ? 2 : 1)
#ifndef PROBE_VARIANTS
#define PROBE_VARIANTS 0
#endif
    if (IN(0)) { for (int rp = 0; rp < NREP(0); ++rp) { p0_prologue(F); __syncthreads(); } SEAM(0); }
    if (IN(1)) {
        SchedP1 S{(int)blockIdx.x, F.G, (const char*)(ws + WS_ACOMB), (const char*)(ws + WS_WINT)};
        EpiP1 E{(bf16*)(ws + WS_UA), (bf16*)(ws + WS_UB), (float*)(ws + WS_US)};
        for (int rp = 0; rp < NREP(1); ++rp) pg8::gemm_phase(F.lds + RING_OFF, ACOMB_LD, 1024, S, E);
        SEAM(1);
    }
    if (IN(2)) { p2_prep<0>(F); SEAM(2); }
    if (IN(3)) { for (int rp = 0; rp < NREP(3); ++rp) { p3_attention(F); __syncthreads(); } SEAM(3); }
    if (IN(4)) { p4_scan_a<0>(F); SEAM(4); }
    if (IN(5)) { p5_scan_b<0>(F); SEAM(5); }
    if (IN(6)) { for (int rp = 0; rp < NREP(6); ++rp) p6_scan_c(F); SEAM(6); }
    const int pm = F.vcu >> 2, pn = F.vcu & 3;
    if (IN(7)) {
        SchedP7 S{pm, pn, (const char*)(ws + WS_ACOMB), (const char*)(ws + WS_WINT), (const char*)(ws + WS_WAB)};
        EpiP7 E{(f32x4*)(ws + WS_UA) + (size_t)blockIdx.x * 16384, (f32x4*)(ws + WS_UB) + (size_t)blockIdx.x * 16384, (bf16*)(ws + WS_MERGED)};
        for (int rp = 0; rp < NREP(7); ++rp) pg8::gemm_phase(F.lds + RING_OFF, ACOMB_LD, 1024, S, E);
        SEAM(7);
    }
    if (IN(8)) {
        SchedP8 S{pm, pn, (const char*)(ws + WS_MERGED), (const char*)(ws + WS_WOUT)};
        EpiP8 E{KIN(0), F.out};
        for (int rp = 0; rp < NREP(8); ++rp) pg8::gemm_phase(F.lds + RING_OFF, 1024, 1024, S, E);
        SEAM(8);
    }
    if (IN(9)) { p9_final_norm(F); }
#undef IN
#undef SEAM
}


#if PROBE_VARIANTS
__global__ void __launch_bounds__(NWAVES * 64, 2) probe_fwd(Args args) {
    extern __shared__ __attribute__((aligned(16))) unsigned char lds[];
    Frame F;
    F.lds = (LAS unsigned char*)lds;
    F.MISC = (volatile LAS unsigned*)(F.lds + MISC_OFF);
    F.tid = threadIdx.x; F.lane = F.tid & 63; F.wave = __builtin_amdgcn_readfirstlane(F.tid >> 6);
    F.G = gridDim.x; { const int bx = blockIdx.x; F.vcu = (bx % 8) * (F.G / 8) + bx / 8; }
    F.out = args.out; F.ws = args.ws;
#ifndef PROBE_REP
#define PROBE_REP 1
#endif
    for (int rp = 0; rp < PROBE_REP; ++rp) {
    if (PROBE_VARIANTS == 1) p4_scan_a<1>(F);
    if (PROBE_VARIANTS == 2) p2_prep<1>(F);
    if (PROBE_VARIANTS == 3) p5_scan_b<1>(F);
    if (PROBE_VARIANTS == 4) p6_scan_c(F);
    if (PROBE_VARIANTS == 5) p0_prologue(F);
    __syncthreads(); }
}
#endif
#ifndef MK_N_LAUNCHES
#define MK_N_LAUNCHES 1
#endif
extern "C" void kernel_launch(void* const* d_in, const int* in_sizes, int n_in, void* d_out, int out_size, void* d_ws, size_t ws_size, hipStream_t stream) {
    static int grid = 0;
    if (grid == 0) {
        if (n_in != 20 || in_sizes[0] != T * DM || out_size != T * DM || ws_size < WS_END) { fprintf(stderr, "kernel_launch: unexpected shapes (n_in %d, in0 %d, out %d, ws %zu); nothing launched\n", n_in, n_in > 0 ? in_sizes[0] : -1, out_size, ws_size); grid = -1; return; }
        int dev = 0, cus = 0, per_cu = 0;
        if (hipGetDevice(&dev) != hipSuccess || hipDeviceGetAttribute(&cus, hipDeviceAttributeMultiprocessorCount, dev) != hipSuccess) { grid = -1; return; }
        #if PROBE_VARIANTS
        (void)hipFuncSetAttribute((const void*)probe_fwd, hipFuncAttributeMaxDynamicSharedMemorySize, LDS_BYTES);
#endif
        if (hipFuncSetAttribute((const void*)hybrid_fwd, hipFuncAttributeMaxDynamicSharedMemorySize, LDS_BYTES) != hipSuccess) { fprintf(stderr, "kernel_launch: hipFuncSetAttribute failed\n"); grid = -1; return; }
        if (hipOccupancyMaxActiveBlocksPerMultiprocessor(&per_cu, (const void*)hybrid_fwd, NWAVES * 64, LDS_BYTES) != hipSuccess || per_cu < 1) fprintf(stderr, "kernel_launch: note: occupancy query reports %d workgroups per CU\n", per_cu);
        (void)hipGetLastError();
        grid = 256;
        if (cus != 256) fprintf(stderr, "kernel_launch: device reports %d CUs; this kernel is built for 256\n", cus);
    }
    if (grid < 0) return;
    (void)hipMemsetAsync((char*)d_ws + WS_CTL, 0, CTL_ZERO_BYTES, stream);
    Args a{};
    for (int i = 0; i < 20; ++i) a.in[i] = (const float*)d_in[i];
    a.out = (float*)d_out; a.ws = (unsigned char*)d_ws;
    if (MK_N_LAUNCHES == 1) { a.ph_lo = 0; a.ph_hi = N_PHASES; hipLaunchKernelGGL(hybrid_fwd, dim3(grid), dim3(NWAVES * 64), LDS_BYTES, stream, a); }
#ifdef PROBE_LO
    if (MK_N_LAUNCHES == 1) { (void)hipMemsetAsync((char*)d_ws + WS_CTL, 0, CTL_ZERO_BYTES, stream); a.ph_lo = PROBE_LO; a.ph_hi = PROBE_HI; a.variant = PROBE_VARIANTS;
#if PROBE_VARIANTS
      hipLaunchKernelGGL(probe_fwd, dim3(grid), dim3(NWAVES * 64), LDS_BYTES, stream, a);
#else
      hipLaunchKernelGGL(hybrid_fwd, dim3(grid), dim3(NWAVES * 64), LDS_BYTES, stream, a);
#endif
    }
#endif
    else for (int p = 0; p < N_PHASES; ++p) { a.ph_lo = p; a.ph_hi = p + 1; hipLaunchKernelGGL(hybrid_fwd, dim3(grid), dim3(NWAVES * 64), LDS_BYTES, stream, a); }
}
```

```cpp
#include <hip/hip_runtime.h>
#include <hip/hip_bf16.h>
#include <cstdio>
#include <cstdint>
#include <cmath>

#define GAS __attribute__((address_space(1)))
#define LAS __attribute__((address_space(3)))
typedef unsigned short bf16;
typedef unsigned v4u __attribute__((ext_vector_type(4)));
typedef unsigned v2u __attribute__((ext_vector_type(2)));
typedef float f32x2 __attribute__((ext_vector_type(2)));
typedef float f32x4 __attribute__((ext_vector_type(4)));
typedef float f32x16 __attribute__((ext_vector_type(16)));
typedef short bf16x8 __attribute__((ext_vector_type(8)));
typedef short s16x4 __attribute__((ext_vector_type(4)));

constexpr int NB = 8, SEQ = 2048, DM = 1024, T = NB * SEQ, NH = 8, HD = 64;
constexpr int IN_COLS = 6280, NPAD = 6400;
constexpr float RMS_EPS = 1e-6f, LNX_EPS = 64e-5f;
constexpr float LOG2E = 1.4426950408889634f;
constexpr float C2 = 0.125f * LOG2E;

constexpr size_t MiB = 1u << 20;
constexpr size_t WS_CTL = 0, CTL_ZERO_BYTES = 64 * 1024;
constexpr size_t WS_WINT = 1 * MiB;
constexpr size_t WS_WAB = 14 * MiB;
constexpr size_t WS_WOUT = 16 * MiB;
constexpr size_t WS_G2 = 19 * MiB;
constexpr size_t WS_BONUS = 19 * MiB + 512 * 1024;
constexpr size_t WS_ACOMB = 20 * MiB;
constexpr size_t WS_UA = 84 * MiB;
constexpr size_t WS_UB = 148 * MiB;
constexpr size_t WS_US = 212 * MiB;
constexpr size_t WS_YLOC = 228 * MiB;
constexpr size_t WS_MERGED = 212 * MiB;
constexpr size_t WS_END = 256 * MiB;
constexpr int ACOMB_LD = 2048, U_LD = 2048;
constexpr int ZA_OFF = 1024, ZB_OFF = 1536;

#define RLX_AGENT __ATOMIC_RELAXED, __HIP_MEMORY_SCOPE_AGENT
#define LDS_WAIT() asm volatile("s_waitcnt lgkmcnt(0)" ::: "memory")
#define VM_WAIT() asm volatile("s_waitcnt vmcnt(0)" ::: "memory")

__device__ __forceinline__ unsigned f2bf(float f) { unsigned u = __builtin_bit_cast(unsigned, f); return (u + 0x7fffu + ((u >> 16) & 1u)) >> 16; }
__device__ __forceinline__ unsigned pk2(float lo, float hi) { return f2bf(lo) | (f2bf(hi) << 16); }
__device__ __forceinline__ float bf2f(unsigned b) { return __builtin_bit_cast(float, b << 16); }
__device__ __forceinline__ float bflo(unsigned w) { return __builtin_bit_cast(float, w << 16); }
__device__ __forceinline__ float bfhi(unsigned w) { return __builtin_bit_cast(float, w & 0xffff0000u); }
__device__ __forceinline__ float frcp(float x) { return __builtin_amdgcn_rcpf(x); }
__device__ __forceinline__ float fexp(float x) { return __builtin_amdgcn_exp2f(x * LOG2E); }
__device__ __forceinline__ float sigmoidf_(float x) { return frcp(1.0f + fexp(-x)); }
__device__ __forceinline__ float siluf_(float x) { return x * frcp(1.0f + fexp(-x)); }
__device__ __forceinline__ float wave_sum(float v) {
#pragma unroll
    for (int o = 1; o < 64; o <<= 1) v += __shfl_xor(v, o);
    return v;
}
template <int CTRL> __device__ __forceinline__ float dppf(float x) { return __builtin_bit_cast(float, __builtin_amdgcn_mov_dpp(__builtin_bit_cast(int, x), CTRL, 0xf, 0xf, true)); }
__device__ __forceinline__ float row16_sum(float v) { v += dppf<0x128>(v); v += dppf<0x124>(v); v += dppf<0x122>(v); v += dppf<0x121>(v); return v; }
namespace pg8 {
#define PG8_LAS __attribute__((address_space(3)))
typedef unsigned short bf16_t;
typedef unsigned u32x4 __attribute__((ext_vector_type(4)));
constexpr int BM = 256, BK = 64, HALF = 128, HTB = HALF * BK * 2  , STAGE_BYTES = 8 * HTB;

__host__ __device__ __forceinline__ int lds_byte(int r, int c) { const int st = (r >> 4) * 2 + (c >> 5), rr = r & 15, cc = c & 31, ob = rr * 64 + cc * 2; return st * 1024 + (ob ^ (((ob >> 9) & 1) << 5)); }
__host__ __device__ __forceinline__ void stage_rc(int b, int& R, int& C) { const int st = b / 1024, sb = b % 1024, swz = sb ^ (((sb >> 9) & 1) << 5); R = (st >> 1) * 16 + swz / 64; C = (st & 1) * 32 + (swz % 64) / 2; }
__host__ __device__ __forceinline__ int perm32(int rho) { const int n = rho >> 4, i = rho & 15; return 8 * (i >> 2) + 4 * n + (i & 3); }

struct Unit { int pm, pn, kind, nt; const char* a; const char* b; };

__device__ __forceinline__ unsigned cvt_pk_bf16(float lo, float hi) { unsigned r; asm volatile("v_cvt_pk_bf16_f32 %0, %1, %2" : "=v"(r) : "v"(lo), "v"(hi)); return r; }

template <class Epi, class Sched>
__device__ __forceinline__ void gemm_phase(PG8_LAS unsigned char* lds, const int lda, const int ldb, const Sched& S, const Epi& E) {
    int tid = threadIdx.x; asm volatile("" : "+v"(tid));
    const int wid = __builtin_amdgcn_readfirstlane(tid >> 6), lane = tid & 63, wr = wid >> 2, wc = wid & 3, fr = lane & 15, fq = lane >> 4;
    unsigned voffA[2], voffB[2];
#pragma unroll
    for (int i = 0; i < 2; ++i) { int R, C; stage_rc(tid * 16 + i * 8192, R, C); const int Rb = (R & ~31) + perm32(R & 31);
        voffA[i] = (unsigned)(R * lda + C) * 2u; voffB[i] = (unsigned)(Rb * ldb + C) * 2u; }
    const size_t kstep = (size_t)(BK * 2);
    const size_t hstepA = (size_t)HALF * lda * 2, hstepB = (size_t)HALF * ldb * 2;
    const unsigned ldsw = (unsigned)wid * 1024u;
    const int aoff = lds_byte(wr * 64 + fr, fq * 8), boff = lds_byte(wc * 32 + fr, fq * 8);
#define PG8_SA(b, h) (((b) * 2 + (h)) * HTB)
#define PG8_SB(b, h) ((4 + (b) * 2 + (h)) * HTB)
#define PG8_STAGE(bufoff, gbase, voff) do { _Pragma("unroll") for (int _i = 0; _i < 2; ++_i) \
        __builtin_amdgcn_global_load_lds((const unsigned*)((const char*)(gbase) + (voff)[_i]), (PG8_LAS unsigned*)(lds + (bufoff) + ldsw + _i * 8192), 16, 0, 0); } while (0)
#define PG8_LDA(dst, b, h) do { _Pragma("unroll") for (int m = 0; m < 4; ++m) _Pragma("unroll") for (int k = 0; k < 2; ++k) dst[m][k] = *(const PG8_LAS bf16x8*)(lds + PG8_SA(b, h) + aoff + m * 2048 + k * 1024); } while (0)
#define PG8_LDB(dst, b, h) do { _Pragma("unroll") for (int n = 0; n < 2; ++n) _Pragma("unroll") for (int k = 0; k < 2; ++k) dst[n][k] = *(const PG8_LAS bf16x8*)(lds + PG8_SB(b, h) + boff + n * 2048 + k * 1024); } while (0)
#define PG8_MMA(ai, bj, At, Bt) do { __builtin_amdgcn_s_setprio(1); _Pragma("unroll") for (int m = 0; m < 4; ++m) _Pragma("unroll") for (int n = 0; n < 2; ++n) _Pragma("unroll") for (int k = 0; k < 2; ++k) \
        acc[ai][bj][m][n] = __builtin_amdgcn_mfma_f32_16x16x32_bf16(Bt[n][k], At[m][k], acc[ai][bj][m][n], 0, 0, 0); __builtin_amdgcn_s_setprio(0); } while (0)
#define PG8_WAIT_V(n) asm volatile("s_waitcnt vmcnt(" #n ")" ::: "memory")
#define PG8_WAIT_L(n) asm volatile("s_waitcnt lgkmcnt(" #n ")" ::: "memory")
#define PG8_BAR __builtin_amdgcn_s_barrier()
#define PG8_SCHED __builtin_amdgcn_sched_barrier(0)
    Unit cur, nxt; int ui = 0;
    if (!S.next(0, cur)) return;
    f32x4 acc[2][2][4][2];
#pragma unroll
    for (int a = 0; a < 2; ++a)
#pragma unroll
        for (int b = 0; b < 2; ++b)
#pragma unroll
            for (int m = 0; m < 4; ++m)
#pragma unroll
                for (int n = 0; n < 2; ++n) acc[a][b][m][n] = (f32x4){0.f, 0.f, 0.f, 0.f};
    bf16x8 At[4][2], B0[2][2], B1[2][2];
    const char* cA = cur.a; const char* cB = cur.b;
    PG8_STAGE(PG8_SB(0, 0), cB, voffB); PG8_STAGE(PG8_SB(0, 1), cB + hstepB, voffB); PG8_STAGE(PG8_SA(0, 0), cA, voffA); PG8_STAGE(PG8_SA(0, 1), cA + hstepA, voffA);
    if (wr == 1) PG8_BAR;
    PG8_WAIT_V(2); PG8_BAR;
    PG8_STAGE(PG8_SB(1, 0), cB + kstep, voffB); PG8_STAGE(PG8_SA(1, 0), cA + kstep, voffA); PG8_STAGE(PG8_SB(1, 1), cB + hstepB + kstep, voffB);
    PG8_WAIT_V(6); PG8_BAR;
    for (;;) {
        const bool has_next = S.next(ui + 1, nxt);
        const char* nA = has_next ? nxt.a : cA; const char* nB = has_next ? nxt.b : cB;
        const int nt = cur.nt;
        for (int t = 0; t < nt; t += 2) {
            const bool last = (t == nt - 2);
            const char* a1 = cA + (size_t)(t + 1) * kstep;
            const char* a2 = last ? nA : cA + (size_t)(t + 2) * kstep; const char* b2 = last ? nB : cB + (size_t)(t + 2) * kstep;
            const char* a3 = a2 + kstep; const char* b3 = b2 + kstep;
            PG8_LDB(B0, 0, 0); PG8_LDB(B1, 0, 1); PG8_SCHED; PG8_LDA(At, 0, 0); PG8_STAGE(PG8_SA(1, 1), a1 + hstepA, voffA);
            PG8_WAIT_V(8); PG8_WAIT_L(0); PG8_BAR; PG8_MMA(0, 0, At, B0); PG8_MMA(0, 1, At, B1); PG8_BAR; PG8_SCHED;
            PG8_LDA(At, 0, 1); PG8_STAGE(PG8_SB(0, 0), b2, voffB); PG8_STAGE(PG8_SB(0, 1), b2 + hstepB, voffB); PG8_STAGE(PG8_SA(0, 0), a2, voffA);
            PG8_WAIT_V(8); PG8_WAIT_L(0); PG8_BAR; PG8_MMA(1, 0, At, B0); PG8_MMA(1, 1, At, B1); PG8_BAR; PG8_SCHED;
            PG8_LDB(B0, 1, 0); PG8_LDB(B1, 1, 1); PG8_SCHED; PG8_LDA(At, 1, 0); PG8_STAGE(PG8_SA(0, 1), a2 + hstepA, voffA);
            PG8_WAIT_V(8); PG8_WAIT_L(0); PG8_BAR; PG8_MMA(0, 0, At, B0); PG8_MMA(0, 1, At, B1); PG8_BAR; PG8_SCHED;
            PG8_LDA(At, 1, 1); PG8_STAGE(PG8_SB(1, 0), b3, voffB); PG8_STAGE(PG8_SB(1, 1), b3 + hstepB, voffB); PG8_STAGE(PG8_SA(1, 0), a3, voffA);
            PG8_WAIT_V(8); PG8_WAIT_L(0); PG8_BAR; PG8_MMA(1, 0, At, B0); PG8_MMA(1, 1, At, B1); PG8_BAR; PG8_SCHED;
        }
        if (wr == 0) PG8_BAR;
        E(acc, cur, wr, wc, fr, fq);
        if (!has_next) break;
#pragma unroll
        for (int a = 0; a < 2; ++a)
#pragma unroll
            for (int b = 0; b < 2; ++b)
#pragma unroll
                for (int m = 0; m < 4; ++m)
#pragma unroll
                    for (int n = 0; n < 2; ++n) acc[a][b][m][n] = (f32x4){0.f, 0.f, 0.f, 0.f};
        cur = nxt; cA = nA; cB = nB; ++ui;
        if (wr == 1) PG8_BAR;
    }
    PG8_WAIT_V(0);
    PG8_BAR;
#undef PG8_SA
#undef PG8_SB
#undef PG8_STAGE
#undef PG8_LDA
#undef PG8_LDB
#undef PG8_MMA
#undef PG8_WAIT_V
#undef PG8_WAIT_L
#undef PG8_BAR
#undef PG8_SCHED
}
}
typedef GAS unsigned gu32;
#define XB_TMO      128
#define XB_XCNT(j)  (256  + 64 * (j))
#define XB_XSUB(j)  (1280 + 64 * (j))
#define XB_XGEN(j)  (2304 + 64 * (j))
#define XB_TOP      3328
#define XB_TOPGEN   3392
#define XCD_BAR_WORDS 3456
#define XB_SPIN_CAP (1u << 18)
__device__ __forceinline__ unsigned xb_ld(unsigned* p)              { return __hip_atomic_load(p, __ATOMIC_RELAXED, __HIP_MEMORY_SCOPE_AGENT); }
__device__ __forceinline__ unsigned xb_add(unsigned* p, unsigned v) { return __hip_atomic_fetch_add(p, v, __ATOMIC_RELAXED, __HIP_MEMORY_SCOPE_AGENT); }
__device__ __forceinline__ unsigned xb_xcc_id() { return (unsigned)__builtin_amdgcn_s_getreg((3 << 11) | 20) & 0xFu; }
#define XB_SPIN(cond, bar) do { unsigned _sp = 0; while (cond) { __builtin_amdgcn_s_sleep(1); \
    if ((++_sp & 255u) == 0u) { if (xb_ld(&(bar)[XB_TMO])) break; if (_sp > XB_SPIN_CAP) { atomicAdd(&(bar)[XB_TMO], 1u); break; } } } } while (0)
struct XcdBarrier { unsigned* bar; unsigned x; volatile LAS unsigned* st; };
__device__ __forceinline__ XcdBarrier xcd_barrier_post(unsigned* bar, volatile LAS unsigned* st) {
    XcdBarrier b; b.bar = bar; b.x = xb_xcc_id(); b.st = st;
    if (threadIdx.x == 0) (void)xb_add(&bar[XB_XCNT(b.x)], 1u);
    return b;
}
__device__ __forceinline__ void xcd_barrier_complete(unsigned* bar, unsigned x, unsigned& nloc, unsigned& nx) {
    const unsigned G = gridDim.x * gridDim.y * gridDim.z;
    unsigned sum, cnt, mine, sp = 0u;
    for (;;) {
        sum = 0u; cnt = 0u; mine = 0u;
#pragma unroll
        for (unsigned j = 0; j < 16; ++j) { const unsigned c = xb_ld(&bar[XB_XCNT(j)]); sum += c; cnt += (c > 0u) ? 1u : 0u; mine = (j == x) ? c : mine; }
        if (sum == G) break;
        __builtin_amdgcn_s_sleep(1);
        if ((++sp & 255u) == 0u) { if (xb_ld(&bar[XB_TMO])) break; if (sp > XB_SPIN_CAP) { atomicAdd(&bar[XB_TMO], 1u); break; } }
    }
    nloc = mine > 0u ? mine : 1u; nx = cnt > 0u ? cnt : 1u;
}
__device__ __forceinline__ void xcd_barrier(const XcdBarrier& b) {
    asm volatile("s_waitcnt vmcnt(0)" ::: "memory");
    __syncthreads();
    if (threadIdx.x == 0) {
        unsigned* bar = b.bar;
        __builtin_amdgcn_s_waitcnt(0);
        unsigned nloc = b.st[0], nx = b.st[1];
        if (nloc == 0u) { xcd_barrier_complete(bar, b.x, nloc, nx); b.st[0] = nloc; b.st[1] = nx; }
        const unsigned old = xb_add(&bar[XB_XSUB(b.x)], 1u);
        const unsigned gen = old / nloc;
        if (old + 1u == (gen + 1u) * nloc) {
            __builtin_amdgcn_fence(__ATOMIC_RELEASE, "agent");
            asm volatile("s_waitcnt vmcnt(0)" ::: "memory");
            const unsigned og = xb_add(&bar[XB_TOP], 1u);
            const unsigned tg = og / nx;
            if (og + 1u == (tg + 1u) * nx) xb_add(&bar[XB_TOPGEN], 1u);
            else XB_SPIN(xb_ld(&bar[XB_TOPGEN]) == tg, bar);
            __builtin_amdgcn_fence(__ATOMIC_ACQUIRE, "agent");
            xb_add(&bar[XB_XGEN(b.x)], 1u);
            asm volatile("s_waitcnt vmcnt(0)" ::: "memory");
        } else {
            XB_SPIN(xb_ld(&bar[XB_XGEN(b.x)]) == gen, bar);
            __builtin_amdgcn_fence(__ATOMIC_ACQUIRE, "agent");
            asm volatile("s_waitcnt vmcnt(0)" ::: "memory");
        }
    }
    __syncthreads();
}

constexpr int RING_OFF = 0, RING_BYTES = 131072;
constexpr int LDSCTL_OFF = RING_BYTES, MISC_OFF = LDSCTL_OFF + 320;
constexpr int LDS_BYTES = 147456;
constexpr int NWAVES = 8;
constexpr int CW_BAR = 4096;

struct Frame {
    LAS unsigned char* lds;
    volatile LAS unsigned* MISC;
    int tid, lane, wave, vcu, G;
    float* out; unsigned char* ws;
};
typedef __attribute__((address_space(4))) const unsigned char* kargp_t;
__device__ __forceinline__ const float* karg_in(int i) { kargp_t p = (kargp_t)__builtin_amdgcn_kernarg_segment_ptr(); asm volatile("" : "+s"(p)); return *(const float* const __attribute__((address_space(4)))*)(p + 8 * i); }
#define KIN(k) karg_in(k)
__device__ __forceinline__ void p0_transpose_item(const float* W, int ldw, bf16* WT, int ldt, int koff, LAS float* scr, int k0, int n0, int scol0, int nvalid, int lane) {
    const int li = lane & 31; const bool ok = li < nvalid;
#pragma unroll 8
    for (int i = 0; i < 32; ++i) { const int kk = 2 * i + (lane >> 5); scr[kk * 33 + li] = ok ? W[(size_t)(k0 + kk) * ldw + scol0 + li] : 0.f; }
    LDS_WAIT(); asm volatile("" ::: "memory");
    const int c = lane & 7;
#pragma unroll
    for (int j = 0; j < 4; ++j) { const int n = (lane >> 3) + 8 * j; const LAS float* s = scr + (8 * c) * 33 + n;
        v4u o; o.x = pk2(s[0 * 33], s[1 * 33]); o.y = pk2(s[2 * 33], s[3 * 33]); o.z = pk2(s[4 * 33], s[5 * 33]); o.w = pk2(s[6 * 33], s[7 * 33]);
        *(GAS v4u*)(WT + (size_t)(n0 + n) * ldt + koff + k0 + 8 * c) = o; }
    LDS_WAIT(); asm volatile("" ::: "memory");
}
__device__ __forceinline__ void win_map(int n0, int& scol0, int& nvalid) {
    nvalid = 32;
    if (n0 < 1536) scol0 = n0;
    else if (n0 < 4096) scol0 = n0 + 128;
    else if (n0 < 6144) scol0 = n0 + 136;
    else if (n0 < 6272) scol0 = n0 - 6144 + 1536;
    else if (n0 == 6272) { scol0 = 4224; nvalid = 8; }
    else { scol0 = 0; nvalid = 0; }
}
__device__ __forceinline__ void p0_prologue(Frame& F) {
    LAS float* scr = (LAS float*)(F.lds + RING_OFF + F.wave * 16384);
    const int gw = F.vcu * NWAVES + F.wave, NGW = F.G * NWAVES;
    bf16* WinT = (bf16*)(F.ws + WS_WINT); bf16* Wab = (bf16*)(F.ws + WS_WAB); bf16* WoutT = (bf16*)(F.ws + WS_WOUT);
    const float* w_in = KIN(2); const float* w_oa = KIN(16); const float* w_ob = KIN(17); const float* w_o = KIN(18);
    constexpr int I_IN = 16 * 200, I_AB = 8 * 32, I_OUT = 16 * 32;
    constexpr int NITEMS = I_IN + 2 * I_AB + I_OUT;
    for (int it = gw; it < NITEMS; it += NGW) {
        int r = it;
        if (r < I_IN) { const int kb = r / 200, nb = r % 200; int sc, nv; win_map(32 * nb, sc, nv); p0_transpose_item(w_in, IN_COLS, WinT, 1024, 0, scr, 64 * kb, 32 * nb, sc, nv, F.lane); continue; } r -= I_IN;
        if (r < I_AB) { const int kb = r / 32, nb = r % 32; p0_transpose_item(w_oa, 1024, Wab, 1024, 0, scr, 64 * kb, 32 * nb, 32 * nb, 32, F.lane); continue; } r -= I_AB;
        if (r < I_AB) { const int kb = r / 32, nb = r % 32; p0_transpose_item(w_ob, 1024, Wab, 1024, 512, scr, 64 * kb, 32 * nb, 32 * nb, 32, F.lane); continue; } r -= I_AB;
        { const int kb = r / 32, nb = r % 32; p0_transpose_item(w_o, 1024, WoutT, 1024, 0, scr, 64 * kb, 32 * nb, 32 * nb, 32, F.lane); }
    }
    bf16* Acomb = (bf16*)(F.ws + WS_ACOMB);
    const GAS f32x4* gp = (const GAS f32x4*)KIN(1) + F.lane;
    f32x4 g[4];
#pragma unroll
    for (int j = 0; j < 4; ++j) g[j] = gp[64 * j];
    const float* xin = KIN(0);
    for (int m = gw; m < T; m += NGW) {
        const GAS f32x4* xr = (const GAS f32x4*)(xin + (size_t)m * DM) + F.lane;
        f32x4 v[4]; float s = 0.f;
#pragma unroll
        for (int j = 0; j < 4; ++j) { v[j] = xr[64 * j]; s += (v[j].x * v[j].x + v[j].y * v[j].y) + (v[j].z * v[j].z + v[j].w * v[j].w); }
        const float rstd = 1.f / sqrtf(wave_sum(s) * (1.f / DM) + RMS_EPS);
        GAS unsigned long long* o8 = (GAS unsigned long long*)(Acomb + (size_t)m * ACOMB_LD) + F.lane;
#pragma unroll
        for (int j = 0; j < 4; ++j) o8[64 * j] = (unsigned long long)pk2(v[j].x * rstd * g[j].x, v[j].y * rstd * g[j].y) | ((unsigned long long)pk2(v[j].z * rstd * g[j].z, v[j].w * rstd * g[j].w) << 32);
    }
}

struct SchedP1 {
    int c, G; const char* A; const char* B;
    __device__ __forceinline__ bool next(int i, pg8::Unit& u) const {
        constexpr int nM = 64, nN = 17, nwg = nM * nN, NX = 8, WGM = 8;
        const int L = i * G + c; if (L >= nwg) return false;
        int wgid = L; { const int q = nwg / NX, r = nwg % NX, xcd = wgid % NX, off = wgid / NX; wgid = (xcd < r ? xcd * (q + 1) : r * (q + 1) + (xcd - r) * q) + off; }
        const int nig = WGM * nN, gid = wgid / nig, fm = gid * WGM;
        u.pm = fm + ((wgid % nig) % WGM); int pn = (wgid % nig) / WGM; u.pn = pn == 16 ? 24 : pn; u.kind = 0; u.nt = 16;
        u.a = A + (size_t)u.pm * 256 * ACOMB_LD * 2; u.b = B + (size_t)u.pn * 256 * 1024 * 2; return true;
    }
};
struct EpiP1 {
    bf16* UA; bf16* UB; float* US;
    __device__ __forceinline__ void operator()(const f32x4 (&acc)[2][2][4][2], const pg8::Unit& u, int wr, int wc, int fr, int fq) const {
        const int row0 = u.pm * 256 + wr * 64 + fr;
        if (u.pn < 16) {
            bf16* base = (u.pn < 8 ? UA + u.pn * 256 : UB + (u.pn - 8) * 256) + wc * 32 + 8 * fq;
#pragma unroll
            for (int ai = 0; ai < 2; ++ai)
#pragma unroll
                for (int m = 0; m < 4; ++m) { bf16* rowp = base + (size_t)(row0 + ai * 128 + m * 16) * U_LD;
#pragma unroll
                    for (int bj = 0; bj < 2; ++bj) { const f32x4 v0 = acc[ai][bj][m][0], v1 = acc[ai][bj][m][1];
                        pg8::u32x4 w; w.x = pg8::cvt_pk_bf16(v0[0], v0[1]); w.y = pg8::cvt_pk_bf16(v0[2], v0[3]); w.z = pg8::cvt_pk_bf16(v1[0], v1[1]); w.w = pg8::cvt_pk_bf16(v1[2], v1[3]);
                        *(pg8::u32x4*)(rowp + bj * 128) = w; } }
        } else {
            float* base = US + wc * 32 + 8 * fq;
#pragma unroll
            for (int ai = 0; ai < 2; ++ai)
#pragma unroll
                for (int m = 0; m < 4; ++m) { float* rowp = base + (size_t)(row0 + ai * 128 + m * 16) * 256;
#pragma unroll
                    for (int bj = 0; bj < 2; ++bj) { *(f32x4*)(rowp + bj * 128) = acc[ai][bj][m][0]; *(f32x4*)(rowp + bj * 128 + 4) = acc[ai][bj][m][1]; } }
        }
    }
};

__device__ __forceinline__ float softplusf_(float x) { return fmaxf(x, 0.f) + __builtin_amdgcn_logf(1.0f + fexp(-fabsf(x))) * 0.6931471805599453f; }
__device__ __forceinline__ float ftanh(float x) { return 1.0f - 2.0f * frcp(fexp(2.0f * x) + 1.0f); }
template <int PRB> __device__ __forceinline__ void p2_prep(Frame& F) {
    const int lane = F.lane, wave = F.wave, tid = F.tid, fr = lane & 15, fq = lane >> 4;
    const float* US = (const float*)(F.ws + WS_US);
    const float* mu = KIN(3);
    const int r0 = F.vcu * 64;
    LAS bf16* At = (LAS bf16*)(F.lds + RING_OFF);
    LAS bf16* Aa = At + 64 * 72;
    {
        const int row = tid >> 3, c8 = (tid & 7) * 8; const int m = r0 + row; const bool first = (m % SEQ) == 0; const int mp = first ? m : m - 1;
        const f32x4 cw0 = *(const f32x4*)(US + (size_t)m * 256 + c8), cw1 = *(const f32x4*)(US + (size_t)m * 256 + c8 + 4), ca0 = *(const f32x4*)(US + (size_t)m * 256 + 64 + c8), ca1 = *(const f32x4*)(US + (size_t)m * 256 + 64 + c8 + 4);
        f32x4 pw0 = *(const f32x4*)(US + (size_t)mp * 256 + c8), pw1 = *(const f32x4*)(US + (size_t)mp * 256 + c8 + 4), pa0 = *(const f32x4*)(US + (size_t)mp * 256 + 64 + c8), pa1 = *(const f32x4*)(US + (size_t)mp * 256 + 64 + c8 + 4);
        if (first) { pw0 = (f32x4){0.f, 0.f, 0.f, 0.f}; pw1 = pw0; pa0 = pw0; pa1 = pw0; }
        const f32x4 mw0 = *(const f32x4*)(mu + 1536 + c8), mw1 = *(const f32x4*)(mu + 1536 + c8 + 4), ma0 = *(const f32x4*)(mu + 1600 + c8), ma1 = *(const f32x4*)(mu + 1600 + c8 + 4);
        const f32x4 w0 = cw0 + (pw0 - cw0) * mw0, w1 = cw1 + (pw1 - cw1) * mw1, a0 = ca0 + (pa0 - ca0) * ma0, a1 = ca1 + (pa1 - ca1) * ma1;
        v4u ow, oa;
        ow.x = pk2(ftanh(w0[0]), ftanh(w0[1])); ow.y = pk2(ftanh(w0[2]), ftanh(w0[3])); ow.z = pk2(ftanh(w1[0]), ftanh(w1[1])); ow.w = pk2(ftanh(w1[2]), ftanh(w1[3]));
        oa.x = pk2(a0[0], a0[1]); oa.y = pk2(a0[2], a0[3]); oa.z = pk2(a1[0], a1[1]); oa.w = pk2(a1[2], a1[3]);
        *(LAS v4u*)(At + row * 72 + c8) = ow; *(LAS v4u*)(Aa + row * 72 + c8) = oa;
    }
    __syncthreads();
    {
        float* DEC = PRB ? (float*)(F.ws + WS_UA) : F.out; float* LR = DEC + (size_t)T * 512;
        const float* wup = KIN(4); const float* aup = KIN(6); const float* w0p = KIN(5); const float* a0p = KIN(7);
        bf16x8 bt[4][2], ba[4][2];
#pragma unroll
        for (int tt = 0; tt < 4; ++tt)
#pragma unroll
            for (int ks = 0; ks < 2; ++ks) { bt[tt][ks] = *(const LAS bf16x8*)(At + (16 * tt + fr) * 72 + 32 * ks + 8 * fq); ba[tt][ks] = *(const LAS bf16x8*)(Aa + (16 * tt + fr) * 72 + 32 * ks + 8 * fq); }
#pragma unroll 1
        for (int ct = 0; ct < 4; ++ct) {
            const int chA = 64 * wave + 16 * ct + fr;
            bf16x8 wf[2], af[2];
#pragma unroll
            for (int ks = 0; ks < 2; ++ks) { float x[8], y[8];
#pragma unroll
                for (int j = 0; j < 8; ++j) { x[j] = wup[(size_t)(32 * ks + 8 * fq + j) * 512 + chA]; y[j] = aup[(size_t)(32 * ks + 8 * fq + j) * 512 + chA]; }
                v4u w; w.x = pk2(x[0], x[1]); w.y = pk2(x[2], x[3]); w.z = pk2(x[4], x[5]); w.w = pk2(x[6], x[7]); wf[ks] = __builtin_bit_cast(bf16x8, w);
                v4u a; a.x = pk2(y[0], y[1]); a.y = pk2(y[2], y[3]); a.z = pk2(y[4], y[5]); a.w = pk2(y[6], y[7]); af[ks] = __builtin_bit_cast(bf16x8, a); }
            const int ch4 = 64 * wave + 16 * ct + 4 * fq;
            const f32x4 w0v = *(const f32x4*)(w0p + ch4), a0v = *(const f32x4*)(a0p + ch4);
#pragma unroll
            for (int tt = 0; tt < 4; ++tt) {
                f32x4 aw = (f32x4){0.f, 0.f, 0.f, 0.f}, aa = aw;
#pragma unroll
                for (int ks = 0; ks < 2; ++ks) { aw = __builtin_amdgcn_mfma_f32_16x16x32_bf16(wf[ks], bt[tt][ks], aw, 0, 0, 0); aa = __builtin_amdgcn_mfma_f32_16x16x32_bf16(af[ks], ba[tt][ks], aa, 0, 0, 0); }
                f32x4 dv, lv;
#pragma unroll
                for (int e = 0; e < 4; ++e) { const float z = w0v[e] + aw[e]; const float w = -softplusf_(-z) - 0.5f; dv[e] = fexp(-fexp(w)); lv[e] = sigmoidf_(a0v[e] + aa[e]); }
                const size_t o = (size_t)(r0 + 16 * tt + fr) * 512 + ch4;
                *(f32x4*)(DEC + o) = dv; *(f32x4*)(LR + o) = lv;
            }
        }
    }
    {
        bf16* UB = (bf16*)(F.ws + WS_UB);
        const int d0 = (lane & 7) * 8;
        float gq[8], gk[8];
        { const float* qg = KIN(14); const float* kg = KIN(15);
#pragma unroll
        for (int e = 0; e < 8; ++e) { gq[e] = qg[d0 + e] * C2; gk[e] = kg[d0 + e]; } }
#pragma unroll 1
        for (int it = 0; it < 4; ++it) {
            v4u w[4]; GAS v4u* p[4];
#pragma unroll
            for (int u = 0; u < 4; ++u) { const int tsk = wave * 16 + it * 4 + u; const int m = r0 + (tsk >> 1), which = tsk & 1;
                p[u] = (GAS v4u*)(UB + (size_t)m * U_LD + which * 512) + lane; w[u] = *p[u]; }
#pragma unroll
            for (int u = 0; u < 4; ++u) { const int which = u & 1;
                float x[8] = {bflo(w[u].x), bfhi(w[u].x), bflo(w[u].y), bfhi(w[u].y), bflo(w[u].z), bfhi(w[u].z), bflo(w[u].w), bfhi(w[u].w)};
                float s = 0.f;
#pragma unroll
                for (int e = 0; e < 8; ++e) s += x[e] * x[e];
                s += dppf<0xB1>(s); s += dppf<0x4E>(s); s += dppf<0x141>(s);
                const float rs = 1.f / sqrtf(s * (1.f / 64.f) + RMS_EPS);
#pragma unroll
                for (int e = 0; e < 8; ++e) x[e] = x[e] * rs * (which ? gk[e] : gq[e]);
                v4u o; o.x = pk2(x[0], x[1]); o.y = pk2(x[2], x[3]); o.z = pk2(x[4], x[5]); o.w = pk2(x[6], x[7]);
                if (PRB) *((GAS v4u*)((bf16*)(F.ws + WS_UA) + ((char*)p[u] - (char*)UB) / 2)) = o; else *p[u] = o; }
        }
    }
    __syncthreads();
    if (F.vcu < 64) {
        const int b = F.vcu >> 3, h = F.vcu & 7; const float fb = KIN(13)[h];
        float* G2 = (float*)(F.ws + (PRB ? WS_UB : WS_G2)) + (size_t)F.vcu * SEQ + 4 * tid;
        LAS float* wtot = (LAS float*)(F.lds + RING_OFF);
        float v[4]; float run = 0.f;
#pragma unroll
        for (int i = 0; i < 4; ++i) v[i] = US[(size_t)(b * SEQ + 4 * tid + i) * 256 + 128 + h] + fb;
#pragma unroll
        for (int i = 0; i < 4; ++i) { run += -softplusf_(-v[i]) * LOG2E; v[i] = run; }
        float ex = run;
#pragma unroll
        for (int o = 1; o < 64; o <<= 1) { const float nn = __shfl_up(ex, o); if (lane >= o) ex += nn; }
        if (lane == 63) wtot[wave] = ex;
        __syncthreads();
        float woff = 0.f;
#pragma unroll
        for (int w = 0; w < 8; ++w) { const float tw = wtot[w]; if (w < wave) woff += tw; }
        const float off = woff + ex - run;
        *(f32x4*)G2 = (f32x4){v[0] + off, v[1] + off, v[2] + off, v[3] + off};
    }
    __syncthreads();
}
__device__ __forceinline__ int crow(int r, int hi) { return (r & 3) + 8 * (r >> 2) + 4 * hi; }
__device__ __forceinline__ s16x4 vtr(const LAS char* p) { typedef short v4i16_t __attribute__((ext_vector_type(4))); return __builtin_bit_cast(s16x4, __builtin_amdgcn_ds_read_tr16_b64_v4i16((LAS v4i16_t*)p)); }
__device__ __forceinline__ unsigned cvtpk_s(float lo, float hi) { typedef __bf16 bf16x2_t __attribute__((ext_vector_type(2))); f32x2 v = {lo, hi}; bf16x2_t b = __builtin_convertvector(v, bf16x2_t); return __builtin_bit_cast(unsigned, b); }

constexpr int AT_K = 0, AT_V = 8192, AT_BIAS = 16384, AT_WS = 16640, AT_OST = 20480;

__device__ __forceinline__ void attn_unit(Frame& F, int b, int h, int qb) {
    const int tid = F.tid, lane = F.lane, r32 = lane & 31, hi = lane >> 5, wid = F.wave;
    const bf16* UB = (const bf16*)(F.ws + WS_UB);
    const float* G2 = (const float*)(F.ws + WS_G2) + (size_t)(b * NH + h) * SEQ;
    bf16* Acomb = (bf16*)(F.ws + WS_ACOMB);
    LAS char* lds = (LAS char*)F.lds;
    const long rowbase = (long)b * SEQ; const int q0 = qb * 256; const int qrow = q0 + wid * 32 + r32;
    const bf16* Qw = UB + (rowbase + q0 + wid * 32) * U_LD + h * 64;
    bf16x8 qr[4];
#pragma unroll
    for (int d0 = 0; d0 < 4; ++d0) qr[d0] = *(const bf16x8*)(Qw + (long)r32 * U_LD + d0 * 16 + hi * 8);
    const float gq = G2[qrow];
    float m_run = -1e30f, l_run = 0.f; f32x16 o[2]; o[0] = f32x16{}; o[1] = f32x16{};
    LAS float* wsf = (LAS float*)(lds + AT_WS) + wid * 64;
    LAS float* biasl = (LAS float*)(lds + AT_BIAS);
    const int NT = (q0 + 256) / 64;
    const int kvl = tid >> 3, ch = tid & 7;
    const LAS char* kp0 = lds + AT_K + hi * 1024 + r32 * 16;
    const LAS char* vp0 = lds + AT_V + ((lane >> 4) & 1) * 32 + (lane & 3) * 8 + (4 * hi + ((lane & 15) >> 2)) * 64;
    for (int t = 0; t < NT; ++t) {
        __syncthreads();
        { const bf16* src = UB + (rowbase + 64 * t + kvl) * U_LD + h * 64 + 8 * ch;
          const v4u kx = *(const v4u*)(src + 512), vx = *(const v4u*)(src + 1024);
          *(LAS v4u*)(lds + AT_K + ch * 1024 + kvl * 16) = kx;
          *(LAS v4u*)(lds + AT_V + (ch >> 2) * 4096 + kvl * 64 + (ch & 3) * 16) = vx;
          if (tid < 64) biasl[tid] = G2[64 * t + tid]; }
        __syncthreads();
        if (64 * t > q0 + wid * 32 + 31) continue;
        f32x16 p0 = f32x16{}, p1 = f32x16{};
#pragma unroll
        for (int d0 = 0; d0 < 4; ++d0) {
            const bf16x8 b0 = *(const LAS bf16x8*)(kp0 + d0 * 2048), b1 = *(const LAS bf16x8*)(kp0 + d0 * 2048 + 512);
            p0 = __builtin_amdgcn_mfma_f32_32x32x16_bf16(b0, qr[d0], p0, 0, 0, 0);
            p1 = __builtin_amdgcn_mfma_f32_32x32x16_bf16(b1, qr[d0], p1, 0, 0, 0);
        }
        float rm = -INFINITY;
#pragma unroll
        for (int g4 = 0; g4 < 4; ++g4) {
            const f32x4 gk0 = *(const LAS f32x4*)(biasl + 8 * g4 + 4 * hi), gk1 = *(const LAS f32x4*)(biasl + 32 + 8 * g4 + 4 * hi);
#pragma unroll
            for (int i = 0; i < 4; ++i) { const int r = 4 * g4 + i; const int key = 64 * t + crow(r, hi);
                float x0 = p0[r] + (gq - gk0[i]), x1 = p1[r] + (gq - gk1[i]);
                if (key > qrow) x0 = -INFINITY; if (key + 32 > qrow) x1 = -INFINITY;
                p0[r] = x0; p1[r] = x1; rm = fmaxf(rm, fmaxf(x0, x1)); }
        }
        { auto rr = __builtin_amdgcn_permlane32_swap(__float_as_uint(rm), __float_as_uint(rm), false, false); rm = fmaxf(__uint_as_float(rr[0]), __uint_as_float(rr[1])); }
        const float m_new = fmaxf(m_run, rm);
        const float alpha = __builtin_amdgcn_exp2f(m_run - m_new);
        m_run = m_new;
        float ls = 0.f;
#pragma unroll
        for (int r = 0; r < 16; ++r) { p0[r] = __builtin_amdgcn_exp2f(p0[r] - m_new); p1[r] = __builtin_amdgcn_exp2f(p1[r] - m_new); ls += p0[r] + p1[r]; }
        l_run = l_run * alpha + ls;
        if (hi == 0) wsf[r32] = alpha;
        v4u pw0, pw1, pw2, pw3;
        pw0 = (v4u){cvtpk_s(p0[0], p0[1]), cvtpk_s(p0[2], p0[3]), cvtpk_s(p0[4], p0[5]), cvtpk_s(p0[6], p0[7])};
        pw1 = (v4u){cvtpk_s(p0[8], p0[9]), cvtpk_s(p0[10], p0[11]), cvtpk_s(p0[12], p0[13]), cvtpk_s(p0[14], p0[15])};
        pw2 = (v4u){cvtpk_s(p1[0], p1[1]), cvtpk_s(p1[2], p1[3]), cvtpk_s(p1[4], p1[5]), cvtpk_s(p1[6], p1[7])};
        pw3 = (v4u){cvtpk_s(p1[8], p1[9]), cvtpk_s(p1[10], p1[11]), cvtpk_s(p1[12], p1[13]), cvtpk_s(p1[14], p1[15])};
        LDS_WAIT();
#pragma unroll
        for (int r = 0; r < 16; ++r) { const float a = wsf[crow(r, hi)]; o[0][r] *= a; o[1][r] *= a; }
#pragma unroll
        for (int d0 = 0; d0 < 2; ++d0) {
#define AT_PV(ks, PW) { const s16x4 lo = vtr(vp0 + d0 * 4096 + ks * 1024), hh = vtr(vp0 + d0 * 4096 + ks * 1024 + 512); \
              const bf16x8 vf = (bf16x8){lo[0], lo[1], lo[2], lo[3], hh[0], hh[1], hh[2], hh[3]}; \
              o[d0] = __builtin_amdgcn_mfma_f32_32x32x16_bf16(__builtin_bit_cast(bf16x8, PW), vf, o[d0], 0, 0, 0); }
            AT_PV(0, pw0) AT_PV(1, pw1) AT_PV(2, pw2) AT_PV(3, pw3)
#undef AT_PV
        }
    }
    { auto rr = __builtin_amdgcn_permlane32_swap(__float_as_uint(l_run), __float_as_uint(l_run), false, false); l_run = __uint_as_float(rr[0]) + __uint_as_float(rr[1]); }
    if (hi == 0) wsf[32 + r32] = l_run;
    LDS_WAIT();
    bf16* stg = (bf16*)(F.lds + AT_OST) + wid * 2048;
    LAS bf16* stgl = (LAS bf16*)(lds + AT_OST) + wid * 2048;
#pragma unroll
    for (int r = 0; r < 16; ++r) { const int orow = crow(r, hi); const float rl = 1.0f / wsf[32 + orow];
#pragma unroll
        for (int d0 = 0; d0 < 2; ++d0) stgl[orow * 64 + d0 * 32 + r32] = (bf16)f2bf(o[d0][r] * rl); }
    LDS_WAIT();
    (void)stg;
#pragma unroll
    for (int i = 0; i < 4; ++i) { const int row = i * 8 + (lane >> 3), c8 = lane & 7;
        const v4u v = *(const LAS v4u*)(stgl + row * 64 + c8 * 8);
        const long grow = rowbase + q0 + wid * 32 + row;
        const v4u gt = *(const v4u*)(UB + grow * U_LD + 1536 + h * 64 + c8 * 8);
        v4u ov;
        ov.x = pk2(bflo(v.x) * siluf_(bflo(gt.x)), bfhi(v.x) * siluf_(bfhi(gt.x)));
        ov.y = pk2(bflo(v.y) * siluf_(bflo(gt.y)), bfhi(v.y) * siluf_(bfhi(gt.y)));
        ov.z = pk2(bflo(v.z) * siluf_(bflo(gt.z)), bfhi(v.z) * siluf_(bfhi(gt.z)));
        ov.w = pk2(bflo(v.w) * siluf_(bflo(gt.w)), bfhi(v.w) * siluf_(bfhi(gt.w)));
        *(v4u*)(Acomb + grow * ACOMB_LD + ZB_OFF + h * 64 + c8 * 8) = ov; }
}
__device__ __forceinline__ void p3_attention(Frame& F) {
    const int bh = F.vcu >> 2, s = F.vcu & 3;
    attn_unit(F, bh >> 3, bh & 7, s);
    __syncthreads();
    attn_unit(F, bh >> 3, bh & 7, 7 - s);
}
template <int Q> __device__ __forceinline__ float bcq(float x) { return __builtin_bit_cast(float, __builtin_amdgcn_mov_dpp(__builtin_bit_cast(int, x), 0x150 + Q, 0xf, 0xf, true)); }

template <int VAR> __device__ __forceinline__ void p4_scan_a(Frame& F) {
    const int lane = F.lane, q16 = lane & 15;
    const int id = F.vcu * NWAVES + F.wave;
    const int b = id >> 8, h = (id >> 5) & 7, c = id & 31;
    const bf16* UA = (const bf16*)(F.ws + WS_UA);
    const float* DEC = F.out; const float* LR = F.out + (size_t)T * 512;
    float* Gm = (float*)(F.ws + WS_UB); float* Hm = Gm + (size_t)2048 * 4096;
    bf16* Rbar = (bf16*)(F.ws + WS_US); bf16* Yloc = (bf16*)(F.ws + WS_YLOC);
    float* BON = (float*)(F.ws + WS_BONUS);
    const float* mu = KIN(3);
    const int ch0 = h * 64 + 4 * q16;
    f32x4 mu_r = *(const f32x4*)(mu + ch0), mu_k = *(const f32x4*)(mu + 512 + ch0), kkc = *(const f32x4*)(KIN(8) + ch0), kac = *(const f32x4*)(KIN(9) + ch0), rkc = *(const f32x4*)(KIN(10) + ch0);
    const float mu_v = mu[1024 + h * 64 + lane];
    const long m0 = (long)b * SEQ + c * 64;
    float sL[64], sG[64];
#pragma unroll
    for (int j = 0; j < 64; ++j) { sL[j] = 0.f; sG[j] = (j == lane) ? 1.f : 0.f; }
    f32x4 pr = {0.f, 0.f, 0.f, 0.f}, pk = {0.f, 0.f, 0.f, 0.f}; float pv = 0.f;
    if (c > 0) { const bf16* up = UA + (m0 - 1) * U_LD; const v2u a = *(const v2u*)(up + ch0), k = *(const v2u*)(up + 512 + ch0);
        pr = (f32x4){bflo(a.x), bfhi(a.x), bflo(a.y), bfhi(a.y)}; pk = (f32x4){bflo(k.x), bfhi(k.x), bflo(k.y), bfhi(k.y)}; pv = bf2f(up[1024 + h * 64 + lane]); }
    v2u n_ua, n_uk; unsigned short n_cv; f32x4 n_lr, n_wv;
    { const bf16* up = UA + m0 * U_LD; n_ua = *(const v2u*)(up + ch0); n_uk = *(const v2u*)(up + 512 + ch0); n_cv = up[1024 + h * 64 + lane];
      n_lr = *(const f32x4*)(LR + m0 * 512 + ch0); n_wv = *(const f32x4*)(DEC + m0 * 512 + ch0); }
    for (int t = 0; t < 64; ++t) {
        const long m = m0 + t;
        const v2u ua = n_ua, uk = n_uk; const float cv = bf2f(n_cv); const f32x4 lr = n_lr, wv = n_wv;
        { const long mn = m0 + (t < 63 ? t + 1 : 63); const bf16* up = UA + mn * U_LD; n_ua = *(const v2u*)(up + ch0); n_uk = *(const v2u*)(up + 512 + ch0); n_cv = up[1024 + h * 64 + lane];
          n_lr = *(const f32x4*)(LR + mn * 512 + ch0); n_wv = *(const f32x4*)(DEC + mn * 512 + ch0); }
        const f32x4 cr = (f32x4){bflo(ua.x), bfhi(ua.x), bflo(ua.y), bfhi(ua.y)}, ck = (f32x4){bflo(uk.x), bfhi(uk.x), bflo(uk.y), bfhi(uk.y)};
        f32x4 rv, kx, av, bv, km;
        float ss = 0.f, bon = 0.f;
#pragma unroll
        for (int e = 0; e < 4; ++e) { rv[e] = cr[e] + (pr[e] - cr[e]) * mu_r[e]; kx[e] = ck[e] + (pk[e] - ck[e]) * mu_k[e]; const float kk = kx[e] * kkc[e]; av[e] = kk; ss += kk * kk; }
        ss = row16_sum(ss);
        const float inv = 1.0f / fmaxf(sqrtf(ss), 1e-12f);
#pragma unroll
        for (int e = 0; e < 4; ++e) { av[e] = -av[e] * inv; bv[e] = -av[e] * lr[e]; km[e] = kx[e] * (1.0f + (lr[e] - 1.0f) * kac[e]); bon += rv[e] * km[e] * rkc[e]; }
        bon = row16_sum(bon);
        const float vi = cv + (pv - cv) * mu_v;
        pr = cr; pk = ck; pv = cv;
        if (lane == 0) BON[m * 8 + h] = bon;
        asm volatile("s_nop 1" : "+v"(av[0]), "+v"(av[1]), "+v"(av[2]), "+v"(av[3]), "+v"(bv[0]), "+v"(bv[1]), "+v"(bv[2]), "+v"(bv[3]));
        asm volatile("s_nop 1" : "+v"(km[0]), "+v"(km[1]), "+v"(km[2]), "+v"(km[3]), "+v"(rv[0]), "+v"(rv[1]), "+v"(rv[2]), "+v"(rv[3]));
        f32x4 wq = wv; asm volatile("s_nop 1" : "+v"(wq[0]), "+v"(wq[1]), "+v"(wq[2]), "+v"(wq[3]));
        float saL0 = 0.f, saL1 = 0.f, saG0 = 0.f, saG1 = 0.f;
#define DFMAC(ACC, BC, X, Q) do { if (VAR == 1) asm("v_fmac_f32_e32 %0, %1, %2" : "+v"(ACC) : "v"(BC), "v"(X)); else asm("v_fmac_f32_dpp %0, %1, %2 row_newbcast:" #Q " row_mask:0xf bank_mask:0xf" : "+v"(ACC) : "v"(BC), "v"(X)); } while (0)
#define DMUL(X, BC, Q) do { if (VAR == 1) asm("v_mul_f32_e32 %0, %1, %0" : "+v"(X) : "v"(BC)); else asm("v_mul_f32_dpp %0, %1, %0 row_newbcast:" #Q " row_mask:0xf bank_mask:0xf" : "+v"(X) : "v"(BC)); } while (0)
#define SA_BLK(Q) { DFMAC(saL0, av[0], sL[4 * Q], Q); DFMAC(saG0, av[0], sG[4 * Q], Q); DFMAC(saL1, av[1], sL[4 * Q + 1], Q); DFMAC(saG1, av[1], sG[4 * Q + 1], Q); \
            DFMAC(saL0, av[2], sL[4 * Q + 2], Q); DFMAC(saG0, av[2], sG[4 * Q + 2], Q); DFMAC(saL1, av[3], sL[4 * Q + 3], Q); DFMAC(saG1, av[3], sG[4 * Q + 3], Q); }
        SA_BLK(0) SA_BLK(1) SA_BLK(2) SA_BLK(3) SA_BLK(4) SA_BLK(5) SA_BLK(6) SA_BLK(7) SA_BLK(8) SA_BLK(9) SA_BLK(10) SA_BLK(11) SA_BLK(12) SA_BLK(13) SA_BLK(14) SA_BLK(15)
#undef SA_BLK
        float saL = saL0 + saL1, saG = saG0 + saG1;
        float yL0 = 0.f, yL1 = 0.f, yG0 = 0.f, yG1 = 0.f;
#define UP_ONE(Q, E, YL, YG) { DMUL(sL[4 * Q + E], wq[E], Q); DMUL(sG[4 * Q + E], wq[E], Q); DFMAC(sL[4 * Q + E], bv[E], saL, Q); DFMAC(sG[4 * Q + E], bv[E], saG, Q); \
            DFMAC(sL[4 * Q + E], km[E], vi, Q); DFMAC(YG, rv[E], sG[4 * Q + E], Q); DFMAC(YL, rv[E], sL[4 * Q + E], Q); }
#define UP_BLK(Q) UP_ONE(Q, 0, yL0, yG0) UP_ONE(Q, 1, yL1, yG1) UP_ONE(Q, 2, yL0, yG0) UP_ONE(Q, 3, yL1, yG1)
        UP_BLK(0) UP_BLK(1) UP_BLK(2) UP_BLK(3) UP_BLK(4) UP_BLK(5) UP_BLK(6) UP_BLK(7) UP_BLK(8) UP_BLK(9) UP_BLK(10) UP_BLK(11) UP_BLK(12) UP_BLK(13) UP_BLK(14) UP_BLK(15)
#undef UP_BLK
#undef UP_ONE
#undef DFMAC
#undef DMUL
        Yloc[m * 512 + h * 64 + lane] = (bf16)f2bf(yL0 + yL1);
        Rbar[m * 512 + h * 64 + lane] = (bf16)f2bf(yG0 + yG1);
    }
    float* hp = Hm + (size_t)id * 4096 + lane * 64; float* gp = Gm + (size_t)id * 4096 + lane * 64;
#pragma unroll
    for (int j = 0; j < 64; j += 4) { *(f32x4*)(hp + j) = (f32x4){sL[j], sL[j + 1], sL[j + 2], sL[j + 3]}; *(f32x4*)(gp + j) = (f32x4){sG[j], sG[j + 1], sG[j + 2], sG[j + 3]}; }
}

template <int PRB> __device__ __forceinline__ void p5_scan_b(Frame& F) {
    const int bh = F.vcu >> 2, i0 = (F.vcu & 3) * 16, lane = F.lane, fr = lane & 15, fq = lane >> 4, n = F.wave;
    const float* Gm = (const float*)(F.ws + WS_UB); const float* Hm = Gm + (size_t)2048 * 4096;
    float* Sst = PRB ? (float*)(F.ws + WS_UA) : F.out;
    LAS float* Ssb = (LAS float*)(F.lds + RING_OFF);
    const int id0 = ((bh >> 3) << 8) | ((bh & 7) << 5);
    if (n < 4) {
        f32x4 st = (f32x4){0.f, 0.f, 0.f, 0.f};
        float gb[16]; f32x4 hv;
        { const float* gp = Gm + (size_t)id0 * 4096 + 16 * n + fr; const float* hp = Hm + (size_t)id0 * 4096 + (size_t)(i0 + 4 * fq) * 64 + 16 * n + fr;
#pragma unroll
          for (int ks = 0; ks < 16; ++ks) gb[ks] = gp[(4 * ks + fq) * 64];
#pragma unroll
          for (int r = 0; r < 4; ++r) hv[r] = hp[r * 64]; }
        for (int c = 0; c < 32; ++c) {
            const size_t base = (size_t)(id0 + c) * 4096;
            { float* sp = Sst + base + (size_t)(i0 + 4 * fq) * 64 + 16 * n + fr;
#pragma unroll
              for (int r = 0; r < 4; ++r) sp[r * 64] = st[r]; }
            if (c == 31) break;
            LAS float* Ss = Ssb + (c & 1) * (16 * 65);
#pragma unroll
            for (int r = 0; r < 4; ++r) Ss[(4 * fq + r) * 65 + 16 * n + fr] = st[r];
            float ga[16]; f32x4 acc = hv;
#pragma unroll
            for (int ks = 0; ks < 16; ++ks) ga[ks] = gb[ks];
            if (c < 30) { const float* gp = Gm + base + 4096 + 16 * n + fr; const float* hp = Hm + base + 4096 + (size_t)(i0 + 4 * fq) * 64 + 16 * n + fr;
#pragma unroll
                for (int ks = 0; ks < 16; ++ks) gb[ks] = gp[(4 * ks + fq) * 64];
#pragma unroll
                for (int r = 0; r < 4; ++r) hv[r] = hp[r * 64]; }
            asm volatile("s_waitcnt lgkmcnt(0)" ::: "memory"); __builtin_amdgcn_s_barrier(); asm volatile("" ::: "memory");
            float av[16];
#pragma unroll
            for (int ks = 0; ks < 16; ++ks) av[ks] = Ss[fr * 65 + 4 * ks + fq];
#pragma unroll
            for (int ks = 0; ks < 16; ++ks) acc = __builtin_amdgcn_mfma_f32_16x16x4f32(av[ks], ga[ks], acc, 0, 0, 0);
            st = acc;
        }
    } else {
        for (int c = 0; c < 31; ++c) { __builtin_amdgcn_s_barrier(); }
    }
    __syncthreads();
}

__device__ __forceinline__ f32x4 bf4(v2u w) { return (f32x4){bflo(w.x), bfhi(w.x), bflo(w.y), bfhi(w.y)}; }
__device__ __forceinline__ float xrow4_sum(float v) {
    v += __shfl_xor(v, 16); v += __shfl_xor(v, 32); return v;
}
__device__ __forceinline__ void p6_scan_c(Frame& F) {
    const int lane = F.lane, fr = lane & 15, fq = lane >> 4;
    const int id = F.vcu * NWAVES + F.wave;
    const int b = id >> 8, h = (id >> 5) & 7, c = id & 31;
    const bf16* UA = (const bf16*)(F.ws + WS_UA);
    const bf16* Rbar = (const bf16*)(F.ws + WS_US); const bf16* Yloc = (const bf16*)(F.ws + WS_YLOC);
    const float* BON = (const float*)(F.ws + WS_BONUS);
    const float* Sst = F.out + (size_t)id * 4096;
    bf16* Acomb = (bf16*)(F.ws + WS_ACOMB);
    const float* mu = KIN(3);
    const long m0 = (long)b * SEQ + c * 64;
    bf16x8 sfr[4][2];
#pragma unroll
    for (int it = 0; it < 4; ++it)
#pragma unroll
        for (int ks = 0; ks < 2; ++ks) { const float* p = Sst + (16 * it + fr) * 64 + 32 * ks + 8 * fq; const f32x4 x0 = *(const f32x4*)p, x1 = *(const f32x4*)(p + 4);
            v4u w; w.x = pk2(x0[0], x0[1]); w.y = pk2(x0[2], x0[3]); w.z = pk2(x1[0], x1[1]); w.w = pk2(x1[2], x1[3]); sfr[it][ks] = __builtin_bit_cast(bf16x8, w); }
    f32x4 lw[4], lb[4], muv[4], mug[4];
    const float* lnw = KIN(11); const float* lnb = KIN(12);
#pragma unroll
    for (int it = 0; it < 4; ++it) { const int ch = h * 64 + 16 * it + 4 * fq; lw[it] = *(const f32x4*)(lnw + ch); lb[it] = *(const f32x4*)(lnb + ch); muv[it] = *(const f32x4*)(mu + 1024 + ch); mug[it] = *(const f32x4*)(mu + 1664 + ch); }
    struct Ld { bf16x8 rfr[2]; v2u yl[4], cv[4], cg[4], pv[4], pg[4]; float bs; };
    auto load = [&](int tt, Ld& L) {
        const long m = m0 + 16 * tt + fr; const long mp = (m % SEQ) == 0 ? m : m - 1;
#pragma unroll
        for (int ks = 0; ks < 2; ++ks) L.rfr[ks] = *(const bf16x8*)(Rbar + m * 512 + h * 64 + 32 * ks + 8 * fq);
        L.bs = BON[m * 8 + h];
#pragma unroll
        for (int it = 0; it < 4; ++it) { const int ch = h * 64 + 16 * it + 4 * fq;
            L.yl[it] = *(const v2u*)(Yloc + m * 512 + ch);
            L.cv[it] = *(const v2u*)(UA + m * U_LD + 1024 + ch); L.cg[it] = *(const v2u*)(UA + m * U_LD + 1536 + ch);
            L.pv[it] = *(const v2u*)(UA + mp * U_LD + 1024 + ch); L.pg[it] = *(const v2u*)(UA + mp * U_LD + 1536 + ch); }
    };
    auto compute = [&](int tt, const Ld& L) {
        const long m = m0 + 16 * tt + fr; const bool first = (m % SEQ) == 0;
        f32x4 y[4]; float s = 0.f;
#pragma unroll
        for (int it = 0; it < 4; ++it) { f32x4 acc = (f32x4){0.f, 0.f, 0.f, 0.f};
#pragma unroll
            for (int ks = 0; ks < 2; ++ks) acc = __builtin_amdgcn_mfma_f32_16x16x32_bf16(sfr[it][ks], L.rfr[ks], acc, 0, 0, 0);
            y[it] = acc + bf4(L.yl[it]); s += (y[it][0] + y[it][1]) + (y[it][2] + y[it][3]); }
        const float mean = xrow4_sum(s) * (1.f / 64.f); float q = 0.f;
#pragma unroll
        for (int it = 0; it < 4; ++it) { y[it] = y[it] - mean; q += (y[it][0] * y[it][0] + y[it][1] * y[it][1]) + (y[it][2] * y[it][2] + y[it][3] * y[it][3]); }
        const float rstd = 1.0f / sqrtf(xrow4_sum(q) * (1.f / 64.f) + LNX_EPS);
#pragma unroll
        for (int it = 0; it < 4; ++it) { const int ch = h * 64 + 16 * it + 4 * fq;
            const f32x4 cv = bf4(L.cv[it]), cg = bf4(L.cg[it]);
            f32x4 pv = bf4(L.pv[it]), pg = bf4(L.pg[it]);
            if (first) { pv = (f32x4){0.f, 0.f, 0.f, 0.f}; pg = pv; }
            const f32x4 vv = cv + (pv - cv) * muv[it], gg = cg + (pg - cg) * mug[it];
            f32x4 z = y[it] * rstd * lw[it] + lb[it] + L.bs * vv;
            z = (f32x4){z[0] * siluf_(gg[0]), z[1] * siluf_(gg[1]), z[2] * siluf_(gg[2]), z[3] * siluf_(gg[3])};
            *(v2u*)(Acomb + m * ACOMB_LD + ZA_OFF + ch) = (v2u){pk2(z[0], z[1]), pk2(z[2], z[3])}; }
    };
    Ld LA, LB;
    load(0, LA); load(1, LB);
    compute(0, LA); load(2, LA);
    compute(1, LB); load(3, LB);
    compute(2, LA); compute(3, LB);
}
struct SchedP7 {
    int pm, pn; const char* Acomb; const char* WinT; const char* Wab;
    __device__ __forceinline__ bool next(int i, pg8::Unit& u) const {
        if (i >= 4) return false;
        u.pm = pm; u.pn = pn; u.kind = i;
        const char* arow = Acomb + (size_t)pm * 256 * ACOMB_LD * 2;
        if (i == 0)      { u.nt = 16; u.a = arow;                 u.b = WinT + (size_t)(4096 + pn * 256) * 1024 * 2; }
        else if (i == 1) { u.nt = 8;  u.a = arow + ZA_OFF * 2;    u.b = Wab + (size_t)(pn * 256) * 1024 * 2; }
        else if (i == 2) { u.nt = 16; u.a = arow;                 u.b = WinT + (size_t)(5120 + pn * 256) * 1024 * 2; }
        else             { u.nt = 8;  u.a = arow + ZB_OFF * 2;    u.b = Wab + (size_t)(pn * 256) * 1024 * 2 + 512 * 2; }
        return true;
    }
};
struct EpiP7 {
    f32x4* SG; f32x4* TMP; bf16* merged;
    __device__ __forceinline__ void operator()(const f32x4 (&acc)[2][2][4][2], const pg8::Unit& u, int wr, int wc, int fr, int fq) const {
        const int tid = threadIdx.x;
        f32x4* SG = this->SG; f32x4* TMP = this->TMP;
        asm volatile("" : "+s"(SG), "+s"(TMP));
        if (u.kind == 0 || u.kind == 2) {
#pragma unroll
            for (int ai = 0; ai < 2; ++ai)
#pragma unroll
                for (int bj = 0; bj < 2; ++bj)
#pragma unroll
                    for (int m = 0; m < 4; ++m)
#pragma unroll
                        for (int n = 0; n < 2; ++n) { const f32x4 v = acc[ai][bj][m][n]; f32x4* p = SG + (((((ai * 2 + bj) * 4 + m) * 2 + n)) << 9);
                            p[tid] = (f32x4){sigmoidf_(v[0]), sigmoidf_(v[1]), sigmoidf_(v[2]), sigmoidf_(v[3])}; asm volatile("" ::: "memory"); }
        } else if (u.kind == 1) {
#pragma unroll
            for (int ai = 0; ai < 2; ++ai)
#pragma unroll
                for (int bj = 0; bj < 2; ++bj)
#pragma unroll
                    for (int m = 0; m < 4; ++m)
#pragma unroll
                        for (int n = 0; n < 2; ++n) { const int ix = ((((ai * 2 + bj) * 4 + m) * 2 + n) << 9); const f32x4* ps = SG + ix; f32x4* pt = TMP + ix; pt[tid] = ps[tid] * acc[ai][bj][m][n]; if (n == 1) asm volatile("" ::: "memory"); }
        } else {
            const int row0 = u.pm * 256 + wr * 64 + fr; bf16* base = merged + u.pn * 256 + wc * 32 + 8 * fq;
#pragma unroll
            for (int ai = 0; ai < 2; ++ai)
#pragma unroll
                for (int m = 0; m < 4; ++m) { bf16* rowp = base + (size_t)(row0 + ai * 128 + m * 16) * 1024;
#pragma unroll
                    for (int bj = 0; bj < 2; ++bj) { const int ix = (((ai * 2 + bj) * 4 + m) * 2) << 9; const f32x4* ps = SG + ix; const f32x4* pt = TMP + ix;
                        const f32x4 v0 = pt[tid] + ps[tid] * acc[ai][bj][m][0], v1 = pt[512 + tid] + ps[512 + tid] * acc[ai][bj][m][1];
                        pg8::u32x4 w; w.x = pg8::cvt_pk_bf16(v0[0], v0[1]); w.y = pg8::cvt_pk_bf16(v0[2], v0[3]); w.z = pg8::cvt_pk_bf16(v1[0], v1[1]); w.w = pg8::cvt_pk_bf16(v1[2], v1[3]);
                        *(pg8::u32x4*)(rowp + bj * 128) = w; asm volatile("" ::: "memory"); } }
        }
    }
};
struct SchedP8 {
    int pm, pn; const char* A; const char* B;
    __device__ __forceinline__ bool next(int i, pg8::Unit& u) const {
        if (i >= 1) return false;
        u.pm = pm; u.pn = pn; u.kind = 0; u.nt = 16; u.a = A + (size_t)pm * 256 * 1024 * 2; u.b = B + (size_t)pn * 256 * 1024 * 2; return true;
    }
};
struct EpiP8 {
    const float* x; float* out;
    __device__ __forceinline__ void operator()(const f32x4 (&acc)[2][2][4][2], const pg8::Unit& u, int wr, int wc, int fr, int fq) const {
        const int row0 = u.pm * 256 + wr * 64 + fr; const int col0 = u.pn * 256 + wc * 32 + 8 * fq;
#pragma unroll
        for (int ai = 0; ai < 2; ++ai)
#pragma unroll
            for (int m = 0; m < 4; ++m) { const size_t off = (size_t)(row0 + ai * 128 + m * 16) * DM + col0;
#pragma unroll
                for (int bj = 0; bj < 2; ++bj) { const f32x4 x0 = *(const f32x4*)(x + off + bj * 128), x1 = *(const f32x4*)(x + off + bj * 128 + 4);
                    *(f32x4*)(out + off + bj * 128) = x0 + acc[ai][bj][m][0]; *(f32x4*)(out + off + bj * 128 + 4) = x1 + acc[ai][bj][m][1]; } }
    }
};
__device__ __forceinline__ void p9_final_norm(Frame& F) {
    const int gw = F.vcu * NWAVES + F.wave, NGW = F.G * NWAVES;
    const GAS f32x4* gp = (const GAS f32x4*)KIN(19) + F.lane;
    f32x4 g[4];
#pragma unroll
    for (int j = 0; j < 4; ++j) g[j] = gp[64 * j];
    for (int m = gw; m < T; m += NGW) {
        GAS f32x4* xr = (GAS f32x4*)(F.out + (size_t)m * DM) + F.lane;
        f32x4 v[4]; float s = 0.f;
#pragma unroll
        for (int j = 0; j < 4; ++j) { v[j] = xr[64 * j]; s += (v[j].x * v[j].x + v[j].y * v[j].y) + (v[j].z * v[j].z + v[j].w * v[j].w); }
        const float rstd = 1.f / sqrtf(wave_sum(s) * (1.f / DM) + RMS_EPS);
#pragma unroll
        for (int j = 0; j < 4; ++j) xr[64 * j] = v[j] * rstd * g[j];
    }
}

constexpr int N_PHASES = 10;
struct Args { const float* in[20]; float* out; unsigned char* ws; int ph_lo, ph_hi, variant, pad; };
__global__ void __launch_bounds__(NWAVES * 64, 2) hybrid_fwd(Args args) {
    extern __shared__ __attribute__((aligned(16))) unsigned char lds[];
    Frame F;
    F.lds = (LAS unsigned char*)lds;
    F.MISC = (volatile LAS unsigned*)(F.lds + MISC_OFF);
    F.tid = threadIdx.x; F.lane = F.tid & 63; F.wave = __builtin_amdgcn_readfirstlane(F.tid >> 6);
    F.G = gridDim.x; { const int bx = blockIdx.x; F.vcu = (bx % 8) * (F.G / 8) + bx / 8; }
    F.out = args.out; F.ws = args.ws;
    unsigned char* ws = args.ws;
    for (int u = F.tid; u < (LDS_BYTES - LDSCTL_OFF) / 4; u += NWAVES * 64) ((LAS unsigned*)(F.lds + LDSCTL_OFF))[u] = 0u;
    __syncthreads();
    const int lo = args.ph_lo, hi = args.ph_hi;
    const bool multi = (hi - lo) > 1;
    XcdBarrier bar; bar.bar = (unsigned*)(ws + WS_CTL) + CW_BAR; bar.x = 0; bar.st = nullptr;
    if (multi) bar = xcd_barrier_post((unsigned*)(ws + WS_CTL) + CW_BAR, F.MISC + 8);
#ifndef PH_MASK
#define PH_MASK 0x3ff
#endif
#define IN(k) (((PH_MASK >> (k)) & 1) && lo <= (k) && (k) < hi)
#define SEAM(k) do { if (IN(k) && IN((k) + 1)) xcd_barrier(bar); } while (0)
#define PF(Fp) Frame Fp = F; { int t_ = threadIdx.x; asm volatile("" : "+v"(t_)); Fp.tid = t_; Fp.lane = t_ & 63; Fp.wave = __builtin_amdgcn_readfirstlane(t_ >> 6); }
#ifndef RPT_MASK
#define RPT_MASK 0
#endif
#define NREP(k) (((RPT_MASK >> (k)) & 1) ? 2 : 1)
#ifndef PROBE_VARIANTS
#define PROBE_VARIANTS 0
#endif
    if (IN(0)) { PF(Fp); p0_prologue(Fp); SEAM(0); }
    if (IN(1)) {
        SchedP1 S{(int)blockIdx.x, F.G, (const char*)(ws + WS_ACOMB), (const char*)(ws + WS_WINT)};
        EpiP1 E{(bf16*)(ws + WS_UA), (bf16*)(ws + WS_UB), (float*)(ws + WS_US)};
        pg8::gemm_phase(F.lds + RING_OFF, ACOMB_LD, 1024, S, E);
        SEAM(1);
    }
    if (IN(2)) { PF(Fp); p2_prep<0>(Fp); SEAM(2); }
    if (IN(3)) { PF(Fp); p3_attention(Fp); SEAM(3); }
    if (IN(4)) { PF(Fp); p4_scan_a<0>(Fp); SEAM(4); }
    if (IN(5)) { PF(Fp); p5_scan_b<0>(Fp); SEAM(5); }
    if (IN(6)) { PF(Fp); p6_scan_c(Fp); SEAM(6); }
    const int pm = F.vcu >> 2, pn = F.vcu & 3;
    if (IN(7)) {
        SchedP7 S{pm, pn, (const char*)(ws + WS_ACOMB), (const char*)(ws + WS_WINT), (const char*)(ws + WS_WAB)};
        EpiP7 E{(f32x4*)(ws + WS_UA) + (size_t)blockIdx.x * 16384, (f32x4*)(ws + WS_UB) + (size_t)blockIdx.x * 16384, (bf16*)(ws + WS_MERGED)};
        pg8::gemm_phase(F.lds + RING_OFF, ACOMB_LD, 1024, S, E);
        SEAM(7);
    }
    if (IN(8)) {
        SchedP8 S{pm, pn, (const char*)(ws + WS_MERGED), (const char*)(ws + WS_WOUT)};
        EpiP8 E{KIN(0), F.out};
        pg8::gemm_phase(F.lds + RING_OFF, 1024, 1024, S, E);
        SEAM(8);
    }
    if (IN(9)) { PF(Fp); p9_final_norm(Fp); }
#undef IN
#undef SEAM
}


#if PROBE_VARIANTS
__global__ void __launch_bounds__(NWAVES * 64, 2) probe_fwd(Args args) {
    extern __shared__ __attribute__((aligned(16))) unsigned char lds[];
    Frame F;
    F.lds = (LAS unsigned char*)lds;
    F.MISC = (volatile LAS unsigned*)(F.lds + MISC_OFF);
    F.tid = threadIdx.x; F.lane = F.tid & 63; F.wave = __builtin_amdgcn_readfirstlane(F.tid >> 6);
    F.G = gridDim.x; { const int bx = blockIdx.x; F.vcu = (bx % 8) * (F.G / 8) + bx / 8; }
    F.out = args.out; F.ws = args.ws;
#ifndef PROBE_REP
#define PROBE_REP 1
#endif
    for (int rp = 0; rp < PROBE_REP; ++rp) {
    if (PROBE_VARIANTS == 1) p4_scan_a<1>(F);
    if (PROBE_VARIANTS == 2) p2_prep<1>(F);
    if (PROBE_VARIANTS == 3) p5_scan_b<1>(F);
    if (PROBE_VARIANTS == 4) p6_scan_c(F);
    if (PROBE_VARIANTS == 5) p0_prologue(F);
    __syncthreads(); }
}
#endif
#ifndef MK_N_LAUNCHES
#define MK_N_LAUNCHES 1
#endif
extern "C" void kernel_launch(void* const* d_in, const int* in_sizes, int n_in, void* d_out, int out_size, void* d_ws, size_t ws_size, hipStream_t stream) {
    static int grid = 0;
    if (grid == 0) {
        if (n_in != 20 || in_sizes[0] != T * DM || out_size != T * DM || ws_size < WS_END) { fprintf(stderr, "kernel_launch: unexpected shapes (n_in %d, in0 %d, out %d, ws %zu); nothing launched\n", n_in, n_in > 0 ? in_sizes[0] : -1, out_size, ws_size); grid = -1; return; }
        int dev = 0, cus = 0, per_cu = 0;
        if (hipGetDevice(&dev) != hipSuccess || hipDeviceGetAttribute(&cus, hipDeviceAttributeMultiprocessorCount, dev) != hipSuccess) { grid = -1; return; }
        #if PROBE_VARIANTS
        (void)hipFuncSetAttribute((const void*)probe_fwd, hipFuncAttributeMaxDynamicSharedMemorySize, LDS_BYTES);
#endif
        if (hipFuncSetAttribute((const void*)hybrid_fwd, hipFuncAttributeMaxDynamicSharedMemorySize, LDS_BYTES) != hipSuccess) { fprintf(stderr, "kernel_launch: hipFuncSetAttribute failed\n"); grid = -1; return; }
        if (hipOccupancyMaxActiveBlocksPerMultiprocessor(&per_cu, (const void*)hybrid_fwd, NWAVES * 64, LDS_BYTES) != hipSuccess || per_cu < 1) fprintf(stderr, "kernel_launch: note: occupancy query reports %d workgroups per CU\n", per_cu);
        (void)hipGetLastError();
        grid = 256;
        if (cus != 256) fprintf(stderr, "kernel_launch: device reports %d CUs; this kernel is built for 256\n", cus);
    }
    if (grid < 0) return;
    (void)hipMemsetAsync((char*)d_ws + WS_CTL, 0, CTL_ZERO_BYTES, stream);
    Args a{};
    for (int i = 0; i < 20; ++i) a.in[i] = (const float*)d_in[i];
    a.out = (float*)d_out; a.ws = (unsigned char*)d_ws;
    if (MK_N_LAUNCHES == 1) { a.ph_lo = 0; a.ph_hi = N_PHASES; hipLaunchKernelGGL(hybrid_fwd, dim3(grid), dim3(NWAVES * 64), LDS_BYTES, stream, a); }
#ifdef PROBE_LO
    if (MK_N_LAUNCHES == 1) { (void)hipMemsetAsync((char*)d_ws + WS_CTL, 0, CTL_ZERO_BYTES, stream); a.ph_lo = PROBE_LO; a.ph_hi = PROBE_HI; a.variant = PROBE_VARIANTS;
#if PROBE_VARIANTS
      hipLaunchKernelGGL(probe_fwd, dim3(grid), dim3(NWAVES * 64), LDS_BYTES, stream, a);
#else
      hipLaunchKernelGGL(hybrid_fwd, dim3(grid), dim3(NWAVES * 64), LDS_BYTES, stream, a);
#endif
    }
#endif
    else for (int p = 0; p < N_PHASES; ++p) { a.ph_lo = p; a.ph_hi = p + 1; hipLaunchKernelGGL(hybrid_fwd, dim3(grid), dim3(NWAVES * 64), LDS_BYTES, stream, a); }
}
```

```cpp
#include <hip/hip_runtime.h>
#include <hip/hip_bf16.h>
#include <cstdio>
#include <cstdint>
#include <cmath>

#define GAS __attribute__((address_space(1)))
#define LAS __attribute__((address_space(3)))
typedef unsigned short bf16;
typedef unsigned v4u __attribute__((ext_vector_type(4)));
typedef unsigned v2u __attribute__((ext_vector_type(2)));
typedef float f32x2 __attribute__((ext_vector_type(2)));
typedef float f32x4 __attribute__((ext_vector_type(4)));
typedef float f32x16 __attribute__((ext_vector_type(16)));
typedef short bf16x8 __attribute__((ext_vector_type(8)));
typedef short s16x4 __attribute__((ext_vector_type(4)));

constexpr int NB = 8, SEQ = 2048, DM = 1024, T = NB * SEQ, NH = 8, HD = 64;
constexpr int IN_COLS = 6280, NPAD = 6400;
constexpr float RMS_EPS = 1e-6f, LNX_EPS = 64e-5f;
constexpr float LOG2E = 1.4426950408889634f;
constexpr float C2 = 0.125f * LOG2E;

constexpr size_t MiB = 1u << 20;
constexpr size_t WS_CTL = 0, CTL_ZERO_BYTES = 64 * 1024;
constexpr size_t WS_WINT = 1 * MiB;
constexpr size_t WS_WAB = 14 * MiB;
constexpr size_t WS_WOUT = 16 * MiB;
constexpr size_t WS_G2 = 19 * MiB;
constexpr size_t WS_BONUS = 19 * MiB + 512 * 1024;
constexpr size_t WS_ACOMB = 20 * MiB;
constexpr size_t WS_UA = 84 * MiB;
constexpr size_t WS_UB = 148 * MiB;
constexpr size_t WS_US = 212 * MiB;
constexpr size_t WS_YLOC = 228 * MiB;
constexpr size_t WS_MERGED = 212 * MiB;
constexpr size_t WS_END = 256 * MiB;
constexpr int ACOMB_LD = 2048, U_LD = 2048;
constexpr int ZA_OFF = 1024, ZB_OFF = 1536;

#define RLX_AGENT __ATOMIC_RELAXED, __HIP_MEMORY_SCOPE_AGENT
#define LDS_WAIT() asm volatile("s_waitcnt lgkmcnt(0)" ::: "memory")
#define VM_WAIT() asm volatile("s_waitcnt vmcnt(0)" ::: "memory")

__device__ __forceinline__ unsigned f2bf(float f) { unsigned u = __builtin_bit_cast(unsigned, f); return (u + 0x7fffu + ((u >> 16) & 1u)) >> 16; }
__device__ __forceinline__ unsigned pk2(float lo, float hi) { return f2bf(lo) | (f2bf(hi) << 16); }
__device__ __forceinline__ float bf2f(unsigned b) { return __builtin_bit_cast(float, b << 16); }
__device__ __forceinline__ float bflo(unsigned w) { return __builtin_bit_cast(float, w << 16); }
__device__ __forceinline__ float bfhi(unsigned w) { return __builtin_bit_cast(float, w & 0xffff0000u); }
__device__ __forceinline__ float frcp(float x) { return __builtin_amdgcn_rcpf(x); }
__device__ __forceinline__ float fexp(float x) { return __builtin_amdgcn_exp2f(x * LOG2E); }
__device__ __forceinline__ float sigmoidf_(float x) { return frcp(1.0f + fexp(-x)); }
__device__ __forceinline__ float siluf_(float x) { return x * frcp(1.0f + fexp(-x)); }
__device__ __forceinline__ float wave_sum(float v) {
#pragma unroll
    for (int o = 1; o < 64; o <<= 1) v += __shfl_xor(v, o);
    return v;
}
template <int CTRL> __device__ __forceinline__ float dppf(float x) { return __builtin_bit_cast(float, __builtin_amdgcn_mov_dpp(__builtin_bit_cast(int, x), CTRL, 0xf, 0xf, true)); }
__device__ __forceinline__ float row16_sum(float v) { v += dppf<0x128>(v); v += dppf<0x124>(v); v += dppf<0x122>(v); v += dppf<0x121>(v); return v; }
namespace pg8 {
#define PG8_LAS __attribute__((address_space(3)))
typedef unsigned short bf16_t;
typedef unsigned u32x4 __attribute__((ext_vector_type(4)));
constexpr int BM = 256, BK = 64, HALF = 128, HTB = HALF * BK * 2  , STAGE_BYTES = 8 * HTB;

__host__ __device__ __forceinline__ int lds_byte(int r, int c) { const int st = (r >> 4) * 2 + (c >> 5), rr = r & 15, cc = c & 31, ob = rr * 64 + cc * 2; return st * 1024 + (ob ^ (((ob >> 9) & 1) << 5)); }
__host__ __device__ __forceinline__ void stage_rc(int b, int& R, int& C) { const int st = b / 1024, sb = b % 1024, swz = sb ^ (((sb >> 9) & 1) << 5); R = (st >> 1) * 16 + swz / 64; C = (st & 1) * 32 + (swz % 64) / 2; }
__host__ __device__ __forceinline__ int perm32(int rho) { const int n = rho >> 4, i = rho & 15; return 8 * (i >> 2) + 4 * n + (i & 3); }

struct Unit { int pm, pn, kind, nt, carry; const char* a; const char* b; };

__device__ __forceinline__ unsigned cvt_pk_bf16(float lo, float hi) { typedef __bf16 bf16x2_t __attribute__((ext_vector_type(2))); typedef float f32x2_t __attribute__((ext_vector_type(2))); f32x2_t v = {lo, hi}; bf16x2_t b = __builtin_convertvector(v, bf16x2_t); return __builtin_bit_cast(unsigned, b); }

template <class Epi, class Sched>
__device__ __forceinline__ void gemm_phase(PG8_LAS unsigned char* lds, const int lda, const int ldb, const Sched& S, const Epi& E) {
    int tid = threadIdx.x; asm volatile("" : "+v"(tid));
    const int wid = __builtin_amdgcn_readfirstlane(tid >> 6), lane = tid & 63, wr = wid >> 2, wc = wid & 3, fr = lane & 15, fq = lane >> 4;
    unsigned voffA[2], voffB[2];
#pragma unroll
    for (int i = 0; i < 2; ++i) { int R, C; stage_rc(tid * 16 + i * 8192, R, C); const int Rb = (R & ~31) + perm32(R & 31);
        voffA[i] = (unsigned)(R * lda + C) * 2u; voffB[i] = (unsigned)(Rb * ldb + C) * 2u; }
    const size_t kstep = (size_t)(BK * 2);
    const size_t hstepA = (size_t)HALF * lda * 2, hstepB = (size_t)HALF * ldb * 2;
    const unsigned ldsw = (unsigned)wid * 1024u;
    const int aoff = lds_byte(wr * 64 + fr, fq * 8), boff = lds_byte(wc * 32 + fr, fq * 8);
#define PG8_SA(b, h) (((b) * 2 + (h)) * HTB)
#define PG8_SB(b, h) ((4 + (b) * 2 + (h)) * HTB)
#define PG8_STAGE(bufoff, gbase, voff) do { _Pragma("unroll") for (int _i = 0; _i < 2; ++_i) \
        __builtin_amdgcn_global_load_lds((const unsigned*)((const char*)(gbase) + (voff)[_i]), (PG8_LAS unsigned*)(lds + (bufoff) + ldsw + _i * 8192), 16, 0, 0); } while (0)
#define PG8_LDA(dst, b, h) do { _Pragma("unroll") for (int m = 0; m < 4; ++m) _Pragma("unroll") for (int k = 0; k < 2; ++k) dst[m][k] = *(const PG8_LAS bf16x8*)(lds + PG8_SA(b, h) + aoff + m * 2048 + k * 1024); } while (0)
#define PG8_LDB(dst, b, h) do { _Pragma("unroll") for (int n = 0; n < 2; ++n) _Pragma("unroll") for (int k = 0; k < 2; ++k) dst[n][k] = *(const PG8_LAS bf16x8*)(lds + PG8_SB(b, h) + boff + n * 2048 + k * 1024); } while (0)
#define PG8_MMA(ai, bj, At, Bt) do { __builtin_amdgcn_s_setprio(1); _Pragma("unroll") for (int m = 0; m < 4; ++m) _Pragma("unroll") for (int n = 0; n < 2; ++n) _Pragma("unroll") for (int k = 0; k < 2; ++k) \
        acc[ai][bj][m][n] = __builtin_amdgcn_mfma_f32_16x16x32_bf16(Bt[n][k], At[m][k], acc[ai][bj][m][n], 0, 0, 0); __builtin_amdgcn_s_setprio(0); } while (0)
#define PG8_WAIT_V(n) asm volatile("s_waitcnt vmcnt(" #n ")" ::: "memory")
#define PG8_WAIT_L(n) asm volatile("s_waitcnt lgkmcnt(" #n ")" ::: "memory")
#define PG8_BAR __builtin_amdgcn_s_barrier()
#define PG8_SCHED __builtin_amdgcn_sched_barrier(0)
    Unit cur, nxt; int ui = 0;
    if (!S.next(0, cur)) return;
    f32x4 acc[2][2][4][2];
#pragma unroll
    for (int a = 0; a < 2; ++a)
#pragma unroll
        for (int b = 0; b < 2; ++b)
#pragma unroll
            for (int m = 0; m < 4; ++m)
#pragma unroll
                for (int n = 0; n < 2; ++n) acc[a][b][m][n] = (f32x4){0.f, 0.f, 0.f, 0.f};
    bf16x8 At[4][2], B0[2][2], B1[2][2];
    const char* cA = cur.a; const char* cB = cur.b;
    PG8_STAGE(PG8_SB(0, 0), cB, voffB); PG8_STAGE(PG8_SB(0, 1), cB + hstepB, voffB); PG8_STAGE(PG8_SA(0, 0), cA, voffA); PG8_STAGE(PG8_SA(0, 1), cA + hstepA, voffA);
    if (wr == 1) PG8_BAR;
    PG8_WAIT_V(2); PG8_BAR;
    PG8_STAGE(PG8_SB(1, 0), cB + kstep, voffB); PG8_STAGE(PG8_SA(1, 0), cA + kstep, voffA); PG8_STAGE(PG8_SB(1, 1), cB + hstepB + kstep, voffB);
    PG8_WAIT_V(6); PG8_BAR;
    for (;;) {
        const bool has_next = S.next(ui + 1, nxt);
        const char* nA = has_next ? nxt.a : cA; const char* nB = has_next ? nxt.b : cB;
        const int nt = cur.nt;
        for (int t = 0; t < nt; t += 2) {
            const bool last = (t == nt - 2);
            const char* a1 = cA + (size_t)(t + 1) * kstep;
            const char* a2 = last ? nA : cA + (size_t)(t + 2) * kstep; const char* b2 = last ? nB : cB + (size_t)(t + 2) * kstep;
            const char* a3 = a2 + kstep; const char* b3 = b2 + kstep;
            PG8_LDB(B0, 0, 0); PG8_LDB(B1, 0, 1); PG8_SCHED; PG8_LDA(At, 0, 0); PG8_STAGE(PG8_SA(1, 1), a1 + hstepA, voffA);
            PG8_WAIT_V(8); PG8_WAIT_L(0); PG8_BAR; PG8_MMA(0, 0, At, B0); PG8_MMA(0, 1, At, B1); PG8_BAR; PG8_SCHED;
            PG8_LDA(At, 0, 1); PG8_STAGE(PG8_SB(0, 0), b2, voffB); PG8_STAGE(PG8_SB(0, 1), b2 + hstepB, voffB); PG8_STAGE(PG8_SA(0, 0), a2, voffA);
            PG8_WAIT_V(8); PG8_WAIT_L(0); PG8_BAR; PG8_MMA(1, 0, At, B0); PG8_MMA(1, 1, At, B1); PG8_BAR; PG8_SCHED;
            PG8_LDB(B0, 1, 0); PG8_LDB(B1, 1, 1); PG8_SCHED; PG8_LDA(At, 1, 0); PG8_STAGE(PG8_SA(0, 1), a2 + hstepA, voffA);
            PG8_WAIT_V(8); PG8_WAIT_L(0); PG8_BAR; PG8_MMA(0, 0, At, B0); PG8_MMA(0, 1, At, B1); PG8_BAR; PG8_SCHED;
            PG8_LDA(At, 1, 1); PG8_STAGE(PG8_SB(1, 0), b3, voffB); PG8_STAGE(PG8_SB(1, 1), b3 + hstepB, voffB); PG8_STAGE(PG8_SA(1, 0), a3, voffA);
            PG8_WAIT_V(8); PG8_WAIT_L(0); PG8_BAR; PG8_MMA(1, 0, At, B0); PG8_MMA(1, 1, At, B1); PG8_BAR; PG8_SCHED;
        }
        if (wr == 0) PG8_BAR;
        E(acc, cur, wr, wc, fr, fq);
        if (!has_next) break;
        if (!cur.carry)
#pragma unroll
        for (int a = 0; a < 2; ++a)
#pragma unroll
            for (int b = 0; b < 2; ++b)
#pragma unroll
                for (int m = 0; m < 4; ++m)
#pragma unroll
                    for (int n = 0; n < 2; ++n) acc[a][b][m][n] = (f32x4){0.f, 0.f, 0.f, 0.f};
        cur = nxt; cA = nA; cB = nB; ++ui;
        if (wr == 1) PG8_BAR;
    }
    PG8_WAIT_V(0);
    PG8_BAR;
#undef PG8_SA
#undef PG8_SB
#undef PG8_STAGE
#undef PG8_LDA
#undef PG8_LDB
#undef PG8_MMA
#undef PG8_WAIT_V
#undef PG8_WAIT_L
#undef PG8_BAR
#undef PG8_SCHED
}
}
typedef GAS unsigned gu32;
#define XB_TMO      128
#define XB_XCNT(j)  (256  + 64 * (j))
#define XB_XSUB(j)  (1280 + 64 * (j))
#define XB_XGEN(j)  (2304 + 64 * (j))
#define XB_TOP      3328
#define XB_TOPGEN   3392
#define XCD_BAR_WORDS 3456
#define XB_SPIN_CAP (1u << 18)
__device__ __forceinline__ unsigned xb_ld(unsigned* p)              { return __hip_atomic_load(p, __ATOMIC_RELAXED, __HIP_MEMORY_SCOPE_AGENT); }
__device__ __forceinline__ unsigned xb_add(unsigned* p, unsigned v) { return __hip_atomic_fetch_add(p, v, __ATOMIC_RELAXED, __HIP_MEMORY_SCOPE_AGENT); }
__device__ __forceinline__ unsigned xb_xcc_id() { return (unsigned)__builtin_amdgcn_s_getreg((3 << 11) | 20) & 0xFu; }
#define XB_SPIN(cond, bar) do { unsigned _sp = 0; while (cond) { __builtin_amdgcn_s_sleep(1); \
    if ((++_sp & 255u) == 0u) { if (xb_ld(&(bar)[XB_TMO])) break; if (_sp > XB_SPIN_CAP) { atomicAdd(&(bar)[XB_TMO], 1u); break; } } } } while (0)
struct XcdBarrier { unsigned* bar; unsigned x; volatile LAS unsigned* st; };
__device__ __forceinline__ XcdBarrier xcd_barrier_post(unsigned* bar, volatile LAS unsigned* st) {
    XcdBarrier b; b.bar = bar; b.x = xb_xcc_id(); b.st = st;
    if (threadIdx.x == 0) (void)xb_add(&bar[XB_XCNT(b.x)], 1u);
    return b;
}
__device__ __forceinline__ void xcd_barrier_complete(unsigned* bar, unsigned x, unsigned& nloc, unsigned& nx) {
    const unsigned G = gridDim.x * gridDim.y * gridDim.z;
    unsigned sum, cnt, mine, sp = 0u;
    for (;;) {
        sum = 0u; cnt = 0u; mine = 0u;
#pragma unroll
        for (unsigned j = 0; j < 16; ++j) { const unsigned c = xb_ld(&bar[XB_XCNT(j)]); sum += c; cnt += (c > 0u) ? 1u : 0u; mine = (j == x) ? c : mine; }
        if (sum == G) break;
        __builtin_amdgcn_s_sleep(1);
        if ((++sp & 255u) == 0u) { if (xb_ld(&bar[XB_TMO])) break; if (sp > XB_SPIN_CAP) { atomicAdd(&bar[XB_TMO], 1u); break; } }
    }
    nloc = mine > 0u ? mine : 1u; nx = cnt > 0u ? cnt : 1u;
}
__device__ __forceinline__ void xcd_barrier(const XcdBarrier& b) {
    asm volatile("s_waitcnt vmcnt(0)" ::: "memory");
    __syncthreads();
    if (threadIdx.x == 0) {
        unsigned* bar = b.bar;
        __builtin_amdgcn_s_waitcnt(0);
        unsigned nloc = b.st[0], nx = b.st[1];
        if (nloc == 0u) { xcd_barrier_complete(bar, b.x, nloc, nx); b.st[0] = nloc; b.st[1] = nx; }
        const unsigned old = xb_add(&bar[XB_XSUB(b.x)], 1u);
        const unsigned gen = old / nloc;
        if (old + 1u == (gen + 1u) * nloc) {
            __builtin_amdgcn_fence(__ATOMIC_RELEASE, "agent");
            asm volatile("s_waitcnt vmcnt(0)" ::: "memory");
            const unsigned og = xb_add(&bar[XB_TOP], 1u);
            const unsigned tg = og / nx;
            if (og + 1u == (tg + 1u) * nx) xb_add(&bar[XB_TOPGEN], 1u);
            else XB_SPIN(xb_ld(&bar[XB_TOPGEN]) == tg, bar);
            __builtin_amdgcn_fence(__ATOMIC_ACQUIRE, "agent");
            xb_add(&bar[XB_XGEN(b.x)], 1u);
            asm volatile("s_waitcnt vmcnt(0)" ::: "memory");
        } else {
            XB_SPIN(xb_ld(&bar[XB_XGEN(b.x)]) == gen, bar);
            __builtin_amdgcn_fence(__ATOMIC_ACQUIRE, "agent");
            asm volatile("s_waitcnt vmcnt(0)" ::: "memory");
        }
    }
    __syncthreads();
}

constexpr int RING_OFF = 0, RING_BYTES = 131072;
constexpr int LDSCTL_OFF = RING_BYTES, MISC_OFF = LDSCTL_OFF + 320;
constexpr int LDS_BYTES = 147456;
constexpr int NWAVES = 8;
constexpr int CW_BAR = 4096;

struct Frame {
    LAS unsigned char* lds; unsigned char* ldsg;
    volatile LAS unsigned* MISC;
    int tid, lane, wave, vcu, G;
    float* out; unsigned char* ws;
};
typedef __attribute__((address_space(4))) const unsigned char* kargp_t;
__device__ __forceinline__ const float* karg_in(int i) { kargp_t p = (kargp_t)__builtin_amdgcn_kernarg_segment_ptr(); asm volatile("" : "+s"(p)); return *(const float* const __attribute__((address_space(4)))*)(p + 8 * i); }
#define KIN(k) karg_in(k)
__device__ __forceinline__ void p0_transpose_item(const float* W, int ldw, bf16* WT, int ldt, int koff, LAS float* scr, int k0, int n0, int scol0, int nvalid, int lane) {
    const int li = lane & 31; const bool ok = li < nvalid;
#pragma unroll 8
    for (int i = 0; i < 32; ++i) { const int kk = 2 * i + (lane >> 5); scr[kk * 33 + li] = ok ? W[(size_t)(k0 + kk) * ldw + scol0 + li] : 0.f; }
    LDS_WAIT(); asm volatile("" ::: "memory");
    const int c = lane & 7;
#pragma unroll
    for (int j = 0; j < 4; ++j) { const int n = (lane >> 3) + 8 * j; const LAS float* s = scr + (8 * c) * 33 + n;
        v4u o; o.x = pk2(s[0 * 33], s[1 * 33]); o.y = pk2(s[2 * 33], s[3 * 33]); o.z = pk2(s[4 * 33], s[5 * 33]); o.w = pk2(s[6 * 33], s[7 * 33]);
        *(GAS v4u*)(WT + (size_t)(n0 + n) * ldt + koff + k0 + 8 * c) = o; }
    LDS_WAIT(); asm volatile("" ::: "memory");
}
__device__ __forceinline__ void win_map(int n0, int& scol0, int& nvalid) {
    nvalid = 32;
    if (n0 < 1536) scol0 = n0;
    else if (n0 < 4096) scol0 = n0 + 128;
    else if (n0 < 6144) scol0 = n0 + 136;
    else if (n0 < 6272) scol0 = n0 - 6144 + 1536;
    else if (n0 == 6272) { scol0 = 4224; nvalid = 8; }
    else { scol0 = 0; nvalid = 0; }
}
__device__ __forceinline__ void p0_prologue(Frame& F) {
    LAS float* scr = (LAS float*)(F.lds + RING_OFF + F.wave * 16384);
    const int gw = F.vcu * NWAVES + F.wave, NGW = F.G * NWAVES;
    bf16* WinT = (bf16*)(F.ws + WS_WINT); bf16* Wab = (bf16*)(F.ws + WS_WAB); bf16* WoutT = (bf16*)(F.ws + WS_WOUT);
    const float* w_in = KIN(2); const float* w_oa = KIN(16); const float* w_ob = KIN(17); const float* w_o = KIN(18);
    constexpr int I_IN = 16 * 200, I_AB = 8 * 32, I_OUT = 16 * 32;
    constexpr int NITEMS = I_IN + 2 * I_AB + I_OUT;
    for (int it = gw; it < NITEMS; it += NGW) {
        int r = it;
        if (r < I_IN) { const int kb = r / 200, nb = r % 200; int sc, nv; win_map(32 * nb, sc, nv); p0_transpose_item(w_in, IN_COLS, WinT, 1024, 0, scr, 64 * kb, 32 * nb, sc, nv, F.lane); continue; } r -= I_IN;
        if (r < I_AB) { const int kb = r / 32, nb = r % 32; p0_transpose_item(w_oa, 1024, Wab, 1024, 0, scr, 64 * kb, 32 * nb, 32 * nb, 32, F.lane); continue; } r -= I_AB;
        if (r < I_AB) { const int kb = r / 32, nb = r % 32; p0_transpose_item(w_ob, 1024, Wab, 1024, 512, scr, 64 * kb, 32 * nb, 32 * nb, 32, F.lane); continue; } r -= I_AB;
        { const int kb = r / 32, nb = r % 32; p0_transpose_item(w_o, 1024, WoutT, 1024, 0, scr, 64 * kb, 32 * nb, 32 * nb, 32, F.lane); }
    }
    bf16* Acomb = (bf16*)(F.ws + WS_ACOMB);
    const GAS f32x4* gp = (const GAS f32x4*)KIN(1) + F.lane;
    f32x4 g[4];
#pragma unroll
    for (int j = 0; j < 4; ++j) g[j] = gp[64 * j];
    const float* xin = KIN(0);
    for (int m = gw; m < T; m += NGW) {
        const GAS f32x4* xr = (const GAS f32x4*)(xin + (size_t)m * DM) + F.lane;
        f32x4 v[4]; float s = 0.f;
#pragma unroll
        for (int j = 0; j < 4; ++j) { v[j] = xr[64 * j]; s += (v[j].x * v[j].x + v[j].y * v[j].y) + (v[j].z * v[j].z + v[j].w * v[j].w); }
        const float rstd = 1.f / sqrtf(wave_sum(s) * (1.f / DM) + RMS_EPS);
        GAS unsigned long long* o8 = (GAS unsigned long long*)(Acomb + (size_t)m * ACOMB_LD) + F.lane;
#pragma unroll
        for (int j = 0; j < 4; ++j) o8[64 * j] = (unsigned long long)pk2(v[j].x * rstd * g[j].x, v[j].y * rstd * g[j].y) | ((unsigned long long)pk2(v[j].z * rstd * g[j].z, v[j].w * rstd * g[j].w) << 32);
    }
}

struct SchedP1 {
    int c, G; const char* A; const char* B;
    __device__ __forceinline__ bool next(int i, pg8::Unit& u) const {
        constexpr int nM = 64, nN = 17, nwg = nM * nN, NX = 8, WGM = 8;
        const int L = i * G + c; if (L >= nwg) return false;
        int wgid = L; { const int q = nwg / NX, r = nwg % NX, xcd = wgid % NX, off = wgid / NX; wgid = (xcd < r ? xcd * (q + 1) : r * (q + 1) + (xcd - r) * q) + off; }
        const int nig = WGM * nN, gid = wgid / nig, fm = gid * WGM;
        u.pm = fm + ((wgid % nig) % WGM); int pn = (wgid % nig) / WGM; u.pn = pn == 16 ? 24 : pn; u.kind = 0; u.nt = 16; u.carry = 0;
        u.a = A + (size_t)u.pm * 256 * ACOMB_LD * 2; u.b = B + (size_t)u.pn * 256 * 1024 * 2; return true;
    }
};
struct EpiP1 {
    bf16* UA; bf16* UB; float* US;
    __device__ __forceinline__ void operator()(f32x4 (&acc)[2][2][4][2], const pg8::Unit& u, int wr, int wc, int fr, int fq) const {
        const int row0 = u.pm * 256 + wr * 64 + fr;
        if (u.pn < 16) {
            bf16* base = (u.pn < 8 ? UA + u.pn * 256 : UB + (u.pn - 8) * 256) + wc * 32 + 8 * fq;
#pragma unroll
            for (int ai = 0; ai < 2; ++ai)
#pragma unroll
                for (int m = 0; m < 4; ++m) { bf16* rowp = base + (size_t)(row0 + ai * 128 + m * 16) * U_LD;
#pragma unroll
                    for (int bj = 0; bj < 2; ++bj) { const f32x4 v0 = acc[ai][bj][m][0], v1 = acc[ai][bj][m][1];
                        pg8::u32x4 w; w.x = pg8::cvt_pk_bf16(v0[0], v0[1]); w.y = pg8::cvt_pk_bf16(v0[2], v0[3]); w.z = pg8::cvt_pk_bf16(v1[0], v1[1]); w.w = pg8::cvt_pk_bf16(v1[2], v1[3]);
                        *(pg8::u32x4*)(rowp + bj * 128) = w; } }
        } else {
            float* base = US + wc * 32 + 8 * fq;
#pragma unroll
            for (int ai = 0; ai < 2; ++ai)
#pragma unroll
                for (int m = 0; m < 4; ++m) { float* rowp = base + (size_t)(row0 + ai * 128 + m * 16) * 256;
#pragma unroll
                    for (int bj = 0; bj < 2; ++bj) { *(f32x4*)(rowp + bj * 128) = acc[ai][bj][m][0]; *(f32x4*)(rowp + bj * 128 + 4) = acc[ai][bj][m][1]; } }
        }
    }
};

__device__ __forceinline__ float softplusf_(float x) { return fmaxf(x, 0.f) + __builtin_amdgcn_logf(1.0f + fexp(-fabsf(x))) * 0.6931471805599453f; }
__device__ __forceinline__ float ftanh(float x) { return 1.0f - 2.0f * frcp(fexp(2.0f * x) + 1.0f); }
template <int PRB> __device__ __forceinline__ void p2_prep(Frame& F) {
    const int lane = F.lane, wave = F.wave, tid = F.tid, fr = lane & 15, fq = lane >> 4;
    const float* US = (const float*)(F.ws + WS_US);
    const float* mu = KIN(3);
    const int r0 = F.vcu * 64;
    LAS bf16* At = (LAS bf16*)(F.lds + RING_OFF);
    LAS bf16* Aa = At + 64 * 72;
    {
        const int row = tid >> 3, c8 = (tid & 7) * 8; const int m = r0 + row; const bool first = (m % SEQ) == 0; const int mp = first ? m : m - 1;
        const f32x4 cw0 = *(const f32x4*)(US + (size_t)m * 256 + c8), cw1 = *(const f32x4*)(US + (size_t)m * 256 + c8 + 4), ca0 = *(const f32x4*)(US + (size_t)m * 256 + 64 + c8), ca1 = *(const f32x4*)(US + (size_t)m * 256 + 64 + c8 + 4);
        f32x4 pw0 = *(const f32x4*)(US + (size_t)mp * 256 + c8), pw1 = *(const f32x4*)(US + (size_t)mp * 256 + c8 + 4), pa0 = *(const f32x4*)(US + (size_t)mp * 256 + 64 + c8), pa1 = *(const f32x4*)(US + (size_t)mp * 256 + 64 + c8 + 4);
        if (first) { pw0 = (f32x4){0.f, 0.f, 0.f, 0.f}; pw1 = pw0; pa0 = pw0; pa1 = pw0; }
        const f32x4 mw0 = *(const f32x4*)(mu + 1536 + c8), mw1 = *(const f32x4*)(mu + 1536 + c8 + 4), ma0 = *(const f32x4*)(mu + 1600 + c8), ma1 = *(const f32x4*)(mu + 1600 + c8 + 4);
        const f32x4 w0 = cw0 + (pw0 - cw0) * mw0, w1 = cw1 + (pw1 - cw1) * mw1, a0 = ca0 + (pa0 - ca0) * ma0, a1 = ca1 + (pa1 - ca1) * ma1;
        v4u ow, oa;
        ow.x = pk2(ftanh(w0[0]), ftanh(w0[1])); ow.y = pk2(ftanh(w0[2]), ftanh(w0[3])); ow.z = pk2(ftanh(w1[0]), ftanh(w1[1])); ow.w = pk2(ftanh(w1[2]), ftanh(w1[3]));
        oa.x = pk2(a0[0], a0[1]); oa.y = pk2(a0[2], a0[3]); oa.z = pk2(a1[0], a1[1]); oa.w = pk2(a1[2], a1[3]);
        *(LAS v4u*)(At + row * 72 + c8) = ow; *(LAS v4u*)(Aa + row * 72 + c8) = oa;
    }
    __syncthreads();
    {
        float* DEC = PRB ? (float*)(F.ws + WS_UA) : F.out; float* LR = DEC + (size_t)T * 512;
        const float* wup = KIN(4); const float* aup = KIN(6); const float* w0p = KIN(5); const float* a0p = KIN(7);
        bf16x8 bt[4][2], ba[4][2];
#pragma unroll
        for (int tt = 0; tt < 4; ++tt)
#pragma unroll
            for (int ks = 0; ks < 2; ++ks) { bt[tt][ks] = *(const LAS bf16x8*)(At + (16 * tt + fr) * 72 + 32 * ks + 8 * fq); ba[tt][ks] = *(const LAS bf16x8*)(Aa + (16 * tt + fr) * 72 + 32 * ks + 8 * fq); }
#pragma unroll 1
        for (int ct = 0; ct < 4; ++ct) {
            const int chA = 64 * wave + 16 * ct + fr;
            bf16x8 wf[2], af[2];
#pragma unroll
            for (int ks = 0; ks < 2; ++ks) { float x[8], y[8];
#pragma unroll
                for (int j = 0; j < 8; ++j) { x[j] = wup[(size_t)(32 * ks + 8 * fq + j) * 512 + chA]; y[j] = aup[(size_t)(32 * ks + 8 * fq + j) * 512 + chA]; }
                v4u w; w.x = pk2(x[0], x[1]); w.y = pk2(x[2], x[3]); w.z = pk2(x[4], x[5]); w.w = pk2(x[6], x[7]); wf[ks] = __builtin_bit_cast(bf16x8, w);
                v4u a; a.x = pk2(y[0], y[1]); a.y = pk2(y[2], y[3]); a.z = pk2(y[4], y[5]); a.w = pk2(y[6], y[7]); af[ks] = __builtin_bit_cast(bf16x8, a); }
            const int ch4 = 64 * wave + 16 * ct + 4 * fq;
            const f32x4 w0v = *(const f32x4*)(w0p + ch4), a0v = *(const f32x4*)(a0p + ch4);
#pragma unroll
            for (int tt = 0; tt < 4; ++tt) {
                f32x4 aw = (f32x4){0.f, 0.f, 0.f, 0.f}, aa = aw;
#pragma unroll
                for (int ks = 0; ks < 2; ++ks) { aw = __builtin_amdgcn_mfma_f32_16x16x32_bf16(wf[ks], bt[tt][ks], aw, 0, 0, 0); aa = __builtin_amdgcn_mfma_f32_16x16x32_bf16(af[ks], ba[tt][ks], aa, 0, 0, 0); }
                f32x4 dv, lv;
#pragma unroll
                for (int e = 0; e < 4; ++e) { const float z = w0v[e] + aw[e]; const float w = -softplusf_(-z) - 0.5f; dv[e] = fexp(-fexp(w)); lv[e] = sigmoidf_(a0v[e] + aa[e]); }
                const size_t o = (size_t)(r0 + 16 * tt + fr) * 512 + ch4;
                *(f32x4*)(DEC + o) = dv; *(f32x4*)(LR + o) = lv;
            }
        }
    }
    {
        bf16* UB = (bf16*)(F.ws + WS_UB);
        const int d0 = (lane & 7) * 8;
        float gq[8], gk[8];
        { const float* qg = KIN(14); const float* kg = KIN(15);
#pragma unroll
        for (int e = 0; e < 8; ++e) { gq[e] = qg[d0 + e] * C2; gk[e] = kg[d0 + e]; } }
#pragma unroll 1
        for (int it = 0; it < 4; ++it) {
            v4u w[4]; GAS v4u* p[4];
#pragma unroll
            for (int u = 0; u < 4; ++u) { const int tsk = wave * 16 + it * 4 + u; const int m = r0 + (tsk >> 1), which = tsk & 1;
                p[u] = (GAS v4u*)(UB + (size_t)m * U_LD + which * 512) + lane; w[u] = *p[u]; }
#pragma unroll
            for (int u = 0; u < 4; ++u) { const int which = u & 1;
                float x[8] = {bflo(w[u].x), bfhi(w[u].x), bflo(w[u].y), bfhi(w[u].y), bflo(w[u].z), bfhi(w[u].z), bflo(w[u].w), bfhi(w[u].w)};
                float s = 0.f;
#pragma unroll
                for (int e = 0; e < 8; ++e) s += x[e] * x[e];
                s += dppf<0xB1>(s); s += dppf<0x4E>(s); s += dppf<0x141>(s);
                const float rs = 1.f / sqrtf(s * (1.f / 64.f) + RMS_EPS);
#pragma unroll
                for (int e = 0; e < 8; ++e) x[e] = x[e] * rs * (which ? gk[e] : gq[e]);
                v4u o; o.x = pk2(x[0], x[1]); o.y = pk2(x[2], x[3]); o.z = pk2(x[4], x[5]); o.w = pk2(x[6], x[7]);
                if (PRB) *((GAS v4u*)((bf16*)(F.ws + WS_UA) + ((char*)p[u] - (char*)UB) / 2)) = o; else *p[u] = o; }
        }
    }
    __syncthreads();
    if (F.vcu < 64) {
        const int b = F.vcu >> 3, h = F.vcu & 7; const float fb = KIN(13)[h];
        float* G2 = (float*)(F.ws + (PRB ? WS_UB : WS_G2)) + (size_t)F.vcu * SEQ + 4 * tid;
        LAS float* wtot = (LAS float*)(F.lds + RING_OFF);
        float v[4]; float run = 0.f;
#pragma unroll
        for (int i = 0; i < 4; ++i) v[i] = US[(size_t)(b * SEQ + 4 * tid + i) * 256 + 128 + h] + fb;
#pragma unroll
        for (int i = 0; i < 4; ++i) { run += -softplusf_(-v[i]) * LOG2E; v[i] = run; }
        float ex = run;
#pragma unroll
        for (int o = 1; o < 64; o <<= 1) { const float nn = __shfl_up(ex, o); if (lane >= o) ex += nn; }
        if (lane == 63) wtot[wave] = ex;
        __syncthreads();
        float woff = 0.f;
#pragma unroll
        for (int w = 0; w < 8; ++w) { const float tw = wtot[w]; if (w < wave) woff += tw; }
        const float off = woff + ex - run;
        *(f32x4*)G2 = (f32x4){v[0] + off, v[1] + off, v[2] + off, v[3] + off};
    }
    __syncthreads();
}
__device__ __forceinline__ int crow(int r, int hi) { return (r & 3) + 8 * (r >> 2) + 4 * hi; }
namespace attn_body {
using bf16=__hip_bfloat16;
using u32x4=__attribute__((ext_vector_type(4)))unsigned;
constexpr int BATCH=8,NHEAD=8,SEQ=2048,D=64,DM=2048;
constexpr int NW=8,QBLK=32,QB=QBLK*NW,KVBLK=64,NQB=SEQ/QB;
constexpr int ATTN_PITCH=DM, ATTN_UNIT_ROWS=QB;
#define SBAR() __builtin_amdgcn_sched_barrier(0)
__device__ __forceinline__ void cmask(f32x16&p0,f32x16&p1,int jb,int qrel,int hi){
  const float NEG=-INFINITY; int kb=64*jb+4*hi;
  #pragma unroll
  for(int r=0;r<16;++r){int kv=kb+(r&3)+8*(r>>2); if(kv>qrel)p0[r]=NEG; if(kv+32>qrel)p1[r]=NEG;}
}

constexpr int NSLOT=3, SLOTB=8192;
constexpr int LDS_K=0, LDS_V=NSLOT*SLOTB, LDS_WS=2*NSLOT*SLOTB, LDS_OST=LDS_WS+NW*64*4, LDS_KX=LDS_OST, LDS_BYTES=LDS_OST+NW*4096;
constexpr float C2A=0.125f*1.4426950408889634f;
__device__ __forceinline__ void glds16(const void*gsrc,unsigned lds_dst){unsigned keep;
  asm volatile("s_mov_b32 %0, m0\n\ts_mov_b32 m0, %2\n\ts_nop 0\n\tglobal_load_lds_dwordx4 %1, off\n\ts_mov_b32 m0, %0":"=&s"(keep):"v"(gsrc),"s"(lds_dst):"memory");}
__device__ __forceinline__ float max3f(float a,float b,float c){float r;asm("v_max3_f32 %0, %1, %2, %3":"=v"(r):"v"(a),"v"(b),"v"(c));return r;}
__device__ __forceinline__ float max2f(float a,float b){float r;asm("v_max_f32_e32 %0, %1, %2":"=v"(r):"v"(a),"v"(b));return r;}
__device__ __forceinline__ float fadd_s(float a,float b){float r;asm("v_add_f32_e32 %0, %1, %2":"=v"(r):"v"(a),"v"(b));return r;}
__device__ __forceinline__ float fsub_s(float a,float b){float r;asm("v_sub_f32_e32 %0, %1, %2":"=v"(r):"v"(a),"v"(b));return r;}
typedef float f32x2_t __attribute__((ext_vector_type(2))); typedef __bf16 bf16x2_t __attribute__((ext_vector_type(2)));
__device__ __forceinline__ unsigned cvtpk_s(float lo,float hi){f32x2_t v={lo,hi};bf16x2_t b=__builtin_convertvector(v,bf16x2_t);return __builtin_bit_cast(unsigned,b);}
#define WAIT_BAR(N) asm volatile("s_waitcnt vmcnt(" #N ") lgkmcnt(0)\n\ts_barrier":::"memory")

__device__ __forceinline__ bf16x8 halfmask(bf16x8 x,unsigned m){u32x4 w=__builtin_bit_cast(u32x4,x);w.x&=m;w.y&=m;w.z&=m;w.w&=m;return __builtin_bit_cast(bf16x8,w);}
__device__ __forceinline__ void qkt(f32x16&p0,f32x16&p1,const char*Kslot,const bf16x8*qr,bf16x8 kx,bf16x8 qr4,int r32,int hi){
  p0=__builtin_amdgcn_mfma_f32_32x32x16_bf16(halfmask(kx,(unsigned)hi-1u),qr4,f32x16{},0,0,0);p1=__builtin_amdgcn_mfma_f32_32x32x16_bf16(halfmask(kx,0u-(unsigned)hi),qr4,f32x16{},0,0,0);
  const char*kb=Kslot+hi*1024+r32*16;
  #pragma unroll
  for(int d0=0;d0<4;++d0){
    const bf16x8 b0=*reinterpret_cast<const bf16x8*>(kb+d0*2048);
    const bf16x8 b1=*reinterpret_cast<const bf16x8*>(kb+d0*2048+512);
    p0=__builtin_amdgcn_mfma_f32_32x32x16_bf16(b0,qr[d0],p0,0,0,0);p1=__builtin_amdgcn_mfma_f32_32x32x16_bf16(b1,qr[d0],p1,0,0,0);}
}
typedef __attribute__((address_space(3))) const char* lds_cptr;
typedef short v4i16_t __attribute__((ext_vector_type(4)));
__device__ __forceinline__ void kload8(bf16x8*kf,lds_cptr kp){
  kf[0]=*(const __attribute__((address_space(3))) bf16x8*)(kp);      kf[1]=*(const __attribute__((address_space(3))) bf16x8*)(kp+512);
  kf[2]=*(const __attribute__((address_space(3))) bf16x8*)(kp+2048); kf[3]=*(const __attribute__((address_space(3))) bf16x8*)(kp+2560);
  kf[4]=*(const __attribute__((address_space(3))) bf16x8*)(kp+4096); kf[5]=*(const __attribute__((address_space(3))) bf16x8*)(kp+4608);
  kf[6]=*(const __attribute__((address_space(3))) bf16x8*)(kp+6144); kf[7]=*(const __attribute__((address_space(3))) bf16x8*)(kp+6656);
}
__device__ __forceinline__ void kload2(bf16x8*kf,lds_cptr kp,int j){ kf[2*j]=*(const __attribute__((address_space(3))) bf16x8*)(kp+j*2048); kf[2*j+1]=*(const __attribute__((address_space(3))) bf16x8*)(kp+j*2048+512); }
__device__ __forceinline__ s16x4 vtr(lds_cptr p){ return __builtin_bit_cast(s16x4,__builtin_amdgcn_ds_read_tr16_b64_v4i16((__attribute__((address_space(3))) v4i16_t*)p)); }
__device__ __forceinline__ float rowmax(const f32x16&p0,const f32x16&p1){
  float a=max3f(p0[0],p0[1],p1[0]),b=max3f(p0[2],p0[3],p1[1]);a=max3f(a,p1[2],p1[3]);
  #pragma unroll
  for(int r=4;r<16;r+=4){a=max3f(a,p0[r],p0[r+1]);b=max3f(b,p0[r+2],p0[r+3]);a=max3f(a,p1[r],p1[r+1]);b=max3f(b,p1[r+2],p1[r+3]);}
  const float m=max2f(a,b);
  auto rr=__builtin_amdgcn_permlane32_swap(__float_as_uint(m),__float_as_uint(m),false,false);
  return max2f(__uint_as_float(rr[0]),__uint_as_float(rr[1]));
}
__device__ __forceinline__ void pv(f32x16*o,int vb,bf16x8 pa0,bf16x8 pa1,bf16x8 pa2,bf16x8 pa3){
  #pragma unroll
  for(int d0=0;d0<2;++d0){s16x4 lo[4],hi[4];
    #pragma unroll
    for(int ks=0;ks<4;++ks){
      asm volatile("ds_read_b64_tr_b16 %0,%1 offset:%c2":"=&v"(lo[ks]):"v"(vb),"i"(d0*4096+ks*1024):"memory");
      asm volatile("ds_read_b64_tr_b16 %0,%1 offset:%c2":"=&v"(hi[ks]):"v"(vb),"i"(d0*4096+ks*1024+512):"memory");}
    asm volatile("s_waitcnt lgkmcnt(0)":::"memory");SBAR();
    #define PK(k) (bf16x8){lo[k][0],lo[k][1],lo[k][2],lo[k][3],hi[k][0],hi[k][1],hi[k][2],hi[k][3]}
    o[d0]=__builtin_amdgcn_mfma_f32_32x32x16_bf16(pa0,PK(0),o[d0],0,0,0);
    o[d0]=__builtin_amdgcn_mfma_f32_32x32x16_bf16(pa1,PK(1),o[d0],0,0,0);
    o[d0]=__builtin_amdgcn_mfma_f32_32x32x16_bf16(pa2,PK(2),o[d0],0,0,0);
    o[d0]=__builtin_amdgcn_mfma_f32_32x32x16_bf16(pa3,PK(3),o[d0],0,0,0);
    #undef PK
  }
}

#ifndef ATTN_STORE16
#define ATTN_STORE16(p,v) (*(u32x4*)(p)=(v))
#endif
__device__ __forceinline__ void split3(float x,unsigned&h_,unsigned&m_,unsigned&l_){h_=f2bf(x);const float r1=x-bf2f(h_);m_=f2bf(r1);const float r2=r1-bf2f(m_);l_=f2bf(r2);}
__device__ __forceinline__ bf16x8 mk_qr4(float c,int hi){unsigned a,b_,c_;split3(c,a,b_,c_);u32x4 w={a|(b_<<16),c_|(0x3F80u<<16),0x3F803F80u,0u};(void)hi;return __builtin_bit_cast(bf16x8,w);}
template<int THRL> __device__ __forceinline__ void attn_unit(int b,int h,int qb,const bf16*Q,const bf16*__restrict__ K,const bf16*__restrict__ V,const bf16*GATE,const float*G2bh,bf16*O,char*shm){
  const int tid=threadIdx.x,lane=tid&63,r32=lane&31,hi=lane>>5; const int wid=__builtin_amdgcn_readfirstlane(tid>>6);
  const long rowbase=(long)b*SEQ; const int q0=qb*QB;
  const bf16*Qw=Q+(rowbase+q0+wid*QBLK)*DM+h*D;
  const bf16*Kh=K+rowbase*DM+h*D,*Vh=V+rowbase*DM+h*D;
  const float gq=G2bh[q0+wid*QBLK+r32];
  const unsigned lds0=(unsigned)(uintptr_t)shm;
  float*wsf=(float*)(shm+LDS_WS)+wid*64;
  const bf16*ksrc=Kh+(long)lane*DM+wid*8;
  const bf16*vsrc=Vh+(long)(16*(wid&3)+(lane>>2))*DM+(wid>>2)*32+(lane&3)*8;
  const unsigned kdst=lds0+LDS_K+wid*1024, vdst=lds0+LDS_V+wid*1024;
  #define DMA_K(t,slot) glds16(ksrc+(long)(t)*KVBLK*DM,(unsigned)__builtin_amdgcn_readfirstlane(kdst+(slot)))
  #define DMA_V(t,slot) glds16(vsrc+(long)(t)*KVBLK*DM,(unsigned)__builtin_amdgcn_readfirstlane(vdst+(slot)))
  const int vb0=(int)(lds0+LDS_V)+((lane>>4)&1)*32+(lane&3)*8+(4*hi+((lane&15)>>2))*64;
  const char*Kbase=shm+LDS_K; bf16x8 kf[8];
  const lds_cptr shm3=(lds_cptr)shm; const lds_cptr kp0=shm3+LDS_K+hi*1024+r32*16; const lds_cptr vp0=shm3+LDS_V+((lane>>4)&1)*32+(lane&3)*8+(4*hi+((lane&15)>>2))*64;
  const lds_cptr kxp=shm3+LDS_KX+(r32+32*hi)*16;
  bf16x8 kx;
  const int NT=(q0+QB)/KVBLK;
  DMA_K(0,0);DMA_V(0,0);DMA_K(1,SLOTB);
  bf16x8 qr[4];
  #pragma unroll
  for(int d0=0;d0<4;++d0)qr[d0]=*reinterpret_cast<const bf16x8*>(&Qw[(long)r32*DM+d0*16+hi*8]);
  float mhat=0.f,l_reg=0.f;f32x16 o[2];o[0]=f32x16{};o[1]=f32x16{};bf16x8 qr4=mk_qr4(gq,hi);
  { float gk[4]; _Pragma("unroll") for(int i=0;i<4;++i){const int k=tid+512*i; gk[i]=(k<q0+QB)?G2bh[k]:0.f;}
    asm volatile("s_waitcnt vmcnt(0)":::"memory");
    _Pragma("unroll") for(int i=0;i<4;++i){const int k=tid+512*i; if(k<q0+QB){unsigned a,b_,c_;split3(-gk[i],a,b_,c_); *(__attribute__((address_space(3))) u32x4*)(shm3+LDS_KX+k*16)=u32x4{0x3F803F80u,0x3F80u|(a<<16),b_|(c_<<16),0u};}}
  }
  const int qrel=wid*QBLK+r32;
  #define CMASK(P0,P1,t) do{int jb_=(t)-(NT-4); if(jb_>=0)cmask(P0,P1,jb_,qrel,hi);}while(0)
  bool resc=false;
  #define START(P0,P1) do{ const float rm=rowmax(P0,P1); resc=false; \
    { const float dl=rm; mhat=fadd_s(mhat,dl); \
      _Pragma("unroll") for(int r=0;r<16;++r){P0[r]=fsub_s(P0[r],dl);P1[r]=fsub_s(P1[r],dl);} \
      qr4=mk_qr4(gq-mhat,hi); } \
    _Pragma("unroll") for(int r=0;r<16;++r)P0[r]=__builtin_amdgcn_exp2f(P0[r]); }while(0)
  #define RESC() do{ if(resc){ asm volatile("s_waitcnt lgkmcnt(0)":::"memory"); \
      _Pragma("unroll") for(int d_=0;d_<2;++d_) _Pragma("unroll") for(int r=0;r<16;++r)o[d_][r]*=wsf[crow(r,hi)]; } }while(0)
  f32x16 pA0,pA1,pB0,pB1;
  int sl_prev=0,sl_cur=0,sl_next=SLOTB;
  #define ROT() do{sl_prev=sl_cur;sl_cur=sl_next;sl_next=(sl_next==(NSLOT-1)*SLOTB)?0:sl_next+SLOTB;}while(0)
  DMA_K(2,2*SLOTB);
  WAIT_BAR(3);
  kx=*(const __attribute__((address_space(3))) bf16x8*)(kxp);
  qkt(pA0,pA1,Kbase,qr,kx,qr4,r32,hi);asm volatile("s_nop 15\n\ts_nop 7":"+v"(pA0),"+v"(pA1));CMASK(pA0,pA1,0);
  START(pA0,pA1);
  _Pragma("unroll") for(int r=0;r<16;++r)pA1[r]=__builtin_amdgcn_exp2f(pA1[r]);
  WAIT_BAR(0);
  DMA_K(3,0);DMA_V(1,SLOTB);
  ROT();
  kload8(kf,kp0+sl_cur);
  kx=*(const __attribute__((address_space(3))) bf16x8*)(kxp+1024);
  WAIT_BAR(2);
  s16x4 vlo[8],vhi[8]; u32x4 pw0,pw1,pw2,pw3;
  #define PKW(P,B) cvtpk_s(P[B],P[B+1])
  #define PAF(k) __builtin_bit_cast(bf16x8,pw##k)
  #define VFR(i) (bf16x8){vlo[i][0],vlo[i][1],vlo[i][2],vlo[i][3],vhi[i][0],vhi[i][1],vhi[i][2],vhi[i][3]}
  #define PIN(x) asm volatile("":"+v"(x))
  #define MX3(a,b,c) __builtin_fmaxf(__builtin_fmaxf((a),(b)),(c))
  #define GAPA(MF,A0,A1,A2,A3,W0,W1,PW) do{ MF; sacc+=A0; sacc+=A1; sacc+=A2; sacc+=A3; PIN(sacc); W0; W1; PIN(PW); SBAR(); }while(0)
  #define EX(v) __builtin_amdgcn_exp2f(v)
  #define GAPB(MF,X,B) do{ MF; X[B]=EX(X[B]); X[B+1]=EX(X[B+1]); X[B+2]=EX(X[B+2]); X[B+3]=EX(X[B+3]); PIN(X); SBAR(); }while(0)
  #define VRD(i) do{ vlo[i]=vtr(vp_+(((i)>>2)*4096+((i)&3)*1024)); vhi[i]=vtr(vp_+(((i)>>2)*4096+((i)&3)*1024+512)); }while(0)
  #define KRD(G,j) do{ if(G){ kload2(kf,kp0+sl_next,j); SBAR(); } }while(0)
  #define KXRD(G,t) do{ if(G){ kx=*(const __attribute__((address_space(3))) bf16x8*)(kxp+((t)+1)*1024); SBAR(); } }while(0)
  #define STEP(C0,C1,P0,P1,t,GK,GV,GL) do{ SBAR(); \
    const lds_cptr vp_=vp0+sl_prev; \
    C0=__builtin_amdgcn_mfma_f32_32x32x16_bf16(halfmask(kx,(unsigned)hi-1u),qr4,f32x16{},0,0,0); C1=__builtin_amdgcn_mfma_f32_32x32x16_bf16(halfmask(kx,0u-(unsigned)hi),qr4,f32x16{},0,0,0); SBAR(); \
    VRD(0); SBAR(); float sacc=(P0[0]+P0[1]); \
    GAPA(C0=__builtin_amdgcn_mfma_f32_32x32x16_bf16(kf[0],qr[0],C0,0,0,0), P0[2],P0[3],P0[4],P0[5],     pw0[0]=PKW(P0,0), pw0[1]=PKW(P0,2), pw0); \
    VRD(4); SBAR(); GAPA(C1=__builtin_amdgcn_mfma_f32_32x32x16_bf16(kf[1],qr[0],C1,0,0,0), P0[6],P0[7],P0[8],P0[9],     pw0[2]=PKW(P0,4), pw0[3]=PKW(P0,6), pw0); \
    VRD(1); SBAR(); GAPA(C0=__builtin_amdgcn_mfma_f32_32x32x16_bf16(kf[2],qr[1],C0,0,0,0),   P0[10],P0[11],P0[12],P0[13], pw1[0]=PKW(P0,8), pw1[1]=PKW(P0,10), pw1); \
    VRD(5); SBAR(); GAPA(C1=__builtin_amdgcn_mfma_f32_32x32x16_bf16(kf[3],qr[1],C1,0,0,0),   P0[14],P0[15],P1[0],P1[1],   pw1[2]=PKW(P0,12),pw1[3]=PKW(P0,14), pw1); \
    VRD(2); SBAR(); GAPA(C0=__builtin_amdgcn_mfma_f32_32x32x16_bf16(kf[4],qr[2],C0,0,0,0),   P1[2],P1[3],P1[4],P1[5],     pw2[0]=PKW(P1,0), pw2[1]=PKW(P1,2), pw2); \
    VRD(6); SBAR(); GAPA(C1=__builtin_amdgcn_mfma_f32_32x32x16_bf16(kf[5],qr[2],C1,0,0,0),   P1[6],P1[7],P1[8],P1[9],     pw2[2]=PKW(P1,4), pw2[3]=PKW(P1,6), pw2); \
    VRD(3); SBAR(); GAPA(C0=__builtin_amdgcn_mfma_f32_32x32x16_bf16(kf[6],qr[3],C0,0,0,0),   P1[10],P1[11],P1[12],P1[13], pw3[0]=PKW(P1,8), pw3[1]=PKW(P1,10), pw3); \
    VRD(7); SBAR(); GAPA(C1=__builtin_amdgcn_mfma_f32_32x32x16_bf16(kf[7],qr[3],C1,0,0,0),   P1[14],P1[15],0.f,0.f,       pw3[2]=PKW(P1,12),pw3[3]=PKW(P1,14), pw3); \
    l_reg+=sacc; \
    if(GK){DMA_K((t)+3,sl_cur);} if(GV){DMA_V((t)+1,sl_next);} \
    CMASK(C0,C1,t); \
    { float a=MX3(C0[0],C0[1],C1[0]),b=MX3(C0[2],C0[3],C1[1]); a=MX3(a,C1[2],C1[3]); \
      _Pragma("unroll") for(int r=4;r<16;r+=4){a=MX3(a,C0[r],C0[r+1]);b=MX3(b,C0[r+2],C0[r+3]);a=MX3(a,C1[r],C1[r+1]);b=MX3(b,C1[r+2],C1[r+3]);} \
      float rm=__builtin_fmaxf(a,b); { auto rr=__builtin_amdgcn_permlane32_swap(__float_as_uint(rm),__float_as_uint(rm),false,false); rm=__builtin_fmaxf(__uint_as_float(rr[0]),__uint_as_float(rr[1])); } \
      resc=false; \
      if(__builtin_expect(__any(rm>(float)THRL),0)){ const float dl=__builtin_fmaxf(rm,0.f); mhat+=dl; \
        _Pragma("unroll") for(int r=0;r<16;++r){C0[r]-=dl;C1[r]-=dl;} \
        qr4=mk_qr4(gq-mhat,hi); \
        const float f=__builtin_amdgcn_exp2f(-dl); l_reg*=f; if(hi==0)wsf[r32]=f; resc=true; } } \
    SBAR(); \
    GAPB(o[0]=__builtin_amdgcn_mfma_f32_32x32x16_bf16(PAF(0),VFR(0),o[0],0,0,0), C0,0); \
    GAPB(o[1]=__builtin_amdgcn_mfma_f32_32x32x16_bf16(PAF(0),VFR(4),o[1],0,0,0), C0,4); \
    KRD(GL,0); GAPB(o[0]=__builtin_amdgcn_mfma_f32_32x32x16_bf16(PAF(1),VFR(1),o[0],0,0,0), C0,8); \
    KRD(GL,1); GAPB(o[1]=__builtin_amdgcn_mfma_f32_32x32x16_bf16(PAF(1),VFR(5),o[1],0,0,0), C0,12); \
    KRD(GL,2); GAPB(o[0]=__builtin_amdgcn_mfma_f32_32x32x16_bf16(PAF(2),VFR(2),o[0],0,0,0), C1,0); \
    KRD(GL,3); GAPB(o[1]=__builtin_amdgcn_mfma_f32_32x32x16_bf16(PAF(2),VFR(6),o[1],0,0,0), C1,4); \
    KXRD(GL,t); GAPB(o[0]=__builtin_amdgcn_mfma_f32_32x32x16_bf16(PAF(3),VFR(3),o[0],0,0,0), C1,8); \
    GAPB(o[1]=__builtin_amdgcn_mfma_f32_32x32x16_bf16(PAF(3),VFR(7),o[1],0,0,0), C1,12); \
    }while(0)
  int t=1;
  #undef CMASK
  #define CMASK(P0,P1,t) do{}while(0)
  for(;t+5<NT;t+=2){
    STEP(pB0,pB1,pA0,pA1,t,true,true,true);     WAIT_BAR(2); RESC(); ROT();
    STEP(pA0,pA1,pB0,pB1,t+1,true,true,true);   WAIT_BAR(2); RESC(); ROT();
  }
  #undef CMASK
  #define CMASK(P0,P1,t) do{int jb_=(t)-(NT-4); if(jb_>=0)cmask(P0,P1,jb_,qrel,hi);}while(0)
  #define ENDW(tt) do{ if((tt)+3<NT){WAIT_BAR(2);} else if((tt)+2<NT){WAIT_BAR(1);} else {WAIT_BAR(0);} }while(0)
  for(;t+1<NT;t+=2){
    STEP(pB0,pB1,pA0,pA1,t,(t+3<NT),(t+1<NT),(t+1<NT));       ENDW(t);   RESC(); ROT();
    STEP(pA0,pA1,pB0,pB1,t+1,(t+4<NT),(t+2<NT),(t+2<NT));     ENDW(t+1); RESC(); ROT();
  }
  STEP(pB0,pB1,pA0,pA1,NT-1,false,false,false); RESC();
  { float sacc=pB0[0]+pB0[1]; _Pragma("unroll") for(int r=2;r<16;++r)sacc+=pB0[r]; _Pragma("unroll") for(int r=0;r<16;++r)sacc+=pB1[r]; l_reg+=sacc;
    pw0=(u32x4){PKW(pB0,0),PKW(pB0,2),PKW(pB0,4),PKW(pB0,6)};pw1=(u32x4){PKW(pB0,8),PKW(pB0,10),PKW(pB0,12),PKW(pB0,14)};pw2=(u32x4){PKW(pB1,0),PKW(pB1,2),PKW(pB1,4),PKW(pB1,6)};pw3=(u32x4){PKW(pB1,8),PKW(pB1,10),PKW(pB1,12),PKW(pB1,14)};
    SBAR(); pv(o,vb0+sl_cur,PAF(0),PAF(1),PAF(2),PAF(3)); }
  #undef PKW
  #undef PAF
  #undef VFR
  #undef PIN
  #undef MX3
  #undef GAPA
  #undef GAPB
  #undef EX
  #undef VRD
  #undef KRD
  #undef KXRD
  #undef STEP
  #undef ENDW
  {auto rr=__builtin_amdgcn_permlane32_swap(__float_as_uint(l_reg),__float_as_uint(l_reg),false,false);l_reg=__uint_as_float(rr[0])+__uint_as_float(rr[1]);}
  if(hi==0)wsf[32+r32]=l_reg;asm volatile("s_waitcnt lgkmcnt(0)":::"memory");
  float rli[16];
  #pragma unroll
  for(int r=0;r<16;++r)rli[r]=__builtin_amdgcn_rcpf(wsf[32+crow(r,hi)]);
  bf16*Ow=O+(rowbase+q0+wid*QBLK)*DM+h*D;
  { bf16*stg=(bf16*)(shm+LDS_OST)+wid*2048;
    #pragma unroll
    for(int r=0;r<16;++r){const int orow=crow(r,hi);
      #pragma unroll
      for(int d0=0;d0<2;++d0)stg[orow*64+d0*32+r32]=__float2bfloat16(o[d0][r]*rli[r]);}
    asm volatile("s_waitcnt lgkmcnt(0)":::"memory");
    const bf16*Gw=GATE+(rowbase+q0+wid*QBLK)*DM+h*D;
    #pragma unroll
    for(int i=0;i<4;++i){const int row=i*8+(lane>>3),ch=lane&7; const u32x4 v=*(const u32x4*)(stg+row*64+ch*8); const u32x4 g=*(const u32x4*)(Gw+(long)row*DM+ch*8); u32x4 w;
      w.x=pk2(bflo(v.x)*siluf_(bflo(g.x)),bfhi(v.x)*siluf_(bfhi(g.x))); w.y=pk2(bflo(v.y)*siluf_(bflo(g.y)),bfhi(v.y)*siluf_(bfhi(g.y))); w.z=pk2(bflo(v.z)*siluf_(bflo(g.z)),bfhi(v.z)*siluf_(bfhi(g.z))); w.w=pk2(bflo(v.w)*siluf_(bflo(g.w)),bfhi(v.w)*siluf_(bfhi(g.w)));
      ATTN_STORE16(Ow+(long)row*DM+ch*8,w);} }
  asm volatile("s_waitcnt lgkmcnt(0)\n\ts_barrier":::"memory");
  #undef DMA_K
  #undef DMA_V
  #undef CMASK
  #undef START
  #undef RESC
  #undef ROT
}
constexpr int ATTN_LDS_BYTES=LDS_BYTES;
struct AttnTensors { const bf16* Q; const bf16* K; const bf16* V; const bf16* GATE; const float* G2; bf16* O; };
struct AttnUnit { int bh; int qb; };
struct StaticOrder {
  int vcu;
  __device__ __forceinline__ explicit StaticOrder(int v):vcu(v){}
  __device__ __forceinline__ bool next(int i,AttnUnit&u)const{ if(i>=2)return false; const int s=vcu&3; u.bh=vcu>>2; u.qb=(i==0)?s:7-s; return true; }
};
template<class Sched,int THRL=8> __device__ __forceinline__ void attn_phase(char*lds,const AttnTensors&T,const Sched&S){
  AttnUnit u;
  for(int i=0;S.next(i,u);++i){ attn_unit<THRL>(u.bh/NHEAD,u.bh%NHEAD,u.qb,T.Q,T.K,T.V,T.GATE,T.G2+(long)u.bh*SEQ,T.O,lds); }
}
#undef SBAR
#undef WAIT_BAR
}

__device__ __forceinline__ void p3_attention(Frame& F) {
    const bf16* UB = (const bf16*)(F.ws + WS_UB);
    const attn_body::AttnTensors AT{(const attn_body::bf16*)UB, (const attn_body::bf16*)(UB + 512), (const attn_body::bf16*)(UB + 1024), (const attn_body::bf16*)(UB + 1536), (const float*)(F.ws + WS_G2), (attn_body::bf16*)((bf16*)(F.ws + WS_ACOMB) + ZB_OFF)};
    const attn_body::StaticOrder S(F.vcu);
    attn_body::attn_phase<attn_body::StaticOrder>((char*)F.ldsg, AT, S);
}
template <int Q> __device__ __forceinline__ float bcq(float x) { return __builtin_bit_cast(float, __builtin_amdgcn_mov_dpp(__builtin_bit_cast(int, x), 0x150 + Q, 0xf, 0xf, true)); }

template <int VAR> __device__ __forceinline__ void p4_scan_a(Frame& F) {
    const int lane = F.lane, q16 = lane & 15;
    const int id = F.vcu * NWAVES + F.wave;
    const int b = id >> 8, h = (id >> 5) & 7, c = id & 31;
    const bf16* UA = (const bf16*)(F.ws + WS_UA);
    const float* DEC = F.out; const float* LR = F.out + (size_t)T * 512;
    float* Gm = (float*)(F.ws + WS_UB); float* Hm = Gm + (size_t)2048 * 4096;
    bf16* Rbar = (bf16*)(F.ws + WS_US); bf16* Yloc = (bf16*)(F.ws + WS_YLOC);
    float* BON = (float*)(F.ws + WS_BONUS);
    const float* mu = KIN(3);
    const int ch0 = h * 64 + 4 * q16;
    f32x4 mu_r = *(const f32x4*)(mu + ch0), mu_k = *(const f32x4*)(mu + 512 + ch0), kkc = *(const f32x4*)(KIN(8) + ch0), kac = *(const f32x4*)(KIN(9) + ch0), rkc = *(const f32x4*)(KIN(10) + ch0);
    const float mu_v = mu[1024 + h * 64 + lane];
    const long m0 = (long)b * SEQ + c * 64;
    float sL[64], sG[64];
#pragma unroll
    for (int j = 0; j < 64; ++j) { sL[j] = 0.f; sG[j] = (j == lane) ? 1.f : 0.f; }
    f32x4 pr = {0.f, 0.f, 0.f, 0.f}, pk = {0.f, 0.f, 0.f, 0.f}; float pv = 0.f;
    if (c > 0) { const bf16* up = UA + (m0 - 1) * U_LD; const v2u a = *(const v2u*)(up + ch0), k = *(const v2u*)(up + 512 + ch0);
        pr = (f32x4){bflo(a.x), bfhi(a.x), bflo(a.y), bfhi(a.y)}; pk = (f32x4){bflo(k.x), bfhi(k.x), bflo(k.y), bfhi(k.y)}; pv = bf2f(up[1024 + h * 64 + lane]); }
    v2u n_ua, n_uk; unsigned short n_cv; f32x4 n_lr, n_wv;
    { const bf16* up = UA + m0 * U_LD; n_ua = *(const v2u*)(up + ch0); n_uk = *(const v2u*)(up + 512 + ch0); n_cv = up[1024 + h * 64 + lane];
      n_lr = *(const f32x4*)(LR + m0 * 512 + ch0); n_wv = *(const f32x4*)(DEC + m0 * 512 + ch0); }
    for (int t = 0; t < 64; ++t) {
        const long m = m0 + t;
        const v2u ua = n_ua, uk = n_uk; const float cv = bf2f(n_cv); const f32x4 lr = n_lr, wv = n_wv;
        { const long mn = m0 + (t < 63 ? t + 1 : 63); const bf16* up = UA + mn * U_LD; n_ua = *(const v2u*)(up + ch0); n_uk = *(const v2u*)(up + 512 + ch0); n_cv = up[1024 + h * 64 + lane];
          n_lr = *(const f32x4*)(LR + mn * 512 + ch0); n_wv = *(const f32x4*)(DEC + mn * 512 + ch0); }
        const f32x4 cr = (f32x4){bflo(ua.x), bfhi(ua.x), bflo(ua.y), bfhi(ua.y)}, ck = (f32x4){bflo(uk.x), bfhi(uk.x), bflo(uk.y), bfhi(uk.y)};
        f32x4 rv, kx, av, bv, km;
        float ss = 0.f, bon = 0.f;
#pragma unroll
        for (int e = 0; e < 4; ++e) { rv[e] = cr[e] + (pr[e] - cr[e]) * mu_r[e]; kx[e] = ck[e] + (pk[e] - ck[e]) * mu_k[e]; const float kk = kx[e] * kkc[e]; av[e] = kk; ss += kk * kk; }
        ss = row16_sum(ss);
        const float inv = 1.0f / fmaxf(sqrtf(ss), 1e-12f);
#pragma unroll
        for (int e = 0; e < 4; ++e) { av[e] = -av[e] * inv; bv[e] = -av[e] * lr[e]; km[e] = kx[e] * (1.0f + (lr[e] - 1.0f) * kac[e]); bon += rv[e] * km[e] * rkc[e]; }
        bon = row16_sum(bon);
        const float vi = cv + (pv - cv) * mu_v;
        pr = cr; pk = ck; pv = cv;
        if (lane == 0) BON[m * 8 + h] = bon;
        asm volatile("s_nop 1" : "+v"(av[0]), "+v"(av[1]), "+v"(av[2]), "+v"(av[3]), "+v"(bv[0]), "+v"(bv[1]), "+v"(bv[2]), "+v"(bv[3]));
        asm volatile("s_nop 1" : "+v"(km[0]), "+v"(km[1]), "+v"(km[2]), "+v"(km[3]), "+v"(rv[0]), "+v"(rv[1]), "+v"(rv[2]), "+v"(rv[3]));
        f32x4 wq = wv; asm volatile("s_nop 1" : "+v"(wq[0]), "+v"(wq[1]), "+v"(wq[2]), "+v"(wq[3]));
        float saL0 = 0.f, saL1 = 0.f, saG0 = 0.f, saG1 = 0.f;
#define DFMAC(ACC, BC, X, Q) do { if (VAR == 1) asm("v_fmac_f32_e32 %0, %1, %2" : "+v"(ACC) : "v"(BC), "v"(X)); else asm("v_fmac_f32_dpp %0, %1, %2 row_newbcast:" #Q " row_mask:0xf bank_mask:0xf" : "+v"(ACC) : "v"(BC), "v"(X)); } while (0)
#define DMUL(X, BC, Q) do { if (VAR == 1) asm("v_mul_f32_e32 %0, %1, %0" : "+v"(X) : "v"(BC)); else asm("v_mul_f32_dpp %0, %1, %0 row_newbcast:" #Q " row_mask:0xf bank_mask:0xf" : "+v"(X) : "v"(BC)); } while (0)
#define SA_BLK(Q) { DFMAC(saL0, av[0], sL[4 * Q], Q); DFMAC(saG0, av[0], sG[4 * Q], Q); DFMAC(saL1, av[1], sL[4 * Q + 1], Q); DFMAC(saG1, av[1], sG[4 * Q + 1], Q); \
            DFMAC(saL0, av[2], sL[4 * Q + 2], Q); DFMAC(saG0, av[2], sG[4 * Q + 2], Q); DFMAC(saL1, av[3], sL[4 * Q + 3], Q); DFMAC(saG1, av[3], sG[4 * Q + 3], Q); }
        SA_BLK(0) SA_BLK(1) SA_BLK(2) SA_BLK(3) SA_BLK(4) SA_BLK(5) SA_BLK(6) SA_BLK(7) SA_BLK(8) SA_BLK(9) SA_BLK(10) SA_BLK(11) SA_BLK(12) SA_BLK(13) SA_BLK(14) SA_BLK(15)
#undef SA_BLK
        float saL = saL0 + saL1, saG = saG0 + saG1;
        float yL0 = 0.f, yL1 = 0.f, yG0 = 0.f, yG1 = 0.f;
#define UP_ONE(Q, E, YL, YG) { DMUL(sL[4 * Q + E], wq[E], Q); DMUL(sG[4 * Q + E], wq[E], Q); DFMAC(sL[4 * Q + E], bv[E], saL, Q); DFMAC(sG[4 * Q + E], bv[E], saG, Q); \
            DFMAC(sL[4 * Q + E], km[E], vi, Q); DFMAC(YG, rv[E], sG[4 * Q + E], Q); DFMAC(YL, rv[E], sL[4 * Q + E], Q); }
#define UP_BLK(Q) UP_ONE(Q, 0, yL0, yG0) UP_ONE(Q, 1, yL1, yG1) UP_ONE(Q, 2, yL0, yG0) UP_ONE(Q, 3, yL1, yG1)
        UP_BLK(0) UP_BLK(1) UP_BLK(2) UP_BLK(3) UP_BLK(4) UP_BLK(5) UP_BLK(6) UP_BLK(7) UP_BLK(8) UP_BLK(9) UP_BLK(10) UP_BLK(11) UP_BLK(12) UP_BLK(13) UP_BLK(14) UP_BLK(15)
#undef UP_BLK
#undef UP_ONE
#undef DFMAC
#undef DMUL
        Yloc[m * 512 + h * 64 + lane] = (bf16)f2bf(yL0 + yL1);
        Rbar[m * 512 + h * 64 + lane] = (bf16)f2bf(yG0 + yG1);
    }
    float* hp = Hm + (size_t)id * 4096 + lane * 64; float* gp = Gm + (size_t)id * 4096 + lane * 64;
#pragma unroll
    for (int j = 0; j < 64; j += 4) { *(f32x4*)(hp + j) = (f32x4){sL[j], sL[j + 1], sL[j + 2], sL[j + 3]}; *(f32x4*)(gp + j) = (f32x4){sG[j], sG[j + 1], sG[j + 2], sG[j + 3]}; }
}

template <int PRB> __device__ __forceinline__ void p5_scan_b(Frame& F) {
    const int bh = F.vcu >> 2, i0 = (F.vcu & 3) * 16, lane = F.lane, fr = lane & 15, fq = lane >> 4, n = F.wave;
    const float* Gm = (const float*)(F.ws + WS_UB); const float* Hm = Gm + (size_t)2048 * 4096;
    float* Sst = PRB ? (float*)(F.ws + WS_UA) : F.out;
    LAS float* Ssb = (LAS float*)(F.lds + RING_OFF);
    const int id0 = ((bh >> 3) << 8) | ((bh & 7) << 5);
    if (n < 4) {
        f32x4 st = (f32x4){0.f, 0.f, 0.f, 0.f};
        float gb[16]; f32x4 hv;
        { const float* gp = Gm + (size_t)id0 * 4096 + 16 * n + fr; const float* hp = Hm + (size_t)id0 * 4096 + (size_t)(i0 + 4 * fq) * 64 + 16 * n + fr;
#pragma unroll
          for (int ks = 0; ks < 16; ++ks) gb[ks] = gp[(4 * ks + fq) * 64];
#pragma unroll
          for (int r = 0; r < 4; ++r) hv[r] = hp[r * 64]; }
        for (int c = 0; c < 32; ++c) {
            const size_t base = (size_t)(id0 + c) * 4096;
            { float* sp = Sst + base + (size_t)(i0 + 4 * fq) * 64 + 16 * n + fr;
#pragma unroll
              for (int r = 0; r < 4; ++r) sp[r * 64] = st[r]; }
            if (c == 31) break;
            LAS float* Ss = Ssb + (c & 1) * (16 * 65);
#pragma unroll
            for (int r = 0; r < 4; ++r) Ss[(4 * fq + r) * 65 + 16 * n + fr] = st[r];
            float ga[16]; f32x4 acc = hv;
#pragma unroll
            for (int ks = 0; ks < 16; ++ks) ga[ks] = gb[ks];
            if (c < 30) { const float* gp = Gm + base + 4096 + 16 * n + fr; const float* hp = Hm + base + 4096 + (size_t)(i0 + 4 * fq) * 64 + 16 * n + fr;
#pragma unroll
                for (int ks = 0; ks < 16; ++ks) gb[ks] = gp[(4 * ks + fq) * 64];
#pragma unroll
                for (int r = 0; r < 4; ++r) hv[r] = hp[r * 64]; }
            asm volatile("s_waitcnt lgkmcnt(0)" ::: "memory"); __builtin_amdgcn_s_barrier(); asm volatile("" ::: "memory");
            float av[16];
#pragma unroll
            for (int ks = 0; ks < 16; ++ks) av[ks] = Ss[fr * 65 + 4 * ks + fq];
#pragma unroll
            for (int ks = 0; ks < 16; ++ks) acc = __builtin_amdgcn_mfma_f32_16x16x4f32(av[ks], ga[ks], acc, 0, 0, 0);
            st = acc;
        }
    } else {
        for (int c = 0; c < 31; ++c) { __builtin_amdgcn_s_barrier(); }
    }
    __syncthreads();
}

__device__ __forceinline__ f32x4 bf4(v2u w) { return (f32x4){bflo(w.x), bfhi(w.x), bflo(w.y), bfhi(w.y)}; }
__device__ __forceinline__ float xrow4_sum(float v) {
    v += __shfl_xor(v, 16); v += __shfl_xor(v, 32); return v;
}
__device__ __forceinline__ void p6_scan_c(Frame& F) {
    const int lane = F.lane, fr = lane & 15, fq = lane >> 4;
    const int id = F.vcu * NWAVES + F.wave;
    const int b = id >> 8, h = (id >> 5) & 7, c = id & 31;
    const bf16* UA = (const bf16*)(F.ws + WS_UA);
    const bf16* Rbar = (const bf16*)(F.ws + WS_US); const bf16* Yloc = (const bf16*)(F.ws + WS_YLOC);
    const float* BON = (const float*)(F.ws + WS_BONUS);
    const float* Sst = F.out + (size_t)id * 4096;
    bf16* Acomb = (bf16*)(F.ws + WS_ACOMB);
    const float* mu = KIN(3);
    const long m0 = (long)b * SEQ + c * 64;
    bf16x8 sfr[4][2];
#pragma unroll
    for (int it = 0; it < 4; ++it)
#pragma unroll
        for (int ks = 0; ks < 2; ++ks) { const float* p = Sst + (16 * it + fr) * 64 + 32 * ks + 8 * fq; const f32x4 x0 = *(const f32x4*)p, x1 = *(const f32x4*)(p + 4);
            v4u w; w.x = pk2(x0[0], x0[1]); w.y = pk2(x0[2], x0[3]); w.z = pk2(x1[0], x1[1]); w.w = pk2(x1[2], x1[3]); sfr[it][ks] = __builtin_bit_cast(bf16x8, w); }
    f32x4 lw[4], lb[4], muv[4], mug[4];
    const float* lnw = KIN(11); const float* lnb = KIN(12);
#pragma unroll
    for (int it = 0; it < 4; ++it) { const int ch = h * 64 + 16 * it + 4 * fq; lw[it] = *(const f32x4*)(lnw + ch); lb[it] = *(const f32x4*)(lnb + ch); muv[it] = *(const f32x4*)(mu + 1024 + ch); mug[it] = *(const f32x4*)(mu + 1664 + ch); }
    struct Ld { bf16x8 rfr[2]; v2u yl[4], cv[4], cg[4], pv[4], pg[4]; float bs; };
    auto load = [&](int tt, Ld& L) {
        const long m = m0 + 16 * tt + fr; const long mp = (m % SEQ) == 0 ? m : m - 1;
#pragma unroll
        for (int ks = 0; ks < 2; ++ks) L.rfr[ks] = *(const bf16x8*)(Rbar + m * 512 + h * 64 + 32 * ks + 8 * fq);
        L.bs = BON[m * 8 + h];
#pragma unroll
        for (int it = 0; it < 4; ++it) { const int ch = h * 64 + 16 * it + 4 * fq;
            L.yl[it] = *(const v2u*)(Yloc + m * 512 + ch);
            L.cv[it] = *(const v2u*)(UA + m * U_LD + 1024 + ch); L.cg[it] = *(const v2u*)(UA + m * U_LD + 1536 + ch);
            L.pv[it] = *(const v2u*)(UA + mp * U_LD + 1024 + ch); L.pg[it] = *(const v2u*)(UA + mp * U_LD + 1536 + ch); }
    };
    auto compute = [&](int tt, const Ld& L) {
        const long m = m0 + 16 * tt + fr; const bool first = (m % SEQ) == 0;
        f32x4 y[4]; float s = 0.f;
#pragma unroll
        for (int it = 0; it < 4; ++it) { f32x4 acc = (f32x4){0.f, 0.f, 0.f, 0.f};
#pragma unroll
            for (int ks = 0; ks < 2; ++ks) acc = __builtin_amdgcn_mfma_f32_16x16x32_bf16(sfr[it][ks], L.rfr[ks], acc, 0, 0, 0);
            y[it] = acc + bf4(L.yl[it]); s += (y[it][0] + y[it][1]) + (y[it][2] + y[it][3]); }
        const float mean = xrow4_sum(s) * (1.f / 64.f); float q = 0.f;
#pragma unroll
        for (int it = 0; it < 4; ++it) { y[it] = y[it] - mean; q += (y[it][0] * y[it][0] + y[it][1] * y[it][1]) + (y[it][2] * y[it][2] + y[it][3] * y[it][3]); }
        const float rstd = 1.0f / sqrtf(xrow4_sum(q) * (1.f / 64.f) + LNX_EPS);
#pragma unroll
        for (int it = 0; it < 4; ++it) { const int ch = h * 64 + 16 * it + 4 * fq;
            const f32x4 cv = bf4(L.cv[it]), cg = bf4(L.cg[it]);
            f32x4 pv = bf4(L.pv[it]), pg = bf4(L.pg[it]);
            if (first) { pv = (f32x4){0.f, 0.f, 0.f, 0.f}; pg = pv; }
            const f32x4 vv = cv + (pv - cv) * muv[it], gg = cg + (pg - cg) * mug[it];
            f32x4 z = y[it] * rstd * lw[it] + lb[it] + L.bs * vv;
            z = (f32x4){z[0] * siluf_(gg[0]), z[1] * siluf_(gg[1]), z[2] * siluf_(gg[2]), z[3] * siluf_(gg[3])};
            *(v2u*)(Acomb + m * ACOMB_LD + ZA_OFF + ch) = (v2u){pk2(z[0], z[1]), pk2(z[2], z[3])}; }
    };
    Ld LA, LB;
    load(0, LA); load(1, LB);
    compute(0, LA); load(2, LA);
    compute(1, LB); load(3, LB);
    compute(2, LA); compute(3, LB);
}
struct SchedP7 {
    int pm, pn; const char* Acomb; const char* WinT; const char* Wab;
    __device__ __forceinline__ bool next(int i, pg8::Unit& u) const {
        if (i >= 4) return false;
        u.pm = pm; u.pn = pn; u.kind = i; u.carry = 0;
        const char* arow = Acomb + (size_t)pm * 256 * ACOMB_LD * 2;
        if (i == 0)      { u.nt = 16; u.a = arow;                 u.b = WinT + (size_t)(4096 + pn * 256) * 1024 * 2; }
        else if (i == 1) { u.nt = 8;  u.a = arow + ZA_OFF * 2;    u.b = Wab + (size_t)(pn * 256) * 1024 * 2; }
        else if (i == 2) { u.nt = 16; u.a = arow;                 u.b = WinT + (size_t)(5120 + pn * 256) * 1024 * 2; }
        else             { u.nt = 8;  u.a = arow + ZB_OFF * 2;    u.b = Wab + (size_t)(pn * 256) * 1024 * 2 + 512 * 2; }
        return true;
    }
};
__device__ __forceinline__ f32x4 bf4lo(v4u w) { return (f32x4){bflo(w.x), bfhi(w.x), bflo(w.y), bfhi(w.y)}; }
__device__ __forceinline__ f32x4 bf4hi(v4u w) { return (f32x4){bflo(w.z), bfhi(w.z), bflo(w.w), bfhi(w.w)}; }
__device__ __forceinline__ v4u pk8(f32x4 v0, f32x4 v1) { v4u w; w.x = pg8::cvt_pk_bf16(v0[0], v0[1]); w.y = pg8::cvt_pk_bf16(v0[2], v0[3]); w.z = pg8::cvt_pk_bf16(v1[0], v1[1]); w.w = pg8::cvt_pk_bf16(v1[2], v1[3]); return w; }
struct EpiP7 {
    v4u* SG; v4u* TMP; bf16* merged;
    __device__ __forceinline__ void operator()(f32x4 (&acc)[2][2][4][2], const pg8::Unit& u, int wr, int wc, int fr, int fq) const {
        const int tid = threadIdx.x;
        GAS v4u* SG = (GAS v4u*)this->SG; GAS v4u* TMP = (GAS v4u*)this->TMP;
        asm volatile("" : "+s"(SG), "+s"(TMP));
        if (u.kind == 0 || u.kind == 2) {
#pragma unroll
            for (int ai = 0; ai < 2; ++ai)
#pragma unroll
                for (int bj = 0; bj < 2; ++bj)
#pragma unroll
                    for (int m = 0; m < 4; ++m) { const f32x4 v0 = acc[ai][bj][m][0], v1 = acc[ai][bj][m][1];
                        (SG + ((((ai * 2 + bj) * 4 + m)) << 9))[tid] = pk8((f32x4){sigmoidf_(v0[0]), sigmoidf_(v0[1]), sigmoidf_(v0[2]), sigmoidf_(v0[3])}, (f32x4){sigmoidf_(v1[0]), sigmoidf_(v1[1]), sigmoidf_(v1[2]), sigmoidf_(v1[3])});
                        asm volatile("" ::: "memory"); }
        } else if (u.kind == 1) {
#pragma unroll
            for (int ai = 0; ai < 2; ++ai)
#pragma unroll
                for (int bj = 0; bj < 2; ++bj)
#pragma unroll
                    for (int m = 0; m < 4; ++m) { const int ix = (((ai * 2 + bj) * 4 + m)) << 9; const v4u g = (SG + ix)[tid];
                        (TMP + ix)[tid] = pk8(acc[ai][bj][m][0] * bf4lo(g), acc[ai][bj][m][1] * bf4hi(g)); if (m & 1) asm volatile("" ::: "memory"); }
        } else {
            const int row0 = u.pm * 256 + wr * 64 + fr; bf16* base = merged + u.pn * 256 + wc * 32 + 8 * fq;
#pragma unroll
            for (int ai = 0; ai < 2; ++ai)
#pragma unroll
                for (int m = 0; m < 4; ++m) { bf16* rowp = base + (size_t)(row0 + ai * 128 + m * 16) * 1024;
#pragma unroll
                    for (int bj = 0; bj < 2; ++bj) { const int ix = (((ai * 2 + bj) * 4 + m)) << 9; const v4u g = (SG + ix)[tid], tm = (TMP + ix)[tid];
                        *(pg8::u32x4*)(rowp + bj * 128) = pk8(bf4lo(tm) + acc[ai][bj][m][0] * bf4lo(g), bf4hi(tm) + acc[ai][bj][m][1] * bf4hi(g)); asm volatile("" ::: "memory"); } }
        }
    }
};
struct SchedP8 {
    int pm, pn; const char* A; const char* B;
    __device__ __forceinline__ bool next(int i, pg8::Unit& u) const {
        if (i >= 1) return false;
        u.pm = pm; u.pn = pn; u.kind = 0; u.nt = 16; u.carry = 0; u.a = A + (size_t)pm * 256 * 1024 * 2; u.b = B + (size_t)pn * 256 * 1024 * 2; return true;
    }
};
struct EpiP8 {
    const float* x; float* out;
    __device__ __forceinline__ void operator()(f32x4 (&acc)[2][2][4][2], const pg8::Unit& u, int wr, int wc, int fr, int fq) const {
        const int row0 = u.pm * 256 + wr * 64 + fr; const int col0 = u.pn * 256 + wc * 32 + 8 * fq;
#pragma unroll
        for (int ai = 0; ai < 2; ++ai)
#pragma unroll
            for (int m = 0; m < 4; ++m) { const size_t off = (size_t)(row0 + ai * 128 + m * 16) * DM + col0;
#pragma unroll
                for (int bj = 0; bj < 2; ++bj) { const f32x4 x0 = *(const f32x4*)(x + off + bj * 128), x1 = *(const f32x4*)(x + off + bj * 128 + 4);
                    *(f32x4*)(out + off + bj * 128) = x0 + acc[ai][bj][m][0]; *(f32x4*)(out + off + bj * 128 + 4) = x1 + acc[ai][bj][m][1]; } }
    }
};
__device__ __forceinline__ void p9_final_norm(Frame& F) {
    const int gw = F.vcu * NWAVES + F.wave, NGW = F.G * NWAVES;
    const GAS f32x4* gp = (const GAS f32x4*)KIN(19) + F.lane;
    f32x4 g[4];
#pragma unroll
    for (int j = 0; j < 4; ++j) g[j] = gp[64 * j];
    for (int m = gw; m < T; m += NGW) {
        GAS f32x4* xr = (GAS f32x4*)(F.out + (size_t)m * DM) + F.lane;
        f32x4 v[4]; float s = 0.f;
#pragma unroll
        for (int j = 0; j < 4; ++j) { v[j] = xr[64 * j]; s += (v[j].x * v[j].x + v[j].y * v[j].y) + (v[j].z * v[j].z + v[j].w * v[j].w); }
        const float rstd = 1.f / sqrtf(wave_sum(s) * (1.f / DM) + RMS_EPS);
#pragma unroll
        for (int j = 0; j < 4; ++j) xr[64 * j] = v[j] * rstd * g[j];
    }
}

constexpr int N_PHASES = 10;
struct Args { const float* in[20]; float* out; unsigned char* ws; int ph_lo, ph_hi, variant, pad; };
__global__ void __launch_bounds__(NWAVES * 64, 2) hybrid_fwd(Args args) {
    extern __shared__ __attribute__((aligned(16))) unsigned char lds[];
    Frame F;
    F.lds = (LAS unsigned char*)lds; F.ldsg = lds;
    F.MISC = (volatile LAS unsigned*)(F.lds + MISC_OFF);
    F.tid = threadIdx.x; F.lane = F.tid & 63; F.wave = __builtin_amdgcn_readfirstlane(F.tid >> 6);
    F.G = gridDim.x; { const int bx = blockIdx.x; F.vcu = (bx % 8) * (F.G / 8) + bx / 8; }
    F.out = args.out; F.ws = args.ws;
    unsigned char* ws = args.ws;
    for (int u = F.tid; u < (LDS_BYTES - LDSCTL_OFF) / 4; u += NWAVES * 64) ((LAS unsigned*)(F.lds + LDSCTL_OFF))[u] = 0u;
    __syncthreads();
    const int lo = args.ph_lo, hi = args.ph_hi;
    const bool multi = (hi - lo) > 1;
    XcdBarrier bar; bar.bar = (unsigned*)(ws + WS_CTL) + CW_BAR; bar.x = 0; bar.st = nullptr;
    if (multi) bar = xcd_barrier_post((unsigned*)(ws + WS_CTL) + CW_BAR, F.MISC + 8);
#ifndef PH_MASK
#define PH_MASK 0x3ff
#endif
#define IN(k) (((PH_MASK >> (k)) & 1) && lo <= (k) && (k) < hi)
#define SEAM(k) do { if (IN(k) && IN((k) + 1)) xcd_barrier(bar); } while (0)
#define PF(Fp) Frame Fp = F; { int t_ = threadIdx.x; asm volatile("" : "+v"(t_)); Fp.tid = t_; Fp.lane = t_ & 63; Fp.wave = __builtin_amdgcn_readfirstlane(t_ >> 6); }
#ifndef RPT_MASK
#define RPT_MASK 0
#endif
#define NREP(k) (((RPT_MASK >> (k)) & 1) ? 2 : 1)
#ifndef PROBE_VARIANTS
#define PROBE_VARIANTS 0
#endif
    if (IN(0)) { PF(Fp); p0_prologue(Fp); SEAM(0); }
    if (IN(1)) {
        SchedP1 S{(int)blockIdx.x, F.G, (const char*)(ws + WS_ACOMB), (const char*)(ws + WS_WINT)};
        EpiP1 E{(bf16*)(ws + WS_UA), (bf16*)(ws + WS_UB), (float*)(ws + WS_US)};
        pg8::gemm_phase(F.lds + RING_OFF, ACOMB_LD, 1024, S, E);
        SEAM(1);
    }
    if (IN(2)) { PF(Fp); p2_prep<0>(Fp); SEAM(2); }
    if (IN(3)) { PF(Fp); p3_attention(Fp); SEAM(3); }
    if (IN(4)) { PF(Fp); p4_scan_a<0>(Fp); SEAM(4); }
    if (IN(5)) { PF(Fp); p5_scan_b<0>(Fp); SEAM(5); }
    if (IN(6)) { PF(Fp); p6_scan_c(Fp); SEAM(6); }
    const int pm = F.vcu >> 2, pn = F.vcu & 3;
    if (IN(7)) {
        SchedP7 S{pm, pn, (const char*)(ws + WS_ACOMB), (const char*)(ws + WS_WINT), (const char*)(ws + WS_WAB)};
        EpiP7 E{(v4u*)(ws + WS_UA) + (size_t)blockIdx.x * 8192, (v4u*)(ws + WS_UB) + (size_t)blockIdx.x * 8192, (bf16*)(ws + WS_MERGED)};
        pg8::gemm_phase(F.lds + RING_OFF, ACOMB_LD, 1024, S, E);
        SEAM(7);
    }
    if (IN(8)) {
        SchedP8 S{pm, pn, (const char*)(ws + WS_MERGED), (const char*)(ws + WS_WOUT)};
        EpiP8 E{KIN(0), F.out};
        pg8::gemm_phase(F.lds + RING_OFF, 1024, 1024, S, E);
        SEAM(8);
    }
    if (IN(9)) { PF(Fp); p9_final_norm(Fp); }
#undef IN
#undef SEAM
}


#if PROBE_VARIANTS
__global__ void __launch_bounds__(NWAVES * 64, 2) probe_fwd(Args args) {
    extern __shared__ __attribute__((aligned(16))) unsigned char lds[];
    Frame F;
    F.lds = (LAS unsigned char*)lds;
    F.MISC = (volatile LAS unsigned*)(F.lds + MISC_OFF);
    F.tid = threadIdx.x; F.lane = F.tid & 63; F.wave = __builtin_amdgcn_readfirstlane(F.tid >> 6);
    F.G = gridDim.x; { const int bx = blockIdx.x; F.vcu = (bx % 8) * (F.G / 8) + bx / 8; }
    F.out = args.out; F.ws = args.ws;
#ifndef PROBE_REP
#define PROBE_REP 1
#endif
    for (int rp = 0; rp < PROBE_REP; ++rp) {
    if (PROBE_VARIANTS == 1) p4_scan_a<1>(F);
    if (PROBE_VARIANTS == 2) p2_prep<1>(F);
    if (PROBE_VARIANTS == 3) p5_scan_b<1>(F);
    if (PROBE_VARIANTS == 4) p6_scan_c(F);
    if (PROBE_VARIANTS == 5) p0_prologue(F);
    __syncthreads(); }
}
#endif
#ifndef MK_N_LAUNCHES
#define MK_N_LAUNCHES 1
#endif
extern "C" void kernel_launch(void* const* d_in, const int* in_sizes, int n_in, void* d_out, int out_size, void* d_ws, size_t ws_size, hipStream_t stream) {
    static int grid = 0;
    if (grid == 0) {
        if (n_in != 20 || in_sizes[0] != T * DM || out_size != T * DM || ws_size < WS_END) { fprintf(stderr, "kernel_launch: unexpected shapes (n_in %d, in0 %d, out %d, ws %zu); nothing launched\n", n_in, n_in > 0 ? in_sizes[0] : -1, out_size, ws_size); grid = -1; return; }
        int dev = 0, cus = 0, per_cu = 0;
        if (hipGetDevice(&dev) != hipSuccess || hipDeviceGetAttribute(&cus, hipDeviceAttributeMultiprocessorCount, dev) != hipSuccess) { grid = -1; return; }
        #if PROBE_VARIANTS
        (void)hipFuncSetAttribute((const void*)probe_fwd, hipFuncAttributeMaxDynamicSharedMemorySize, LDS_BYTES);
#endif
        if (hipFuncSetAttribute((const void*)hybrid_fwd, hipFuncAttributeMaxDynamicSharedMemorySize, LDS_BYTES) != hipSuccess) { fprintf(stderr, "kernel_launch: hipFuncSetAttribute failed\n"); grid = -1; return; }
        if (hipOccupancyMaxActiveBlocksPerMultiprocessor(&per_cu, (const void*)hybrid_fwd, NWAVES * 64, LDS_BYTES) != hipSuccess || per_cu < 1) fprintf(stderr, "kernel_launch: note: occupancy query reports %d workgroups per CU\n", per_cu);
        (void)hipGetLastError();
        grid = 256;
        if (cus != 256) fprintf(stderr, "kernel_launch: device reports %d CUs; this kernel is built for 256\n", cus);
    }
    if (grid < 0) return;
    (void)hipMemsetAsync((char*)d_ws + WS_CTL, 0, CTL_ZERO_BYTES, stream);
    Args a{};
    for (int i = 0; i < 20; ++i) a.in[i] = (const float*)d_in[i];
    a.out = (float*)d_out; a.ws = (unsigned char*)d_ws;
    if (MK_N_LAUNCHES == 1) { a.ph_lo = 0; a.ph_hi = N_PHASES; hipLaunchKernelGGL(hybrid_fwd, dim3(grid), dim3(NWAVES * 64), LDS_BYTES, stream, a); }
#ifdef PROBE_LO
    if (MK_N_LAUNCHES == 1) { (void)hipMemsetAsync((char*)d_ws + WS_CTL, 0, CTL_ZERO_BYTES, stream); a.ph_lo = PROBE_LO; a.ph_hi = PROBE_HI; a.variant = PROBE_VARIANTS;
#if PROBE_VARIANTS
      hipLaunchKernelGGL(probe_fwd, dim3(grid), dim3(NWAVES * 64), LDS_BYTES, stream, a);
#else
      hipLaunchKernelGGL(hybrid_fwd, dim3(grid), dim3(NWAVES * 64), LDS_BYTES, stream, a);
#endif
    }
#endif
    else for (int p = 0; p < N_PHASES; ++p) { a.ph_lo = p; a.ph_hi = p + 1; hipLaunchKernelGGL(hybrid_fwd, dim3(grid), dim3(NWAVES * 64), LDS_BYTES, stream, a); }
}
```

```cpp
#include <hip/hip_runtime.h>
#include <hip/hip_bf16.h>
#include <cstdio>
#include <cstdint>
#include <cmath>

#define GAS __attribute__((address_space(1)))
#define LAS __attribute__((address_space(3)))
typedef unsigned short bf16;
typedef unsigned v4u __attribute__((ext_vector_type(4)));
typedef unsigned v2u __attribute__((ext_vector_type(2)));
typedef float f32x2 __attribute__((ext_vector_type(2)));
typedef float f32x4 __attribute__((ext_vector_type(4)));
typedef float f32x16 __attribute__((ext_vector_type(16)));
typedef short bf16x8 __attribute__((ext_vector_type(8)));
typedef short s16x4 __attribute__((ext_vector_type(4)));

constexpr int NB = 8, SEQ = 2048, DM = 1024, T = NB * SEQ, NH = 8, HD = 64;
constexpr int IN_COLS = 6280, NPAD = 6400;
constexpr float RMS_EPS = 1e-6f, LNX_EPS = 64e-5f;
constexpr float LOG2E = 1.4426950408889634f;
constexpr float C2 = 0.125f * LOG2E;

constexpr size_t MiB = 1u << 20;
constexpr size_t WS_CTL = 0, CTL_ZERO_BYTES = 64 * 1024;
constexpr size_t WS_WINT = 1 * MiB;
constexpr size_t WS_WAB = 14 * MiB;
constexpr size_t WS_WOUT = 16 * MiB;
constexpr size_t WS_G2 = 19 * MiB;
constexpr size_t WS_BONUS = 19 * MiB + 512 * 1024;
constexpr size_t WS_ACOMB = 20 * MiB;
constexpr size_t WS_UA = 84 * MiB;
constexpr size_t WS_UB = 148 * MiB;
constexpr size_t WS_US = 212 * MiB;
constexpr size_t WS_YLOC = 228 * MiB;
constexpr size_t WS_MERGED = 212 * MiB;
constexpr size_t WS_END = 256 * MiB;
constexpr int ACOMB_LD = 2048, U_LD = 2048;
constexpr int ZA_OFF = 1024, ZB_OFF = 1536;

#define RLX_AGENT __ATOMIC_RELAXED, __HIP_MEMORY_SCOPE_AGENT
#define LDS_WAIT() asm volatile("s_waitcnt lgkmcnt(0)" ::: "memory")
#define VM_WAIT() asm volatile("s_waitcnt vmcnt(0)" ::: "memory")

__device__ __forceinline__ unsigned f2bf(float f) { unsigned u = __builtin_bit_cast(unsigned, f); return (u + 0x7fffu + ((u >> 16) & 1u)) >> 16; }
__device__ __forceinline__ unsigned pk2(float lo, float hi) { return f2bf(lo) | (f2bf(hi) << 16); }
__device__ __forceinline__ float bf2f(unsigned b) { return __builtin_bit_cast(float, b << 16); }
__device__ __forceinline__ float bflo(unsigned w) { return __builtin_bit_cast(float, w << 16); }
__device__ __forceinline__ float bfhi(unsigned w) { return __builtin_bit_cast(float, w & 0xffff0000u); }
__device__ __forceinline__ float frcp(float x) { return __builtin_amdgcn_rcpf(x); }
__device__ __forceinline__ float fexp(float x) { return __builtin_amdgcn_exp2f(x * LOG2E); }
__device__ __forceinline__ float sigmoidf_(float x) { return frcp(1.0f + fexp(-x)); }
__device__ __forceinline__ float siluf_(float x) { return x * frcp(1.0f + fexp(-x)); }
__device__ __forceinline__ float wave_sum(float v) {
#pragma unroll
    for (int o = 1; o < 64; o <<= 1) v += __shfl_xor(v, o);
    return v;
}
template <int CTRL> __device__ __forceinline__ float dppf(float x) { return __builtin_bit_cast(float, __builtin_amdgcn_mov_dpp(__builtin_bit_cast(int, x), CTRL, 0xf, 0xf, true)); }
__device__ __forceinline__ float row16_sum(float v) { v += dppf<0x128>(v); v += dppf<0x124>(v); v += dppf<0x122>(v); v += dppf<0x121>(v); return v; }
namespace pg8 {
#define PG8_LAS __attribute__((address_space(3)))
typedef unsigned short bf16_t;
typedef unsigned u32x4 __attribute__((ext_vector_type(4)));
constexpr int BM = 256, BK = 64, HALF = 128, HTB = HALF * BK * 2  , STAGE_BYTES = 8 * HTB;

__host__ __device__ __forceinline__ int lds_byte(int r, int c) { const int st = (r >> 4) * 2 + (c >> 5), rr = r & 15, cc = c & 31, ob = rr * 64 + cc * 2; return st * 1024 + (ob ^ (((ob >> 9) & 1) << 5)); }
__host__ __device__ __forceinline__ void stage_rc(int b, int& R, int& C) { const int st = b / 1024, sb = b % 1024, swz = sb ^ (((sb >> 9) & 1) << 5); R = (st >> 1) * 16 + swz / 64; C = (st & 1) * 32 + (swz % 64) / 2; }
__host__ __device__ __forceinline__ int perm32(int rho) { const int n = rho >> 4, i = rho & 15; return 8 * (i >> 2) + 4 * n + (i & 3); }

struct Unit { int pm, pn, kind, nt, carry; const char* a; const char* b; };

__device__ __forceinline__ unsigned cvt_pk_bf16(float lo, float hi) { typedef __bf16 bf16x2_t __attribute__((ext_vector_type(2))); typedef float f32x2_t __attribute__((ext_vector_type(2))); f32x2_t v = {lo, hi}; bf16x2_t b = __builtin_convertvector(v, bf16x2_t); return __builtin_bit_cast(unsigned, b); }

template <class Epi, class Sched>
__device__ __forceinline__ void gemm_phase(PG8_LAS unsigned char* lds, const int lda, const int ldb, const Sched& S, const Epi& E) {
    int tid = threadIdx.x; asm volatile("" : "+v"(tid));
    const int wid = __builtin_amdgcn_readfirstlane(tid >> 6), lane = tid & 63, wr = wid >> 2, wc = wid & 3, fr = lane & 15, fq = lane >> 4;
    unsigned voffA[2], voffB[2];
#pragma unroll
    for (int i = 0; i < 2; ++i) { int R, C; stage_rc(tid * 16 + i * 8192, R, C); const int Rb = (R & ~31) + perm32(R & 31);
        voffA[i] = (unsigned)(R * lda + C) * 2u; voffB[i] = (unsigned)(Rb * ldb + C) * 2u; }
    const size_t kstep = (size_t)(BK * 2);
    const size_t hstepA = (size_t)HALF * lda * 2, hstepB = (size_t)HALF * ldb * 2;
    const unsigned ldsw = (unsigned)wid * 1024u;
    const int aoff = lds_byte(wr * 64 + fr, fq * 8), boff = lds_byte(wc * 32 + fr, fq * 8);
#define PG8_SA(b, h) (((b) * 2 + (h)) * HTB)
#define PG8_SB(b, h) ((4 + (b) * 2 + (h)) * HTB)
#define PG8_STAGE(bufoff, gbase, voff) do { _Pragma("unroll") for (int _i = 0; _i < 2; ++_i) \
        __builtin_amdgcn_global_load_lds((const unsigned*)((const char*)(gbase) + (voff)[_i]), (PG8_LAS unsigned*)(lds + (bufoff) + ldsw + _i * 8192), 16, 0, 0); } while (0)
#define PG8_LDA(dst, b, h) do { _Pragma("unroll") for (int m = 0; m < 4; ++m) _Pragma("unroll") for (int k = 0; k < 2; ++k) dst[m][k] = *(const PG8_LAS bf16x8*)(lds + PG8_SA(b, h) + aoff + m * 2048 + k * 1024); } while (0)
#define PG8_LDB(dst, b, h) do { _Pragma("unroll") for (int n = 0; n < 2; ++n) _Pragma("unroll") for (int k = 0; k < 2; ++k) dst[n][k] = *(const PG8_LAS bf16x8*)(lds + PG8_SB(b, h) + boff + n * 2048 + k * 1024); } while (0)
#define PG8_MMA(ai, bj, At, Bt) do { __builtin_amdgcn_s_setprio(1); _Pragma("unroll") for (int m = 0; m < 4; ++m) _Pragma("unroll") for (int n = 0; n < 2; ++n) _Pragma("unroll") for (int k = 0; k < 2; ++k) \
        acc[ai][bj][m][n] = __builtin_amdgcn_mfma_f32_16x16x32_bf16(Bt[n][k], At[m][k], acc[ai][bj][m][n], 0, 0, 0); __builtin_amdgcn_s_setprio(0); } while (0)
#define PG8_WAIT_V(n) asm volatile("s_waitcnt vmcnt(" #n ")" ::: "memory")
#define PG8_WAIT_L(n) asm volatile("s_waitcnt lgkmcnt(" #n ")" ::: "memory")
#define PG8_BAR __builtin_amdgcn_s_barrier()
#define PG8_SCHED __builtin_amdgcn_sched_barrier(0)
    Unit cur, nxt; int ui = 0;
    if (!S.next(0, cur)) return;
    f32x4 acc[2][2][4][2];
#pragma unroll
    for (int a = 0; a < 2; ++a)
#pragma unroll
        for (int b = 0; b < 2; ++b)
#pragma unroll
            for (int m = 0; m < 4; ++m)
#pragma unroll
                for (int n = 0; n < 2; ++n) acc[a][b][m][n] = (f32x4){0.f, 0.f, 0.f, 0.f};
    bf16x8 At[4][2], B0[2][2], B1[2][2];
    const char* cA = cur.a; const char* cB = cur.b;
    PG8_STAGE(PG8_SB(0, 0), cB, voffB); PG8_STAGE(PG8_SB(0, 1), cB + hstepB, voffB); PG8_STAGE(PG8_SA(0, 0), cA, voffA); PG8_STAGE(PG8_SA(0, 1), cA + hstepA, voffA);
    if (wr == 1) PG8_BAR;
    PG8_WAIT_V(2); PG8_BAR;
    PG8_STAGE(PG8_SB(1, 0), cB + kstep, voffB); PG8_STAGE(PG8_SA(1, 0), cA + kstep, voffA); PG8_STAGE(PG8_SB(1, 1), cB + hstepB + kstep, voffB);
    PG8_WAIT_V(6); PG8_BAR;
    for (;;) {
        const bool has_next = S.next(ui + 1, nxt);
        const char* nA = has_next ? nxt.a : cA; const char* nB = has_next ? nxt.b : cB;
        const int nt = cur.nt;
        for (int t = 0; t < nt; t += 2) {
            const bool last = (t == nt - 2);
            const char* a1 = cA + (size_t)(t + 1) * kstep;
            const char* a2 = last ? nA : cA + (size_t)(t + 2) * kstep; const char* b2 = last ? nB : cB + (size_t)(t + 2) * kstep;
            const char* a3 = a2 + kstep; const char* b3 = b2 + kstep;
            PG8_LDB(B0, 0, 0); PG8_LDB(B1, 0, 1); PG8_SCHED; PG8_LDA(At, 0, 0); PG8_STAGE(PG8_SA(1, 1), a1 + hstepA, voffA);
            PG8_WAIT_V(8); PG8_WAIT_L(0); PG8_BAR; PG8_MMA(0, 0, At, B0); PG8_MMA(0, 1, At, B1); PG8_BAR; PG8_SCHED;
            PG8_LDA(At, 0, 1); PG8_STAGE(PG8_SB(0, 0), b2, voffB); PG8_STAGE(PG8_SB(0, 1), b2 + hstepB, voffB); PG8_STAGE(PG8_SA(0, 0), a2, voffA);
            PG8_WAIT_V(8); PG8_WAIT_L(0); PG8_BAR; PG8_MMA(1, 0, At, B0); PG8_MMA(1, 1, At, B1); PG8_BAR; PG8_SCHED;
            PG8_LDB(B0, 1, 0); PG8_LDB(B1, 1, 1); PG8_SCHED; PG8_LDA(At, 1, 0); PG8_STAGE(PG8_SA(0, 1), a2 + hstepA, voffA);
            PG8_WAIT_V(8); PG8_WAIT_L(0); PG8_BAR; PG8_MMA(0, 0, At, B0); PG8_MMA(0, 1, At, B1); PG8_BAR; PG8_SCHED;
            PG8_LDA(At, 1, 1); PG8_STAGE(PG8_SB(1, 0), b3, voffB); PG8_STAGE(PG8_SB(1, 1), b3 + hstepB, voffB); PG8_STAGE(PG8_SA(1, 0), a3, voffA);
            PG8_WAIT_V(8); PG8_WAIT_L(0); PG8_BAR; PG8_MMA(1, 0, At, B0); PG8_MMA(1, 1, At, B1); PG8_BAR; PG8_SCHED;
        }
        if (wr == 0) PG8_BAR;
        E(acc, cur, wr, wc, fr, fq);
        if (!has_next) break;
        if (!cur.carry)
#pragma unroll
        for (int a = 0; a < 2; ++a)
#pragma unroll
            for (int b = 0; b < 2; ++b)
#pragma unroll
                for (int m = 0; m < 4; ++m)
#pragma unroll
                    for (int n = 0; n < 2; ++n) acc[a][b][m][n] = (f32x4){0.f, 0.f, 0.f, 0.f};
        cur = nxt; cA = nA; cB = nB; ++ui;
        if (wr == 1) PG8_BAR;
    }
    PG8_WAIT_V(0);
    PG8_BAR;
#undef PG8_SA
#undef PG8_SB
#undef PG8_STAGE
#undef PG8_LDA
#undef PG8_LDB
#undef PG8_MMA
#undef PG8_WAIT_V
#undef PG8_WAIT_L
#undef PG8_BAR
#undef PG8_SCHED
}
}
typedef GAS unsigned gu32;
#define XB_TMO      128
#define XB_XCNT(j)  (256  + 64 * (j))
#define XB_XSUB(j)  (1280 + 64 * (j))
#define XB_XGEN(j)  (2304 + 64 * (j))
#define XB_TOP      3328
#define XB_TOPGEN   3392
#define XCD_BAR_WORDS 3456
#define XB_SPIN_CAP (1u << 18)
__device__ __forceinline__ unsigned xb_ld(unsigned* p)              { return __hip_atomic_load(p, __ATOMIC_RELAXED, __HIP_MEMORY_SCOPE_AGENT); }
__device__ __forceinline__ unsigned xb_add(unsigned* p, unsigned v) { return __hip_atomic_fetch_add(p, v, __ATOMIC_RELAXED, __HIP_MEMORY_SCOPE_AGENT); }
__device__ __forceinline__ unsigned xb_xcc_id() { return (unsigned)__builtin_amdgcn_s_getreg((3 << 11) | 20) & 0xFu; }
#define XB_SPIN(cond, bar) do { unsigned _sp = 0; while (cond) { __builtin_amdgcn_s_sleep(1); \
    if ((++_sp & 255u) == 0u) { if (xb_ld(&(bar)[XB_TMO])) break; if (_sp > XB_SPIN_CAP) { atomicAdd(&(bar)[XB_TMO], 1u); break; } } } } while (0)
struct XcdBarrier { unsigned* bar; unsigned x; volatile LAS unsigned* st; };
__device__ __forceinline__ XcdBarrier xcd_barrier_post(unsigned* bar, volatile LAS unsigned* st) {
    XcdBarrier b; b.bar = bar; b.x = xb_xcc_id(); b.st = st;
    if (threadIdx.x == 0) (void)xb_add(&bar[XB_XCNT(b.x)], 1u);
    return b;
}
__device__ __forceinline__ void xcd_barrier_complete(unsigned* bar, unsigned x, unsigned& nloc, unsigned& nx) {
    const unsigned G = gridDim.x * gridDim.y * gridDim.z;
    unsigned sum, cnt, mine, sp = 0u;
    for (;;) {
        sum = 0u; cnt = 0u; mine = 0u;
#pragma unroll
        for (unsigned j = 0; j < 16; ++j) { const unsigned c = xb_ld(&bar[XB_XCNT(j)]); sum += c; cnt += (c > 0u) ? 1u : 0u; mine = (j == x) ? c : mine; }
        if (sum == G) break;
        __builtin_amdgcn_s_sleep(1);
        if ((++sp & 255u) == 0u) { if (xb_ld(&bar[XB_TMO])) break; if (sp > XB_SPIN_CAP) { atomicAdd(&bar[XB_TMO], 1u); break; } }
    }
    nloc = mine > 0u ? mine : 1u; nx = cnt > 0u ? cnt : 1u;
}
__device__ __forceinline__ void xcd_barrier(const XcdBarrier& b) {
    asm volatile("s_waitcnt vmcnt(0)" ::: "memory");
    __syncthreads();
    if (threadIdx.x == 0) {
        unsigned* bar = b.bar;
        __builtin_amdgcn_s_waitcnt(0);
        unsigned nloc = b.st[0], nx = b.st[1];
        if (nloc == 0u) { xcd_barrier_complete(bar, b.x, nloc, nx); b.st[0] = nloc; b.st[1] = nx; }
        const unsigned old = xb_add(&bar[XB_XSUB(b.x)], 1u);
        const unsigned gen = old / nloc;
        if (old + 1u == (gen + 1u) * nloc) {
            __builtin_amdgcn_fence(__ATOMIC_RELEASE, "agent");
            asm volatile("s_waitcnt vmcnt(0)" ::: "memory");
            const unsigned og = xb_add(&bar[XB_TOP], 1u);
            const unsigned tg = og / nx;
            if (og + 1u == (tg + 1u) * nx) xb_add(&bar[XB_TOPGEN], 1u);
            else XB_SPIN(xb_ld(&bar[XB_TOPGEN]) == tg, bar);
            __builtin_amdgcn_fence(__ATOMIC_ACQUIRE, "agent");
            xb_add(&bar[XB_XGEN(b.x)], 1u);
            asm volatile("s_waitcnt vmcnt(0)" ::: "memory");
        } else {
            XB_SPIN(xb_ld(&bar[XB_XGEN(b.x)]) == gen, bar);
            __builtin_amdgcn_fence(__ATOMIC_ACQUIRE, "agent");
            asm volatile("s_waitcnt vmcnt(0)" ::: "memory");
        }
    }
    __syncthreads();
}

constexpr int RING_OFF = 0, RING_BYTES = 131072;
constexpr int LDSCTL_OFF = RING_BYTES, MISC_OFF = LDSCTL_OFF + 320;
constexpr int LDS_BYTES = 147456;
constexpr int NWAVES = 8;
constexpr int CW_BAR = 4096;

struct Frame {
    LAS unsigned char* lds; unsigned char* ldsg;
    volatile LAS unsigned* MISC;
    int tid, lane, wave, vcu, G;
    float* out; unsigned char* ws;
};
typedef __attribute__((address_space(4))) const unsigned char* kargp_t;
__device__ __forceinline__ const float* karg_in(int i) { kargp_t p = (kargp_t)__builtin_amdgcn_kernarg_segment_ptr(); asm volatile("" : "+s"(p)); return *(const float* const __attribute__((address_space(4)))*)(p + 8 * i); }
#define KIN(k) karg_in(k)
__device__ __forceinline__ void p0_transpose_item(const float* W, int ldw, bf16* WT, int ldt, int koff, LAS float* scr, int k0, int n0, int scol0, int nvalid, int lane) {
    const int li = lane & 31; const bool ok = li < nvalid;
#pragma unroll 8
    for (int i = 0; i < 32; ++i) { const int kk = 2 * i + (lane >> 5); scr[kk * 33 + li] = ok ? W[(size_t)(k0 + kk) * ldw + scol0 + li] : 0.f; }
    LDS_WAIT(); asm volatile("" ::: "memory");
    const int c = lane & 7;
#pragma unroll
    for (int j = 0; j < 4; ++j) { const int n = (lane >> 3) + 8 * j; const LAS float* s = scr + (8 * c) * 33 + n;
        v4u o; o.x = pk2(s[0 * 33], s[1 * 33]); o.y = pk2(s[2 * 33], s[3 * 33]); o.z = pk2(s[4 * 33], s[5 * 33]); o.w = pk2(s[6 * 33], s[7 * 33]);
        *(GAS v4u*)(WT + (size_t)(n0 + n) * ldt + koff + k0 + 8 * c) = o; }
    LDS_WAIT(); asm volatile("" ::: "memory");
}
__device__ __forceinline__ void win_map(int n0, int& scol0, int& nvalid) {
    nvalid = 32;
    if (n0 < 1536) scol0 = n0;
    else if (n0 < 4096) scol0 = n0 + 128;
    else if (n0 < 6144) scol0 = n0 + 136;
    else if (n0 < 6272) scol0 = n0 - 6144 + 1536;
    else if (n0 == 6272) { scol0 = 4224; nvalid = 8; }
    else { scol0 = 0; nvalid = 0; }
}
__device__ __forceinline__ void p0_prologue(Frame& F) {
    LAS float* scr = (LAS float*)(F.lds + RING_OFF + F.wave * 16384);
    const int gw = F.vcu * NWAVES + F.wave, NGW = F.G * NWAVES;
    bf16* WinT = (bf16*)(F.ws + WS_WINT); bf16* Wab = (bf16*)(F.ws + WS_WAB); bf16* WoutT = (bf16*)(F.ws + WS_WOUT);
    const float* w_in = KIN(2); const float* w_oa = KIN(16); const float* w_ob = KIN(17); const float* w_o = KIN(18);
    constexpr int I_IN = 16 * 200, I_AB = 8 * 32, I_OUT = 16 * 32;
    constexpr int NITEMS = I_IN + 2 * I_AB + I_OUT;
    for (int it = gw; it < NITEMS; it += NGW) {
        int r = it;
        if (r < I_IN) { const int kb = r / 200, nb = r % 200; int sc, nv; win_map(32 * nb, sc, nv); p0_transpose_item(w_in, IN_COLS, WinT, 1024, 0, scr, 64 * kb, 32 * nb, sc, nv, F.lane); continue; } r -= I_IN;
        if (r < I_AB) { const int kb = r / 32, nb = r % 32; p0_transpose_item(w_oa, 1024, Wab, 1024, 0, scr, 64 * kb, 32 * nb, 32 * nb, 32, F.lane); continue; } r -= I_AB;
        if (r < I_AB) { const int kb = r / 32, nb = r % 32; p0_transpose_item(w_ob, 1024, Wab, 1024, 512, scr, 64 * kb, 32 * nb, 32 * nb, 32, F.lane); continue; } r -= I_AB;
        { const int kb = r / 32, nb = r % 32; p0_transpose_item(w_o, 1024, WoutT, 1024, 0, scr, 64 * kb, 32 * nb, 32 * nb, 32, F.lane); }
    }
    bf16* Acomb = (bf16*)(F.ws + WS_ACOMB);
    const GAS f32x4* gp = (const GAS f32x4*)KIN(1) + F.lane;
    f32x4 g[4];
#pragma unroll
    for (int j = 0; j < 4; ++j) g[j] = gp[64 * j];
    const float* xin = KIN(0);
    for (int m = gw; m < T; m += NGW) {
        const GAS f32x4* xr = (const GAS f32x4*)(xin + (size_t)m * DM) + F.lane;
        f32x4 v[4]; float s = 0.f;
#pragma unroll
        for (int j = 0; j < 4; ++j) { v[j] = xr[64 * j]; s += (v[j].x * v[j].x + v[j].y * v[j].y) + (v[j].z * v[j].z + v[j].w * v[j].w); }
        const float rstd = 1.f / sqrtf(wave_sum(s) * (1.f / DM) + RMS_EPS);
        GAS unsigned long long* o8 = (GAS unsigned long long*)(Acomb + (size_t)m * ACOMB_LD) + F.lane;
#pragma unroll
        for (int j = 0; j < 4; ++j) o8[64 * j] = (unsigned long long)pk2(v[j].x * rstd * g[j].x, v[j].y * rstd * g[j].y) | ((unsigned long long)pk2(v[j].z * rstd * g[j].z, v[j].w * rstd * g[j].w) << 32);
    }
}

struct SchedP1 {
    int c, G; const char* A; const char* B;
    __device__ __forceinline__ bool next(int i, pg8::Unit& u) const {
        constexpr int nM = 64, nN = 17, nwg = nM * nN, NX = 8, WGM = 8;
        const int L = i * G + c; if (L >= nwg) return false;
        int wgid = L; { const int q = nwg / NX, r = nwg % NX, xcd = wgid % NX, off = wgid / NX; wgid = (xcd < r ? xcd * (q + 1) : r * (q + 1) + (xcd - r) * q) + off; }
        const int nig = WGM * nN, gid = wgid / nig, fm = gid * WGM;
        u.pm = fm + ((wgid % nig) % WGM); int pn = (wgid % nig) / WGM; u.pn = pn == 16 ? 24 : pn; u.kind = 0; u.nt = 16; u.carry = 0;
        u.a = A + (size_t)u.pm * 256 * ACOMB_LD * 2; u.b = B + (size_t)u.pn * 256 * 1024 * 2; return true;
    }
};
struct EpiP1 {
    bf16* UA; bf16* UB; float* US;
    __device__ __forceinline__ void operator()(f32x4 (&acc)[2][2][4][2], const pg8::Unit& u, int wr, int wc, int fr, int fq) const {
        const int row0 = u.pm * 256 + wr * 64 + fr;
        if (u.pn < 16) {
            bf16* base = (u.pn < 8 ? UA + u.pn * 256 : UB + (u.pn - 8) * 256) + wc * 32 + 8 * fq;
#pragma unroll
            for (int ai = 0; ai < 2; ++ai)
#pragma unroll
                for (int m = 0; m < 4; ++m) { bf16* rowp = base + (size_t)(row0 + ai * 128 + m * 16) * U_LD;
#pragma unroll
                    for (int bj = 0; bj < 2; ++bj) { const f32x4 v0 = acc[ai][bj][m][0], v1 = acc[ai][bj][m][1];
                        pg8::u32x4 w; w.x = pg8::cvt_pk_bf16(v0[0], v0[1]); w.y = pg8::cvt_pk_bf16(v0[2], v0[3]); w.z = pg8::cvt_pk_bf16(v1[0], v1[1]); w.w = pg8::cvt_pk_bf16(v1[2], v1[3]);
                        *(pg8::u32x4*)(rowp + bj * 128) = w; } }
        } else {
            float* base = US + wc * 32 + 8 * fq;
#pragma unroll
            for (int ai = 0; ai < 2; ++ai)
#pragma unroll
                for (int m = 0; m < 4; ++m) { float* rowp = base + (size_t)(row0 + ai * 128 + m * 16) * 256;
#pragma unroll
                    for (int bj = 0; bj < 2; ++bj) { *(f32x4*)(rowp + bj * 128) = acc[ai][bj][m][0]; *(f32x4*)(rowp + bj * 128 + 4) = acc[ai][bj][m][1]; } }
        }
    }
};

__device__ __forceinline__ float softplusf_(float x) { return fmaxf(x, 0.f) + __builtin_amdgcn_logf(1.0f + fexp(-fabsf(x))) * 0.6931471805599453f; }
__device__ __forceinline__ float ftanh(float x) { return 1.0f - 2.0f * frcp(fexp(2.0f * x) + 1.0f); }
template <int PRB> __device__ __forceinline__ void p2_prep(Frame& F) {
    const int lane = F.lane, wave = F.wave, tid = F.tid, fr = lane & 15, fq = lane >> 4;
    const float* US = (const float*)(F.ws + WS_US);
    const float* mu = KIN(3);
    const int r0 = F.vcu * 64;
    LAS bf16* At = (LAS bf16*)(F.lds + RING_OFF);
    LAS bf16* Aa = At + 64 * 72;
    {
        const int row = tid >> 3, c8 = (tid & 7) * 8; const int m = r0 + row; const bool first = (m % SEQ) == 0; const int mp = first ? m : m - 1;
        const f32x4 cw0 = *(const f32x4*)(US + (size_t)m * 256 + c8), cw1 = *(const f32x4*)(US + (size_t)m * 256 + c8 + 4), ca0 = *(const f32x4*)(US + (size_t)m * 256 + 64 + c8), ca1 = *(const f32x4*)(US + (size_t)m * 256 + 64 + c8 + 4);
        f32x4 pw0 = *(const f32x4*)(US + (size_t)mp * 256 + c8), pw1 = *(const f32x4*)(US + (size_t)mp * 256 + c8 + 4), pa0 = *(const f32x4*)(US + (size_t)mp * 256 + 64 + c8), pa1 = *(const f32x4*)(US + (size_t)mp * 256 + 64 + c8 + 4);
        if (first) { pw0 = (f32x4){0.f, 0.f, 0.f, 0.f}; pw1 = pw0; pa0 = pw0; pa1 = pw0; }
        const f32x4 mw0 = *(const f32x4*)(mu + 1536 + c8), mw1 = *(const f32x4*)(mu + 1536 + c8 + 4), ma0 = *(const f32x4*)(mu + 1600 + c8), ma1 = *(const f32x4*)(mu + 1600 + c8 + 4);
        const f32x4 w0 = cw0 + (pw0 - cw0) * mw0, w1 = cw1 + (pw1 - cw1) * mw1, a0 = ca0 + (pa0 - ca0) * ma0, a1 = ca1 + (pa1 - ca1) * ma1;
        v4u ow, oa;
        ow.x = pk2(ftanh(w0[0]), ftanh(w0[1])); ow.y = pk2(ftanh(w0[2]), ftanh(w0[3])); ow.z = pk2(ftanh(w1[0]), ftanh(w1[1])); ow.w = pk2(ftanh(w1[2]), ftanh(w1[3]));
        oa.x = pk2(a0[0], a0[1]); oa.y = pk2(a0[2], a0[3]); oa.z = pk2(a1[0], a1[1]); oa.w = pk2(a1[2], a1[3]);
        *(LAS v4u*)(At + row * 72 + c8) = ow; *(LAS v4u*)(Aa + row * 72 + c8) = oa;
    }
    __syncthreads();
    {
        float* DEC = PRB ? (float*)(F.ws + WS_UA) : F.out; float* LR = DEC + (size_t)T * 512;
        const float* wup = KIN(4); const float* aup = KIN(6); const float* w0p = KIN(5); const float* a0p = KIN(7);
        bf16x8 bt[4][2], ba[4][2];
#pragma unroll
        for (int tt = 0; tt < 4; ++tt)
#pragma unroll
            for (int ks = 0; ks < 2; ++ks) { bt[tt][ks] = *(const LAS bf16x8*)(At + (16 * tt + fr) * 72 + 32 * ks + 8 * fq); ba[tt][ks] = *(const LAS bf16x8*)(Aa + (16 * tt + fr) * 72 + 32 * ks + 8 * fq); }
#pragma unroll 1
        for (int ct = 0; ct < 4; ++ct) {
            const int chA = 64 * wave + 16 * ct + fr;
            bf16x8 wf[2], af[2];
#pragma unroll
            for (int ks = 0; ks < 2; ++ks) { float x[8], y[8];
#pragma unroll
                for (int j = 0; j < 8; ++j) { x[j] = wup[(size_t)(32 * ks + 8 * fq + j) * 512 + chA]; y[j] = aup[(size_t)(32 * ks + 8 * fq + j) * 512 + chA]; }
                v4u w; w.x = pk2(x[0], x[1]); w.y = pk2(x[2], x[3]); w.z = pk2(x[4], x[5]); w.w = pk2(x[6], x[7]); wf[ks] = __builtin_bit_cast(bf16x8, w);
                v4u a; a.x = pk2(y[0], y[1]); a.y = pk2(y[2], y[3]); a.z = pk2(y[4], y[5]); a.w = pk2(y[6], y[7]); af[ks] = __builtin_bit_cast(bf16x8, a); }
            const int ch4 = 64 * wave + 16 * ct + 4 * fq;
            const f32x4 w0v = *(const f32x4*)(w0p + ch4), a0v = *(const f32x4*)(a0p + ch4);
#pragma unroll
            for (int tt = 0; tt < 4; ++tt) {
                f32x4 aw = (f32x4){0.f, 0.f, 0.f, 0.f}, aa = aw;
#pragma unroll
                for (int ks = 0; ks < 2; ++ks) { aw = __builtin_amdgcn_mfma_f32_16x16x32_bf16(wf[ks], bt[tt][ks], aw, 0, 0, 0); aa = __builtin_amdgcn_mfma_f32_16x16x32_bf16(af[ks], ba[tt][ks], aa, 0, 0, 0); }
                f32x4 dv, lv;
#pragma unroll
                for (int e = 0; e < 4; ++e) { const float z = w0v[e] + aw[e]; const float w = -softplusf_(-z) - 0.5f; dv[e] = -fexp(w);                        lv[e] = sigmoidf_(a0v[e] + aa[e]); }
                const size_t o = (size_t)(r0 + 16 * tt + fr) * 512 + ch4;
                *(f32x4*)(DEC + o) = dv; *(f32x4*)(LR + o) = lv;
            }
        }
    }
    {
        bf16* UB = (bf16*)(F.ws + WS_UB);
        const int d0 = (lane & 7) * 8;
        float gq[8], gk[8];
        { const float* qg = KIN(14); const float* kg = KIN(15);
#pragma unroll
        for (int e = 0; e < 8; ++e) { gq[e] = qg[d0 + e] * C2; gk[e] = kg[d0 + e]; } }
#pragma unroll 1
        for (int it = 0; it < 4; ++it) {
            v4u w[4]; GAS v4u* p[4];
#pragma unroll
            for (int u = 0; u < 4; ++u) { const int tsk = wave * 16 + it * 4 + u; const int m = r0 + (tsk >> 1), which = tsk & 1;
                p[u] = (GAS v4u*)(UB + (size_t)m * U_LD + which * 512) + lane; w[u] = *p[u]; }
#pragma unroll
            for (int u = 0; u < 4; ++u) { const int which = u & 1;
                float x[8] = {bflo(w[u].x), bfhi(w[u].x), bflo(w[u].y), bfhi(w[u].y), bflo(w[u].z), bfhi(w[u].z), bflo(w[u].w), bfhi(w[u].w)};
                float s = 0.f;
#pragma unroll
                for (int e = 0; e < 8; ++e) s += x[e] * x[e];
                s += dppf<0xB1>(s); s += dppf<0x4E>(s); s += dppf<0x141>(s);
                const float rs = 1.f / sqrtf(s * (1.f / 64.f) + RMS_EPS);
#pragma unroll
                for (int e = 0; e < 8; ++e) x[e] = x[e] * rs * (which ? gk[e] : gq[e]);
                v4u o; o.x = pk2(x[0], x[1]); o.y = pk2(x[2], x[3]); o.z = pk2(x[4], x[5]); o.w = pk2(x[6], x[7]);
                if (PRB) *((GAS v4u*)((bf16*)(F.ws + WS_UA) + ((char*)p[u] - (char*)UB) / 2)) = o; else *p[u] = o; }
        }
    }
    __syncthreads();
    if (F.vcu < 64) {
        const int b = F.vcu >> 3, h = F.vcu & 7; const float fb = KIN(13)[h];
        float* G2 = (float*)(F.ws + (PRB ? WS_UB : WS_G2)) + (size_t)F.vcu * SEQ + 4 * tid;
        LAS float* wtot = (LAS float*)(F.lds + RING_OFF);
        float v[4]; float run = 0.f;
#pragma unroll
        for (int i = 0; i < 4; ++i) v[i] = US[(size_t)(b * SEQ + 4 * tid + i) * 256 + 128 + h] + fb;
#pragma unroll
        for (int i = 0; i < 4; ++i) { run += -softplusf_(-v[i]) * LOG2E; v[i] = run; }
        float ex = run;
#pragma unroll
        for (int o = 1; o < 64; o <<= 1) { const float nn = __shfl_up(ex, o); if (lane >= o) ex += nn; }
        if (lane == 63) wtot[wave] = ex;
        __syncthreads();
        float woff = 0.f;
#pragma unroll
        for (int w = 0; w < 8; ++w) { const float tw = wtot[w]; if (w < wave) woff += tw; }
        const float off = woff + ex - run;
        *(f32x4*)G2 = (f32x4){v[0] + off, v[1] + off, v[2] + off, v[3] + off};
    }
    __syncthreads();
}
__device__ __forceinline__ int crow(int r, int hi) { return (r & 3) + 8 * (r >> 2) + 4 * hi; }
namespace attn_body {
using bf16=__hip_bfloat16;
using u32x4=__attribute__((ext_vector_type(4)))unsigned;
constexpr int BATCH=8,NHEAD=8,SEQ=2048,D=64,DM=2048;
constexpr int NW=8,QBLK=32,QB=QBLK*NW,KVBLK=64,NQB=SEQ/QB;
constexpr int ATTN_PITCH=DM, ATTN_UNIT_ROWS=QB;
#define SBAR() __builtin_amdgcn_sched_barrier(0)
__device__ __forceinline__ void cmask(f32x16&p0,f32x16&p1,int jb,int qrel,int hi){
  const float NEG=-INFINITY; int kb=64*jb+4*hi;
  #pragma unroll
  for(int r=0;r<16;++r){int kv=kb+(r&3)+8*(r>>2); if(kv>qrel)p0[r]=NEG; if(kv+32>qrel)p1[r]=NEG;}
}

constexpr int NSLOT=3, SLOTB=8192;
constexpr int LDS_K=0, LDS_V=NSLOT*SLOTB, LDS_WS=2*NSLOT*SLOTB, LDS_OST=LDS_WS+NW*64*4, LDS_KX=LDS_OST, LDS_BYTES=LDS_OST+NW*4096;
constexpr float C2A=0.125f*1.4426950408889634f;
__device__ __forceinline__ void glds16(const void*gsrc,unsigned lds_dst){unsigned keep;
  asm volatile("s_mov_b32 %0, m0\n\ts_mov_b32 m0, %2\n\ts_nop 0\n\tglobal_load_lds_dwordx4 %1, off\n\ts_mov_b32 m0, %0":"=&s"(keep):"v"(gsrc),"s"(lds_dst):"memory");}
__device__ __forceinline__ float max3f(float a,float b,float c){float r;asm("v_max3_f32 %0, %1, %2, %3":"=v"(r):"v"(a),"v"(b),"v"(c));return r;}
__device__ __forceinline__ float max2f(float a,float b){float r;asm("v_max_f32_e32 %0, %1, %2":"=v"(r):"v"(a),"v"(b));return r;}
__device__ __forceinline__ float fadd_s(float a,float b){float r;asm("v_add_f32_e32 %0, %1, %2":"=v"(r):"v"(a),"v"(b));return r;}
__device__ __forceinline__ float fsub_s(float a,float b){float r;asm("v_sub_f32_e32 %0, %1, %2":"=v"(r):"v"(a),"v"(b));return r;}
typedef float f32x2_t __attribute__((ext_vector_type(2))); typedef __bf16 bf16x2_t __attribute__((ext_vector_type(2)));
__device__ __forceinline__ unsigned cvtpk_s(float lo,float hi){f32x2_t v={lo,hi};bf16x2_t b=__builtin_convertvector(v,bf16x2_t);return __builtin_bit_cast(unsigned,b);}
#define WAIT_BAR(N) asm volatile("s_waitcnt vmcnt(" #N ") lgkmcnt(0)\n\ts_barrier":::"memory")

__device__ __forceinline__ bf16x8 halfmask(bf16x8 x,unsigned m){u32x4 w=__builtin_bit_cast(u32x4,x);w.x&=m;w.y&=m;w.z&=m;w.w&=m;return __builtin_bit_cast(bf16x8,w);}
__device__ __forceinline__ void qkt(f32x16&p0,f32x16&p1,const char*Kslot,const bf16x8*qr,bf16x8 kx,bf16x8 qr4,int r32,int hi){
  p0=__builtin_amdgcn_mfma_f32_32x32x16_bf16(halfmask(kx,(unsigned)hi-1u),qr4,f32x16{},0,0,0);p1=__builtin_amdgcn_mfma_f32_32x32x16_bf16(halfmask(kx,0u-(unsigned)hi),qr4,f32x16{},0,0,0);
  const char*kb=Kslot+hi*1024+r32*16;
  #pragma unroll
  for(int d0=0;d0<4;++d0){
    const bf16x8 b0=*reinterpret_cast<const bf16x8*>(kb+d0*2048);
    const bf16x8 b1=*reinterpret_cast<const bf16x8*>(kb+d0*2048+512);
    p0=__builtin_amdgcn_mfma_f32_32x32x16_bf16(b0,qr[d0],p0,0,0,0);p1=__builtin_amdgcn_mfma_f32_32x32x16_bf16(b1,qr[d0],p1,0,0,0);}
}
typedef __attribute__((address_space(3))) const char* lds_cptr;
typedef short v4i16_t __attribute__((ext_vector_type(4)));
__device__ __forceinline__ void kload8(bf16x8*kf,lds_cptr kp){
  kf[0]=*(const __attribute__((address_space(3))) bf16x8*)(kp);      kf[1]=*(const __attribute__((address_space(3))) bf16x8*)(kp+512);
  kf[2]=*(const __attribute__((address_space(3))) bf16x8*)(kp+2048); kf[3]=*(const __attribute__((address_space(3))) bf16x8*)(kp+2560);
  kf[4]=*(const __attribute__((address_space(3))) bf16x8*)(kp+4096); kf[5]=*(const __attribute__((address_space(3))) bf16x8*)(kp+4608);
  kf[6]=*(const __attribute__((address_space(3))) bf16x8*)(kp+6144); kf[7]=*(const __attribute__((address_space(3))) bf16x8*)(kp+6656);
}
__device__ __forceinline__ void kload2(bf16x8*kf,lds_cptr kp,int j){ kf[2*j]=*(const __attribute__((address_space(3))) bf16x8*)(kp+j*2048); kf[2*j+1]=*(const __attribute__((address_space(3))) bf16x8*)(kp+j*2048+512); }
__device__ __forceinline__ s16x4 vtr(lds_cptr p){ return __builtin_bit_cast(s16x4,__builtin_amdgcn_ds_read_tr16_b64_v4i16((__attribute__((address_space(3))) v4i16_t*)p)); }
__device__ __forceinline__ float rowmax(const f32x16&p0,const f32x16&p1){
  float a=max3f(p0[0],p0[1],p1[0]),b=max3f(p0[2],p0[3],p1[1]);a=max3f(a,p1[2],p1[3]);
  #pragma unroll
  for(int r=4;r<16;r+=4){a=max3f(a,p0[r],p0[r+1]);b=max3f(b,p0[r+2],p0[r+3]);a=max3f(a,p1[r],p1[r+1]);b=max3f(b,p1[r+2],p1[r+3]);}
  const float m=max2f(a,b);
  auto rr=__builtin_amdgcn_permlane32_swap(__float_as_uint(m),__float_as_uint(m),false,false);
  return max2f(__uint_as_float(rr[0]),__uint_as_float(rr[1]));
}
__device__ __forceinline__ void pv(f32x16*o,int vb,bf16x8 pa0,bf16x8 pa1,bf16x8 pa2,bf16x8 pa3){
  #pragma unroll
  for(int d0=0;d0<2;++d0){s16x4 lo[4],hi[4];
    #pragma unroll
    for(int ks=0;ks<4;++ks){
      asm volatile("ds_read_b64_tr_b16 %0,%1 offset:%c2":"=&v"(lo[ks]):"v"(vb),"i"(d0*4096+ks*1024):"memory");
      asm volatile("ds_read_b64_tr_b16 %0,%1 offset:%c2":"=&v"(hi[ks]):"v"(vb),"i"(d0*4096+ks*1024+512):"memory");}
    asm volatile("s_waitcnt lgkmcnt(0)":::"memory");SBAR();
    #define PK(k) (bf16x8){lo[k][0],lo[k][1],lo[k][2],lo[k][3],hi[k][0],hi[k][1],hi[k][2],hi[k][3]}
    o[d0]=__builtin_amdgcn_mfma_f32_32x32x16_bf16(pa0,PK(0),o[d0],0,0,0);
    o[d0]=__builtin_amdgcn_mfma_f32_32x32x16_bf16(pa1,PK(1),o[d0],0,0,0);
    o[d0]=__builtin_amdgcn_mfma_f32_32x32x16_bf16(pa2,PK(2),o[d0],0,0,0);
    o[d0]=__builtin_amdgcn_mfma_f32_32x32x16_bf16(pa3,PK(3),o[d0],0,0,0);
    #undef PK
  }
}

#ifndef ATTN_STORE16
#define ATTN_STORE16(p,v) (*(u32x4*)(p)=(v))
#endif
__device__ __forceinline__ void split3(float x,unsigned&h_,unsigned&m_,unsigned&l_){h_=f2bf(x);const float r1=x-bf2f(h_);m_=f2bf(r1);const float r2=r1-bf2f(m_);l_=f2bf(r2);}
__device__ __forceinline__ bf16x8 mk_qr4(float c,int hi){unsigned a,b_,c_;split3(c,a,b_,c_);u32x4 w={a|(b_<<16),c_|(0x3F80u<<16),0x3F803F80u,0u};(void)hi;return __builtin_bit_cast(bf16x8,w);}
template<int THRL> __device__ __forceinline__ void attn_unit(int b,int h,int qb,const bf16*Q,const bf16*__restrict__ K,const bf16*__restrict__ V,const bf16*GATE,const float*G2bh,bf16*O,char*shm){
  const int tid=threadIdx.x,lane=tid&63,r32=lane&31,hi=lane>>5; const int wid=__builtin_amdgcn_readfirstlane(tid>>6);
  const long rowbase=(long)b*SEQ; const int q0=qb*QB;
  const bf16*Qw=Q+(rowbase+q0+wid*QBLK)*DM+h*D;
  const bf16*Kh=K+rowbase*DM+h*D,*Vh=V+rowbase*DM+h*D;
  const float gq=G2bh[q0+wid*QBLK+r32];
  const unsigned lds0=(unsigned)(uintptr_t)shm;
  float*wsf=(float*)(shm+LDS_WS)+wid*64;
  const bf16*ksrc=Kh+(long)lane*DM+wid*8;
  const bf16*vsrc=Vh+(long)(16*(wid&3)+(lane>>2))*DM+(wid>>2)*32+(lane&3)*8;
  const unsigned kdst=lds0+LDS_K+wid*1024, vdst=lds0+LDS_V+wid*1024;
  #define DMA_K(t,slot) glds16(ksrc+(long)(t)*KVBLK*DM,(unsigned)__builtin_amdgcn_readfirstlane(kdst+(slot)))
  #define DMA_V(t,slot) glds16(vsrc+(long)(t)*KVBLK*DM,(unsigned)__builtin_amdgcn_readfirstlane(vdst+(slot)))
  const int vb0=(int)(lds0+LDS_V)+((lane>>4)&1)*32+(lane&3)*8+(4*hi+((lane&15)>>2))*64;
  const char*Kbase=shm+LDS_K; bf16x8 kf[8];
  const lds_cptr shm3=(lds_cptr)shm; const lds_cptr kp0=shm3+LDS_K+hi*1024+r32*16; const lds_cptr vp0=shm3+LDS_V+((lane>>4)&1)*32+(lane&3)*8+(4*hi+((lane&15)>>2))*64;
  const lds_cptr kxp=shm3+LDS_KX+(r32+32*hi)*16;
  bf16x8 kx;
  const int NT=(q0+QB)/KVBLK;
  DMA_K(0,0);DMA_V(0,0);DMA_K(1,SLOTB);
  bf16x8 qr[4];
  #pragma unroll
  for(int d0=0;d0<4;++d0)qr[d0]=*reinterpret_cast<const bf16x8*>(&Qw[(long)r32*DM+d0*16+hi*8]);
  float mhat=0.f,l_reg=0.f;f32x16 o[2];o[0]=f32x16{};o[1]=f32x16{};bf16x8 qr4=mk_qr4(gq,hi);
  { float gk[4]; _Pragma("unroll") for(int i=0;i<4;++i){const int k=tid+512*i; gk[i]=(k<q0+QB)?G2bh[k]:0.f;}
    asm volatile("s_waitcnt vmcnt(0)":::"memory");
    _Pragma("unroll") for(int i=0;i<4;++i){const int k=tid+512*i; if(k<q0+QB){unsigned a,b_,c_;split3(-gk[i],a,b_,c_); *(__attribute__((address_space(3))) u32x4*)(shm3+LDS_KX+k*16)=u32x4{0x3F803F80u,0x3F80u|(a<<16),b_|(c_<<16),0u};}}
  }
  const int qrel=wid*QBLK+r32;
  #define CMASK(P0,P1,t) do{int jb_=(t)-(NT-4); if(jb_>=0)cmask(P0,P1,jb_,qrel,hi);}while(0)
  bool resc=false;
  #define START(P0,P1) do{ const float rm=rowmax(P0,P1); resc=false; \
    { const float dl=rm; mhat=fadd_s(mhat,dl); \
      _Pragma("unroll") for(int r=0;r<16;++r){P0[r]=fsub_s(P0[r],dl);P1[r]=fsub_s(P1[r],dl);} \
      qr4=mk_qr4(gq-mhat,hi); } \
    _Pragma("unroll") for(int r=0;r<16;++r)P0[r]=__builtin_amdgcn_exp2f(P0[r]); }while(0)
  #define RESC() do{ if(resc){ asm volatile("s_waitcnt lgkmcnt(0)":::"memory"); \
      _Pragma("unroll") for(int d_=0;d_<2;++d_) _Pragma("unroll") for(int r=0;r<16;++r)o[d_][r]*=wsf[crow(r,hi)]; } }while(0)
  f32x16 pA0,pA1,pB0,pB1;
  int sl_prev=0,sl_cur=0,sl_next=SLOTB;
  #define ROT() do{sl_prev=sl_cur;sl_cur=sl_next;sl_next=(sl_next==(NSLOT-1)*SLOTB)?0:sl_next+SLOTB;}while(0)
  DMA_K(2,2*SLOTB);
  WAIT_BAR(3);
  kx=*(const __attribute__((address_space(3))) bf16x8*)(kxp);
  qkt(pA0,pA1,Kbase,qr,kx,qr4,r32,hi);asm volatile("s_nop 15\n\ts_nop 7":"+v"(pA0),"+v"(pA1));CMASK(pA0,pA1,0);
  START(pA0,pA1);
  _Pragma("unroll") for(int r=0;r<16;++r)pA1[r]=__builtin_amdgcn_exp2f(pA1[r]);
  WAIT_BAR(0);
  DMA_K(3,0);DMA_V(1,SLOTB);
  ROT();
  kload8(kf,kp0+sl_cur);
  kx=*(const __attribute__((address_space(3))) bf16x8*)(kxp+1024);
  WAIT_BAR(2);
  s16x4 vlo[8],vhi[8]; u32x4 pw0,pw1,pw2,pw3;
  #define PKW(P,B) cvtpk_s(P[B],P[B+1])
  #define PAF(k) __builtin_bit_cast(bf16x8,pw##k)
  #define VFR(i) (bf16x8){vlo[i][0],vlo[i][1],vlo[i][2],vlo[i][3],vhi[i][0],vhi[i][1],vhi[i][2],vhi[i][3]}
  #define PIN(x) asm volatile("":"+v"(x))
  #define MX3(a,b,c) __builtin_fmaxf(__builtin_fmaxf((a),(b)),(c))
  #define GAPA(MF,A0,A1,A2,A3,W0,W1,PW) do{ MF; sacc+=A0; sacc+=A1; sacc+=A2; sacc+=A3; PIN(sacc); W0; W1; PIN(PW); SBAR(); }while(0)
  #define EX(v) __builtin_amdgcn_exp2f(v)
  #define GAPB(MF,X,B) do{ MF; X[B]=EX(X[B]); X[B+1]=EX(X[B+1]); X[B+2]=EX(X[B+2]); X[B+3]=EX(X[B+3]); PIN(X); SBAR(); }while(0)
  #define VRD(i) do{ vlo[i]=vtr(vp_+(((i)>>2)*4096+((i)&3)*1024)); vhi[i]=vtr(vp_+(((i)>>2)*4096+((i)&3)*1024+512)); }while(0)
  #define KRD(G,j) do{ if(G){ kload2(kf,kp0+sl_next,j); SBAR(); } }while(0)
  #define KXRD(G,t) do{ if(G){ kx=*(const __attribute__((address_space(3))) bf16x8*)(kxp+((t)+1)*1024); SBAR(); } }while(0)
  #define STEP(C0,C1,P0,P1,t,GK,GV,GL) do{ SBAR(); \
    const lds_cptr vp_=vp0+sl_prev; \
    C0=__builtin_amdgcn_mfma_f32_32x32x16_bf16(halfmask(kx,(unsigned)hi-1u),qr4,f32x16{},0,0,0); C1=__builtin_amdgcn_mfma_f32_32x32x16_bf16(halfmask(kx,0u-(unsigned)hi),qr4,f32x16{},0,0,0); SBAR(); \
    VRD(0); SBAR(); float sacc=(P0[0]+P0[1]); \
    GAPA(C0=__builtin_amdgcn_mfma_f32_32x32x16_bf16(kf[0],qr[0],C0,0,0,0), P0[2],P0[3],P0[4],P0[5],     pw0[0]=PKW(P0,0), pw0[1]=PKW(P0,2), pw0); \
    VRD(4); SBAR(); GAPA(C1=__builtin_amdgcn_mfma_f32_32x32x16_bf16(kf[1],qr[0],C1,0,0,0), P0[6],P0[7],P0[8],P0[9],     pw0[2]=PKW(P0,4), pw0[3]=PKW(P0,6), pw0); \
    VRD(1); SBAR(); GAPA(C0=__builtin_amdgcn_mfma_f32_32x32x16_bf16(kf[2],qr[1],C0,0,0,0),   P0[10],P0[11],P0[12],P0[13], pw1[0]=PKW(P0,8), pw1[1]=PKW(P0,10), pw1); \
    VRD(5); SBAR(); GAPA(C1=__builtin_amdgcn_mfma_f32_32x32x16_bf16(kf[3],qr[1],C1,0,0,0),   P0[14],P0[15],P1[0],P1[1],   pw1[2]=PKW(P0,12),pw1[3]=PKW(P0,14), pw1); \
    VRD(2); SBAR(); GAPA(C0=__builtin_amdgcn_mfma_f32_32x32x16_bf16(kf[4],qr[2],C0,0,0,0),   P1[2],P1[3],P1[4],P1[5],     pw2[0]=PKW(P1,0), pw2[1]=PKW(P1,2), pw2); \
    VRD(6); SBAR(); GAPA(C1=__builtin_amdgcn_mfma_f32_32x32x16_bf16(kf[5],qr[2],C1,0,0,0),   P1[6],P1[7],P1[8],P1[9],     pw2[2]=PKW(P1,4), pw2[3]=PKW(P1,6), pw2); \
    VRD(3); SBAR(); GAPA(C0=__builtin_amdgcn_mfma_f32_32x32x16_bf16(kf[6],qr[3],C0,0,0,0),   P1[10],P1[11],P1[12],P1[13], pw3[0]=PKW(P1,8), pw3[1]=PKW(P1,10), pw3); \
    VRD(7); SBAR(); GAPA(C1=__builtin_amdgcn_mfma_f32_32x32x16_bf16(kf[7],qr[3],C1,0,0,0),   P1[14],P1[15],0.f,0.f,       pw3[2]=PKW(P1,12),pw3[3]=PKW(P1,14), pw3); \
    l_reg+=sacc; \
    if(GK){DMA_K((t)+3,sl_cur);} if(GV){DMA_V((t)+1,sl_next);} \
    CMASK(C0,C1,t); \
    { float a=MX3(C0[0],C0[1],C1[0]),b=MX3(C0[2],C0[3],C1[1]); a=MX3(a,C1[2],C1[3]); \
      _Pragma("unroll") for(int r=4;r<16;r+=4){a=MX3(a,C0[r],C0[r+1]);b=MX3(b,C0[r+2],C0[r+3]);a=MX3(a,C1[r],C1[r+1]);b=MX3(b,C1[r+2],C1[r+3]);} \
      float rm=__builtin_fmaxf(a,b); { auto rr=__builtin_amdgcn_permlane32_swap(__float_as_uint(rm),__float_as_uint(rm),false,false); rm=__builtin_fmaxf(__uint_as_float(rr[0]),__uint_as_float(rr[1])); } \
      resc=false; \
      if(__builtin_expect(__any(rm>(float)THRL),0)){ const float dl=__builtin_fmaxf(rm,0.f); mhat+=dl; \
        _Pragma("unroll") for(int r=0;r<16;++r){C0[r]-=dl;C1[r]-=dl;} \
        qr4=mk_qr4(gq-mhat,hi); \
        const float f=__builtin_amdgcn_exp2f(-dl); l_reg*=f; if(hi==0)wsf[r32]=f; resc=true; } } \
    SBAR(); \
    GAPB(o[0]=__builtin_amdgcn_mfma_f32_32x32x16_bf16(PAF(0),VFR(0),o[0],0,0,0), C0,0); \
    GAPB(o[1]=__builtin_amdgcn_mfma_f32_32x32x16_bf16(PAF(0),VFR(4),o[1],0,0,0), C0,4); \
    KRD(GL,0); GAPB(o[0]=__builtin_amdgcn_mfma_f32_32x32x16_bf16(PAF(1),VFR(1),o[0],0,0,0), C0,8); \
    KRD(GL,1); GAPB(o[1]=__builtin_amdgcn_mfma_f32_32x32x16_bf16(PAF(1),VFR(5),o[1],0,0,0), C0,12); \
    KRD(GL,2); GAPB(o[0]=__builtin_amdgcn_mfma_f32_32x32x16_bf16(PAF(2),VFR(2),o[0],0,0,0), C1,0); \
    KRD(GL,3); GAPB(o[1]=__builtin_amdgcn_mfma_f32_32x32x16_bf16(PAF(2),VFR(6),o[1],0,0,0), C1,4); \
    KXRD(GL,t); GAPB(o[0]=__builtin_amdgcn_mfma_f32_32x32x16_bf16(PAF(3),VFR(3),o[0],0,0,0), C1,8); \
    GAPB(o[1]=__builtin_amdgcn_mfma_f32_32x32x16_bf16(PAF(3),VFR(7),o[1],0,0,0), C1,12); \
    }while(0)
  int t=1;
  #undef CMASK
  #define CMASK(P0,P1,t) do{}while(0)
  for(;t+5<NT;t+=2){
    STEP(pB0,pB1,pA0,pA1,t,true,true,true);     WAIT_BAR(2); RESC(); ROT();
    STEP(pA0,pA1,pB0,pB1,t+1,true,true,true);   WAIT_BAR(2); RESC(); ROT();
  }
  #undef CMASK
  #define CMASK(P0,P1,t) do{int jb_=(t)-(NT-4); if(jb_>=0)cmask(P0,P1,jb_,qrel,hi);}while(0)
  #define ENDW(tt) do{ if((tt)+3<NT){WAIT_BAR(2);} else if((tt)+2<NT){WAIT_BAR(1);} else {WAIT_BAR(0);} }while(0)
  for(;t+1<NT;t+=2){
    STEP(pB0,pB1,pA0,pA1,t,(t+3<NT),(t+1<NT),(t+1<NT));       ENDW(t);   RESC(); ROT();
    STEP(pA0,pA1,pB0,pB1,t+1,(t+4<NT),(t+2<NT),(t+2<NT));     ENDW(t+1); RESC(); ROT();
  }
  STEP(pB0,pB1,pA0,pA1,NT-1,false,false,false); RESC();
  { float sacc=pB0[0]+pB0[1]; _Pragma("unroll") for(int r=2;r<16;++r)sacc+=pB0[r]; _Pragma("unroll") for(int r=0;r<16;++r)sacc+=pB1[r]; l_reg+=sacc;
    pw0=(u32x4){PKW(pB0,0),PKW(pB0,2),PKW(pB0,4),PKW(pB0,6)};pw1=(u32x4){PKW(pB0,8),PKW(pB0,10),PKW(pB0,12),PKW(pB0,14)};pw2=(u32x4){PKW(pB1,0),PKW(pB1,2),PKW(pB1,4),PKW(pB1,6)};pw3=(u32x4){PKW(pB1,8),PKW(pB1,10),PKW(pB1,12),PKW(pB1,14)};
    SBAR(); pv(o,vb0+sl_cur,PAF(0),PAF(1),PAF(2),PAF(3)); }
  #undef PKW
  #undef PAF
  #undef VFR
  #undef PIN
  #undef MX3
  #undef GAPA
  #undef GAPB
  #undef EX
  #undef VRD
  #undef KRD
  #undef KXRD
  #undef STEP
  #undef ENDW
  {auto rr=__builtin_amdgcn_permlane32_swap(__float_as_uint(l_reg),__float_as_uint(l_reg),false,false);l_reg=__uint_as_float(rr[0])+__uint_as_float(rr[1]);}
  if(hi==0)wsf[32+r32]=l_reg;asm volatile("s_waitcnt lgkmcnt(0)":::"memory");
  float rli[16];
  #pragma unroll
  for(int r=0;r<16;++r)rli[r]=__builtin_amdgcn_rcpf(wsf[32+crow(r,hi)]);
  bf16*Ow=O+(rowbase+q0+wid*QBLK)*DM+h*D;
  { bf16*stg=(bf16*)(shm+LDS_OST)+wid*2048;
    #pragma unroll
    for(int r=0;r<16;++r){const int orow=crow(r,hi);
      #pragma unroll
      for(int d0=0;d0<2;++d0)stg[orow*64+d0*32+r32]=__float2bfloat16(o[d0][r]*rli[r]);}
    asm volatile("s_waitcnt lgkmcnt(0)":::"memory");
    const bf16*Gw=GATE+(rowbase+q0+wid*QBLK)*DM+h*D;
    #pragma unroll
    for(int i=0;i<4;++i){const int row=i*8+(lane>>3),ch=lane&7; const u32x4 v=*(const u32x4*)(stg+row*64+ch*8); const u32x4 g=*(const u32x4*)(Gw+(long)row*DM+ch*8); u32x4 w;
      w.x=pk2(bflo(v.x)*siluf_(bflo(g.x)),bfhi(v.x)*siluf_(bfhi(g.x))); w.y=pk2(bflo(v.y)*siluf_(bflo(g.y)),bfhi(v.y)*siluf_(bfhi(g.y))); w.z=pk2(bflo(v.z)*siluf_(bflo(g.z)),bfhi(v.z)*siluf_(bfhi(g.z))); w.w=pk2(bflo(v.w)*siluf_(bflo(g.w)),bfhi(v.w)*siluf_(bfhi(g.w)));
      ATTN_STORE16(Ow+(long)row*DM+ch*8,w);} }
  asm volatile("s_waitcnt lgkmcnt(0)\n\ts_barrier":::"memory");
  #undef DMA_K
  #undef DMA_V
  #undef CMASK
  #undef START
  #undef RESC
  #undef ROT
}
constexpr int ATTN_LDS_BYTES=LDS_BYTES;
struct AttnTensors { const bf16* Q; const bf16* K; const bf16* V; const bf16* GATE; const float* G2; bf16* O; };
struct AttnUnit { int bh; int qb; };
struct StaticOrder {
  int vcu;
  __device__ __forceinline__ explicit StaticOrder(int v):vcu(v){}
  __device__ __forceinline__ bool next(int i,AttnUnit&u)const{ if(i>=2)return false; const int s=vcu&3; u.bh=vcu>>2; u.qb=(i==0)?s:7-s; return true; }
};
template<class Sched,int THRL=8> __device__ __forceinline__ void attn_phase(char*lds,const AttnTensors&T,const Sched&S){
  AttnUnit u;
  for(int i=0;S.next(i,u);++i){ attn_unit<THRL>(u.bh/NHEAD,u.bh%NHEAD,u.qb,T.Q,T.K,T.V,T.GATE,T.G2+(long)u.bh*SEQ,T.O,lds); }
}
#undef SBAR
#undef WAIT_BAR
}

__device__ __forceinline__ void p3_attention(Frame& F) {
    const bf16* UB = (const bf16*)(F.ws + WS_UB);
    const attn_body::AttnTensors AT{(const attn_body::bf16*)UB, (const attn_body::bf16*)(UB + 512), (const attn_body::bf16*)(UB + 1024), (const attn_body::bf16*)(UB + 1536), (const float*)(F.ws + WS_G2), (attn_body::bf16*)((bf16*)(F.ws + WS_ACOMB) + ZB_OFF)};
    const attn_body::StaticOrder S(F.vcu);
    attn_body::attn_phase<attn_body::StaticOrder>((char*)F.ldsg, AT, S);
}
constexpr int SPT = 72, SLOTB_ = 64 * SPT * 2;
struct ScanRaw { v4u ur, uk, uv, pr, pk, pv; f32x4 lr0, lr1, ld0, ld1; };
__device__ __forceinline__ bf16x8 rf(const LAS bf16* img, int r0, int k0, int fr, int fq) { return *(const LAS bf16x8*)(img + (r0 + fr) * SPT + k0 + 8 * fq); }
__device__ __forceinline__ bf16x8 cf(const LAS bf16* img, int c0, int k0, int fr, int fq) {
    typedef short v4i16_t __attribute__((ext_vector_type(4)));
    const LAS bf16* p = img + (k0 + 8 * fq + (fr >> 2)) * SPT + c0 + 4 * (fr & 3);
    const v4i16_t lo = __builtin_amdgcn_ds_read_tr16_b64_v4i16((LAS v4i16_t*)p), hi = __builtin_amdgcn_ds_read_tr16_b64_v4i16((LAS v4i16_t*)(p + 4 * SPT));
    return (bf16x8){lo[0], lo[1], lo[2], lo[3], hi[0], hi[1], hi[2], hi[3]};
}
__device__ __forceinline__ void stT(LAS bf16* img, int n0, int m0, f32x4 a, int fr, int fq) { *(LAS v2u*)(img + (n0 + fr) * SPT + m0 + 4 * fq) = (v2u){pg8::cvt_pk_bf16(a[0], a[1]), pg8::cvt_pk_bf16(a[2], a[3])}; }
__device__ __forceinline__ f32x4 ldT(const LAS bf16* img, int n0, int m0, int fr, int fq) { const v2u w = *(const LAS v2u*)(img + (n0 + fr) * SPT + m0 + 4 * fq); return (f32x4){bflo(w.x), bfhi(w.x), bflo(w.y), bfhi(w.y)}; }
template <int MODE> __device__ __forceinline__ void prod2(f32x4& d0, f32x4& d1, const LAS bf16* Fm, const LAS bf16* Gm, int n0, int m0, int fr, int fq) {
#pragma unroll
    for (int ks = 0; ks < 2; ++ks) {
        const bf16x8 bfrag = MODE == 2 ? cf(Fm, n0, 32 * ks, fr, fq) : rf(Fm, n0, 32 * ks, fr, fq);
        const bf16x8 a0 = MODE == 0 ? rf(Gm, m0, 32 * ks, fr, fq) : cf(Gm, m0, 32 * ks, fr, fq), a1 = MODE == 0 ? rf(Gm, m0 + 16, 32 * ks, fr, fq) : cf(Gm, m0 + 16, 32 * ks, fr, fq);
        d0 = __builtin_amdgcn_mfma_f32_16x16x32_bf16(a0, bfrag, d0, 0, 0, 0); d1 = __builtin_amdgcn_mfma_f32_16x16x32_bf16(a1, bfrag, d1, 0, 0, 0);
    }
}
#define SC_BAR() do { asm volatile("s_waitcnt lgkmcnt(0)" ::: "memory"); __builtin_amdgcn_s_barrier(); asm volatile("" ::: "memory"); } while (0)

template <int VAR> __device__ __forceinline__ void p4_scan_a(Frame& F) {
    const int tid = F.tid, lane = F.lane, w = F.wave, fr = lane & 15, fq = lane >> 4;
    const bf16* UA = (const bf16*)(F.ws + WS_UA);
    const float* LDm = F.out; const float* LR = F.out + (size_t)T * 512;
    float* Gg = (float*)(F.ws + WS_UB); float* Hg = Gg + (size_t)2048 * 4096;
    bf16* Rbar = (bf16*)(F.ws + WS_US); bf16* Yloc = (bf16*)(F.ws + WS_YLOC);
    float* BON = (float*)(F.ws + WS_BONUS);
    const float* mu = KIN(3); const float* kkp = KIN(8); const float* kap = KIN(9); const float* rkp = KIN(10);
    LAS bf16* const mAt = (LAS bf16*)(F.lds + 0 * SLOTB_); LAS bf16* const mRt = (LAS bf16*)(F.lds + 1 * SLOTB_); LAS bf16* const mBt = (LAS bf16*)(F.lds + 2 * SLOTB_); LAS bf16* const mKt = (LAS bf16*)(F.lds + 3 * SLOTB_);
    LAS bf16* const mBd = (LAS bf16*)(F.lds + 4 * SLOTB_); LAS bf16* const mKd = (LAS bf16*)(F.lds + 5 * SLOTB_); LAS bf16* const mV = (LAS bf16*)(F.lds + 6 * SLOTB_); LAS bf16* const m7 = (LAS bf16*)(F.lds + 7 * SLOTB_);
    LAS bf16* const m8 = (LAS bf16*)(F.lds + 8 * SLOTB_); LAS bf16* const mQ = (LAS bf16*)(F.lds + 9 * SLOTB_); LAS bf16* const mR1 = (LAS bf16*)(F.lds + 10 * SLOTB_); LAS bf16* const mR2 = (LAS bf16*)(F.lds + 11 * SLOTB_);
    LAS bf16* const mW1 = (LAS bf16*)(F.lds + 12 * SLOTB_); LAS bf16* const mAb = (LAS bf16*)(F.lds + 13 * SLOTB_);
    LAS float* const Ls = (LAS float*)(F.lds + 7 * SLOTB_); LAS float* const Lc = Ls + 4096; LAS float* const e63 = (LAS float*)(F.lds + 14 * SLOTB_);
    const int t = tid >> 3, c8 = (tid & 7) * 8;
    const int n0 = 16 * (w >> 1), m0 = 32 * (w & 1);
    const int id0 = F.vcu * 8; const int b = id0 >> 8, h = (id0 >> 5) & 7; const int hc = h * 64 + c8;
    auto load_raw = [&](int id, ScanRaw& R) {
        const int c = id & 31; const long m = (long)b * SEQ + c * 64 + t; const long mp = (c == 0 && t == 0) ? m : m - 1;
        const bf16* up = UA + m * U_LD + hc; const bf16* pp = UA + mp * U_LD + hc;
        R.ur = *(const v4u*)up; R.uk = *(const v4u*)(up + 512); R.uv = *(const v4u*)(up + 1024);
        R.pr = *(const v4u*)pp; R.pk = *(const v4u*)(pp + 512); R.pv = *(const v4u*)(pp + 1024);
        R.lr0 = *(const f32x4*)(LR + m * 512 + hc); R.lr1 = *(const f32x4*)(LR + m * 512 + hc + 4); R.ld0 = *(const f32x4*)(LDm + m * 512 + hc); R.ld1 = *(const f32x4*)(LDm + m * 512 + hc + 4);
    };
    ScanRaw RW; load_raw(id0, RW);
#pragma unroll 1
    for (int kq = 0; kq < 8; ++kq) {
        const int id = id0 + kq, c = id & 31; const long mrow0 = (long)b * SEQ + c * 64;
        float rr[8], kk_[8], vv[8], lr[8], ld[8], av[8], bv[8], km[8];
        { const bool first = (c == 0 && t == 0);
          const unsigned ur[4] = {RW.ur.x, RW.ur.y, RW.ur.z, RW.ur.w}, uk[4] = {RW.uk.x, RW.uk.y, RW.uk.z, RW.uk.w}, uv[4] = {RW.uv.x, RW.uv.y, RW.uv.z, RW.uv.w};
          const unsigned pr[4] = {RW.pr.x, RW.pr.y, RW.pr.z, RW.pr.w}, pk[4] = {RW.pk.x, RW.pk.y, RW.pk.z, RW.pk.w}, pv[4] = {RW.pv.x, RW.pv.y, RW.pv.z, RW.pv.w};
          float ss = 0.f, bon = 0.f;
#pragma unroll
          for (int e = 0; e < 8; ++e) { const int q = e >> 1; const bool hi_ = e & 1;
              const float cr = hi_ ? bfhi(ur[q]) : bflo(ur[q]), ck = hi_ ? bfhi(uk[q]) : bflo(uk[q]), cv = hi_ ? bfhi(uv[q]) : bflo(uv[q]);
              const float xr = first ? 0.f : (hi_ ? bfhi(pr[q]) : bflo(pr[q])), xk = first ? 0.f : (hi_ ? bfhi(pk[q]) : bflo(pk[q])), xv = first ? 0.f : (hi_ ? bfhi(pv[q]) : bflo(pv[q]));
              rr[e] = cr + (xr - cr) * mu[hc + e]; kk_[e] = ck + (xk - ck) * mu[512 + hc + e]; vv[e] = cv + (xv - cv) * mu[1024 + hc + e];
              lr[e] = e < 4 ? RW.lr0[e & 3] : RW.lr1[e & 3]; ld[e] = e < 4 ? RW.ld0[e & 3] : RW.ld1[e & 3];
              const float kv = kk_[e] * kkp[hc + e]; av[e] = kv; ss += kv * kv; }
          ss += dppf<0xB1>(ss); ss += dppf<0x4E>(ss); ss += dppf<0x141>(ss);
          const float inv = 1.0f / fmaxf(sqrtf(ss), 1e-12f);
#pragma unroll
          for (int e = 0; e < 8; ++e) { av[e] = -av[e] * inv; bv[e] = -av[e] * lr[e]; km[e] = kk_[e] * (1.0f + (lr[e] - 1.0f) * kap[hc + e]); bon += rr[e] * km[e] * rkp[hc + e]; }
          bon += dppf<0xB1>(bon); bon += dppf<0x4E>(bon); bon += dppf<0x141>(bon);
          if ((tid & 7) == 0) BON[(mrow0 + t) * 8 + h] = bon;
          *(LAS f32x4*)(Ls + t * 64 + c8) = (f32x4){ld[0], ld[1], ld[2], ld[3]}; *(LAS f32x4*)(Ls + t * 64 + c8 + 4) = (f32x4){ld[4], ld[5], ld[6], ld[7]}; }
        if (kq < 7) load_raw(id + 1, RW);
        SC_BAR();
        { const int j = tid & 63, g = w; float off = 0.f;
          for (int tau = 0; tau < 8 * g; ++tau) off += Ls[tau * 64 + j];
#pragma unroll
          for (int i = 0; i < 8; ++i) { off += Ls[(8 * g + i) * 64 + j]; Lc[(8 * g + i) * 64 + j] = off; } }
        SC_BAR();
        { const f32x4 l0 = *(const LAS f32x4*)(Lc + t * 64 + c8), l1 = *(const LAS f32x4*)(Lc + t * 64 + c8 + 4), z0 = *(const LAS f32x4*)(Lc + 63 * 64 + c8), z1 = *(const LAS f32x4*)(Lc + 63 * 64 + c8 + 4);
          float oa[8], orr[8], ob[8], ok[8], obd[8], okd[8];
#pragma unroll
          for (int e = 0; e < 8; ++e) { const float Lt = e < 4 ? l0[e & 3] : l1[e & 3], L63 = e < 4 ? z0[e & 3] : z1[e & 3];
              const float eLm = fexp(Lt - ld[e]), eL = fexp(Lt), en = fexp(-Lt), ed = fexp(L63 - Lt);
              oa[e] = av[e] * eLm; orr[e] = rr[e] * eL; ob[e] = bv[e] * en; ok[e] = km[e] * en; obd[e] = bv[e] * ed; okd[e] = km[e] * ed;
              if (t == 63) e63[c8 + e] = eL; }
#define SC_ST8(img, x) *(LAS v4u*)((img) + t * SPT + c8) = (v4u){pg8::cvt_pk_bf16(x[0], x[1]), pg8::cvt_pk_bf16(x[2], x[3]), pg8::cvt_pk_bf16(x[4], x[5]), pg8::cvt_pk_bf16(x[6], x[7])}
          SC_ST8(mAt, oa); SC_ST8(mRt, orr); SC_ST8(mBt, ob); SC_ST8(mKt, ok); SC_ST8(mBd, obd); SC_ST8(mKd, okd); SC_ST8(mV, vv);
#undef SC_ST8
        }
        SC_BAR();
        { f32x4 p0 = {0.f, 0.f, 0.f, 0.f}, p1 = p0, q0 = p0, q1 = p0, r10 = p0, r11 = p0, r20 = p0, r21 = p0;
          prod2<0>(p0, p1, mAt, mBt, n0, m0, fr, fq); prod2<0>(q0, q1, mAt, mKt, n0, m0, fr, fq); prod2<0>(r10, r11, mRt, mBt, n0, m0, fr, fq); prod2<0>(r20, r21, mRt, mKt, n0, m0, fr, fq);
          const int tt = n0 + fr;
#pragma unroll
          for (int r = 0; r < 4; ++r) { const int s0 = m0 + 4 * fq + r, s1 = s0 + 16;
              if (!(s0 < tt)) { p0[r] = 0.f; q0[r] = 0.f; } if (!(s1 < tt)) { p1[r] = 0.f; q1[r] = 0.f; }
              if (!(s0 <= tt)) { r10[r] = 0.f; r20[r] = 0.f; } if (!(s1 <= tt)) { r11[r] = 0.f; r21[r] = 0.f; } }
          stT(m7, n0, m0, p0, fr, fq); stT(m7, n0, m0 + 16, p1, fr, fq); stT(mQ, n0, m0, q0, fr, fq); stT(mQ, n0, m0 + 16, q1, fr, fq);
          stT(mR1, n0, m0, r10, fr, fq); stT(mR1, n0, m0 + 16, r11, fr, fq); stT(mR2, n0, m0, r20, fr, fq); stT(mR2, n0, m0 + 16, r21, fr, fq);
#pragma unroll
          for (int r = 0; r < 4; ++r) { if (m0 + 4 * fq + r == tt) p0[r] += 1.0f; if (m0 + 16 + 4 * fq + r == tt) p1[r] += 1.0f; }
          stT(m8, n0, m0, p0, fr, fq); stT(m8, n0, m0 + 16, p1, fr, fq); }
        SC_BAR();
        { f32x4 s0 = {0.f, 0.f, 0.f, 0.f}, s1 = s0, w0 = s0, w1 = s0;
          prod2<1>(s0, s1, m7, m7, n0, m0, fr, fq); prod2<1>(w0, w1, mQ, mV, n0, m0, fr, fq);
          stT(mBt, n0, m0, s0, fr, fq); stT(mBt, n0, m0 + 16, s1, fr, fq); stT(mW1, n0, m0, w0, fr, fq); stT(mW1, n0, m0 + 16, w1, fr, fq); }
        SC_BAR();
#pragma unroll
        for (int it = 0; it < 5; ++it) {
            LAS bf16* const Sc = (it & 1) ? mKt : mBt; LAS bf16* const Sn = (it & 1) ? mBt : mKt;
            LAS bf16* const Xc = (it & 1) ? m7 : m8; LAS bf16* const Xn = (it & 1) ? m8 : m7;
            f32x4 x0 = ldT(Xc, n0, m0, fr, fq), x1 = ldT(Xc, n0, m0 + 16, fr, fq);
            prod2<1>(x0, x1, Sc, Xc, n0, m0, fr, fq);
            if (it < 4) { f32x4 s0 = {0.f, 0.f, 0.f, 0.f}, s1 = s0; prod2<1>(s0, s1, Sc, Sc, n0, m0, fr, fq); stT(Sn, n0, m0, s0, fr, fq); stT(Sn, n0, m0 + 16, s1, fr, fq); }
            stT(Xn, n0, m0, x0, fr, fq); stT(Xn, n0, m0 + 16, x1, fr, fq);
            SC_BAR();
        }
        { f32x4 u0 = {0.f, 0.f, 0.f, 0.f}, u1 = u0, a0 = u0, a1 = u0;
          prod2<1>(u0, u1, m7, mW1, n0, m0, fr, fq); prod2<1>(a0, a1, m7, mAt, n0, m0, fr, fq);
          stT(mQ, n0, m0, u0, fr, fq); stT(mQ, n0, m0 + 16, u1, fr, fq); stT(mAb, n0, m0, a0, fr, fq); stT(mAb, n0, m0 + 16, a1, fr, fq); }
        SC_BAR();
        { const long mrow = mrow0 + n0 + fr; const int col = h * 64 + m0 + 4 * fq;
          f32x4 y0 = {0.f, 0.f, 0.f, 0.f}, y1 = y0;
          prod2<1>(y0, y1, mR1, mQ, n0, m0, fr, fq); prod2<1>(y0, y1, mR2, mV, n0, m0, fr, fq);
          *(v2u*)(Yloc + mrow * 512 + col) = (v2u){pg8::cvt_pk_bf16(y0[0], y0[1]), pg8::cvt_pk_bf16(y0[2], y0[3])}; *(v2u*)(Yloc + mrow * 512 + col + 16) = (v2u){pg8::cvt_pk_bf16(y1[0], y1[1]), pg8::cvt_pk_bf16(y1[2], y1[3])};
          f32x4 b0 = ldT(mRt, n0, m0, fr, fq), b1 = ldT(mRt, n0, m0 + 16, fr, fq);
          prod2<1>(b0, b1, mR1, mAb, n0, m0, fr, fq);
          *(v2u*)(Rbar + mrow * 512 + col) = (v2u){pg8::cvt_pk_bf16(b0[0], b0[1]), pg8::cvt_pk_bf16(b0[2], b0[3])}; *(v2u*)(Rbar + mrow * 512 + col + 16) = (v2u){pg8::cvt_pk_bf16(b1[0], b1[1]), pg8::cvt_pk_bf16(b1[2], b1[3])};
          f32x4 g0 = {0.f, 0.f, 0.f, 0.f}, g1 = g0, h0 = g0, h1 = g0;
          prod2<2>(g0, g1, mAb, mBd, n0, m0, fr, fq);
#pragma unroll
          for (int r = 0; r < 4; ++r) { if (m0 + 4 * fq + r == n0 + fr) g0[r] += e63[n0 + fr]; if (m0 + 16 + 4 * fq + r == n0 + fr) g1[r] += e63[n0 + fr]; }
          prod2<2>(h0, h1, mQ, mBd, n0, m0, fr, fq); prod2<2>(h0, h1, mV, mKd, n0, m0, fr, fq);
          float* gp = Gg + (size_t)id * 4096 + (n0 + fr) * 64 + m0 + 4 * fq; float* hp = Hg + (size_t)id * 4096 + (n0 + fr) * 64 + m0 + 4 * fq;
          *(f32x4*)gp = g0; *(f32x4*)(gp + 16) = g1; *(f32x4*)hp = h0; *(f32x4*)(hp + 16) = h1; }
        SC_BAR();
    }
    __syncthreads();
}
#undef SC_BAR

template <int PRB> __device__ __forceinline__ void p5_scan_b(Frame& F) {
    const int bh = F.vcu >> 2, i0 = (F.vcu & 3) * 16, lane = F.lane, fr = lane & 15, fq = lane >> 4, n = F.wave;
    const float* Gm = (const float*)(F.ws + WS_UB); const float* Hm = Gm + (size_t)2048 * 4096;
    float* Sst = PRB ? (float*)(F.ws + WS_UA) : F.out;
    LAS float* Ssb = (LAS float*)(F.lds + RING_OFF);
    const int id0 = ((bh >> 3) << 8) | ((bh & 7) << 5);
    if (n < 4) {
        f32x4 st = (f32x4){0.f, 0.f, 0.f, 0.f};
        float gb[16]; f32x4 hv;
        { const float* gp = Gm + (size_t)id0 * 4096 + 16 * n + fr; const float* hp = Hm + (size_t)id0 * 4096 + (size_t)(i0 + 4 * fq) * 64 + 16 * n + fr;
#pragma unroll
          for (int ks = 0; ks < 16; ++ks) gb[ks] = gp[(4 * ks + fq) * 64];
#pragma unroll
          for (int r = 0; r < 4; ++r) hv[r] = hp[r * 64]; }
        for (int c = 0; c < 32; ++c) {
            const size_t base = (size_t)(id0 + c) * 4096;
            { float* sp = Sst + base + (size_t)(i0 + 4 * fq) * 64 + 16 * n + fr;
#pragma unroll
              for (int r = 0; r < 4; ++r) sp[r * 64] = st[r]; }
            if (c == 31) break;
            LAS float* Ss = Ssb + (c & 1) * (16 * 65);
#pragma unroll
            for (int r = 0; r < 4; ++r) Ss[(4 * fq + r) * 65 + 16 * n + fr] = st[r];
            float ga[16]; f32x4 acc = hv;
#pragma unroll
            for (int ks = 0; ks < 16; ++ks) ga[ks] = gb[ks];
            if (c < 30) { const float* gp = Gm + base + 4096 + 16 * n + fr; const float* hp = Hm + base + 4096 + (size_t)(i0 + 4 * fq) * 64 + 16 * n + fr;
#pragma unroll
                for (int ks = 0; ks < 16; ++ks) gb[ks] = gp[(4 * ks + fq) * 64];
#pragma unroll
                for (int r = 0; r < 4; ++r) hv[r] = hp[r * 64]; }
            asm volatile("s_waitcnt lgkmcnt(0)" ::: "memory"); __builtin_amdgcn_s_barrier(); asm volatile("" ::: "memory");
            float av[16];
#pragma unroll
            for (int ks = 0; ks < 16; ++ks) av[ks] = Ss[fr * 65 + 4 * ks + fq];
#pragma unroll
            for (int ks = 0; ks < 16; ++ks) acc = __builtin_amdgcn_mfma_f32_16x16x4f32(av[ks], ga[ks], acc, 0, 0, 0);
            st = acc;
        }
    } else {
        for (int c = 0; c < 31; ++c) { __builtin_amdgcn_s_barrier(); }
    }
    __syncthreads();
}

__device__ __forceinline__ f32x4 bf4(v2u w) { return (f32x4){bflo(w.x), bfhi(w.x), bflo(w.y), bfhi(w.y)}; }
__device__ __forceinline__ float xrow4_sum(float v) {
    v += __shfl_xor(v, 16); v += __shfl_xor(v, 32); return v;
}
__device__ __forceinline__ void p6_scan_c(Frame& F) {
    const int lane = F.lane, fr = lane & 15, fq = lane >> 4;
    const int id = F.vcu * NWAVES + F.wave;
    const int b = id >> 8, h = (id >> 5) & 7, c = id & 31;
    const bf16* UA = (const bf16*)(F.ws + WS_UA);
    const bf16* Rbar = (const bf16*)(F.ws + WS_US); const bf16* Yloc = (const bf16*)(F.ws + WS_YLOC);
    const float* BON = (const float*)(F.ws + WS_BONUS);
    const float* Sst = F.out + (size_t)id * 4096;
    bf16* Acomb = (bf16*)(F.ws + WS_ACOMB);
    const float* mu = KIN(3);
    const long m0 = (long)b * SEQ + c * 64;
    bf16x8 sfr[4][2];
#pragma unroll
    for (int it = 0; it < 4; ++it)
#pragma unroll
        for (int ks = 0; ks < 2; ++ks) { const float* p = Sst + (16 * it + fr) * 64 + 32 * ks + 8 * fq; const f32x4 x0 = *(const f32x4*)p, x1 = *(const f32x4*)(p + 4);
            v4u w; w.x = pk2(x0[0], x0[1]); w.y = pk2(x0[2], x0[3]); w.z = pk2(x1[0], x1[1]); w.w = pk2(x1[2], x1[3]); sfr[it][ks] = __builtin_bit_cast(bf16x8, w); }
    f32x4 lw[4], lb[4], muv[4], mug[4];
    const float* lnw = KIN(11); const float* lnb = KIN(12);
#pragma unroll
    for (int it = 0; it < 4; ++it) { const int ch = h * 64 + 16 * it + 4 * fq; lw[it] = *(const f32x4*)(lnw + ch); lb[it] = *(const f32x4*)(lnb + ch); muv[it] = *(const f32x4*)(mu + 1024 + ch); mug[it] = *(const f32x4*)(mu + 1664 + ch); }
    struct Ld { bf16x8 rfr[2]; v2u yl[4], cv[4], cg[4], pv[4], pg[4]; float bs; };
    auto load = [&](int tt, Ld& L) {
        const long m = m0 + 16 * tt + fr; const long mp = (m % SEQ) == 0 ? m : m - 1;
#pragma unroll
        for (int ks = 0; ks < 2; ++ks) L.rfr[ks] = *(const bf16x8*)(Rbar + m * 512 + h * 64 + 32 * ks + 8 * fq);
        L.bs = BON[m * 8 + h];
#pragma unroll
        for (int it = 0; it < 4; ++it) { const int ch = h * 64 + 16 * it + 4 * fq;
            L.yl[it] = *(const v2u*)(Yloc + m * 512 + ch);
            L.cv[it] = *(const v2u*)(UA + m * U_LD + 1024 + ch); L.cg[it] = *(const v2u*)(UA + m * U_LD + 1536 + ch);
            L.pv[it] = *(const v2u*)(UA + mp * U_LD + 1024 + ch); L.pg[it] = *(const v2u*)(UA + mp * U_LD + 1536 + ch); }
    };
    auto compute = [&](int tt, const Ld& L) {
        const long m = m0 + 16 * tt + fr; const bool first = (m % SEQ) == 0;
        f32x4 y[4]; float s = 0.f;
#pragma unroll
        for (int it = 0; it < 4; ++it) { f32x4 acc = (f32x4){0.f, 0.f, 0.f, 0.f};
#pragma unroll
            for (int ks = 0; ks < 2; ++ks) acc = __builtin_amdgcn_mfma_f32_16x16x32_bf16(sfr[it][ks], L.rfr[ks], acc, 0, 0, 0);
            y[it] = acc + bf4(L.yl[it]); s += (y[it][0] + y[it][1]) + (y[it][2] + y[it][3]); }
        const float mean = xrow4_sum(s) * (1.f / 64.f); float q = 0.f;
#pragma unroll
        for (int it = 0; it < 4; ++it) { y[it] = y[it] - mean; q += (y[it][0] * y[it][0] + y[it][1] * y[it][1]) + (y[it][2] * y[it][2] + y[it][3] * y[it][3]); }
        const float rstd = 1.0f / sqrtf(xrow4_sum(q) * (1.f / 64.f) + LNX_EPS);
#pragma unroll
        for (int it = 0; it < 4; ++it) { const int ch = h * 64 + 16 * it + 4 * fq;
            const f32x4 cv = bf4(L.cv[it]), cg = bf4(L.cg[it]);
            f32x4 pv = bf4(L.pv[it]), pg = bf4(L.pg[it]);
            if (first) { pv = (f32x4){0.f, 0.f, 0.f, 0.f}; pg = pv; }
            const f32x4 vv = cv + (pv - cv) * muv[it], gg = cg + (pg - cg) * mug[it];
            f32x4 z = y[it] * rstd * lw[it] + lb[it] + L.bs * vv;
            z = (f32x4){z[0] * siluf_(gg[0]), z[1] * siluf_(gg[1]), z[2] * siluf_(gg[2]), z[3] * siluf_(gg[3])};
            *(v2u*)(Acomb + m * ACOMB_LD + ZA_OFF + ch) = (v2u){pk2(z[0], z[1]), pk2(z[2], z[3])}; }
    };
    Ld LA, LB;
    load(0, LA); load(1, LB);
    compute(0, LA); load(2, LA);
    compute(1, LB); load(3, LB);
    compute(2, LA); compute(3, LB);
}
struct SchedP7 {
    int pm, pn; const char* Acomb; const char* WinT; const char* Wab;
    __device__ __forceinline__ bool next(int i, pg8::Unit& u) const {
        if (i >= 4) return false;
        u.pm = pm; u.pn = pn; u.kind = i; u.carry = 0;
        const char* arow = Acomb + (size_t)pm * 256 * ACOMB_LD * 2;
        if (i == 0)      { u.nt = 16; u.a = arow;                 u.b = WinT + (size_t)(4096 + pn * 256) * 1024 * 2; }
        else if (i == 1) { u.nt = 8;  u.a = arow + ZA_OFF * 2;    u.b = Wab + (size_t)(pn * 256) * 1024 * 2; }
        else if (i == 2) { u.nt = 16; u.a = arow;                 u.b = WinT + (size_t)(5120 + pn * 256) * 1024 * 2; }
        else             { u.nt = 8;  u.a = arow + ZB_OFF * 2;    u.b = Wab + (size_t)(pn * 256) * 1024 * 2 + 512 * 2; }
        return true;
    }
};
__device__ __forceinline__ f32x4 bf4lo(v4u w) { return (f32x4){bflo(w.x), bfhi(w.x), bflo(w.y), bfhi(w.y)}; }
__device__ __forceinline__ f32x4 bf4hi(v4u w) { return (f32x4){bflo(w.z), bfhi(w.z), bflo(w.w), bfhi(w.w)}; }
__device__ __forceinline__ v4u pk8(f32x4 v0, f32x4 v1) { v4u w; w.x = pg8::cvt_pk_bf16(v0[0], v0[1]); w.y = pg8::cvt_pk_bf16(v0[2], v0[3]); w.z = pg8::cvt_pk_bf16(v1[0], v1[1]); w.w = pg8::cvt_pk_bf16(v1[2], v1[3]); return w; }
struct EpiP7 {
    v4u* SG; v4u* TMP; bf16* merged;
    __device__ __forceinline__ void operator()(f32x4 (&acc)[2][2][4][2], const pg8::Unit& u, int wr, int wc, int fr, int fq) const {
        const int tid = threadIdx.x;
        GAS v4u* SG = (GAS v4u*)this->SG; GAS v4u* TMP = (GAS v4u*)this->TMP;
        asm volatile("" : "+s"(SG), "+s"(TMP));
        if (u.kind == 0 || u.kind == 2) {
#pragma unroll
            for (int ai = 0; ai < 2; ++ai)
#pragma unroll
                for (int bj = 0; bj < 2; ++bj)
#pragma unroll
                    for (int m = 0; m < 4; ++m) { const f32x4 v0 = acc[ai][bj][m][0], v1 = acc[ai][bj][m][1];
                        (SG + ((((ai * 2 + bj) * 4 + m)) << 9))[tid] = pk8((f32x4){sigmoidf_(v0[0]), sigmoidf_(v0[1]), sigmoidf_(v0[2]), sigmoidf_(v0[3])}, (f32x4){sigmoidf_(v1[0]), sigmoidf_(v1[1]), sigmoidf_(v1[2]), sigmoidf_(v1[3])});
                        asm volatile("" ::: "memory"); }
        } else if (u.kind == 1) {
#pragma unroll
            for (int ai = 0; ai < 2; ++ai)
#pragma unroll
                for (int bj = 0; bj < 2; ++bj)
#pragma unroll
                    for (int m = 0; m < 4; ++m) { const int ix = (((ai * 2 + bj) * 4 + m)) << 9; const v4u g = (SG + ix)[tid];
                        (TMP + ix)[tid] = pk8(acc[ai][bj][m][0] * bf4lo(g), acc[ai][bj][m][1] * bf4hi(g)); if (m & 1) asm volatile("" ::: "memory"); }
        } else {
            const int row0 = u.pm * 256 + wr * 64 + fr; bf16* base = merged + u.pn * 256 + wc * 32 + 8 * fq;
#pragma unroll
            for (int ai = 0; ai < 2; ++ai)
#pragma unroll
                for (int m = 0; m < 4; ++m) { bf16* rowp = base + (size_t)(row0 + ai * 128 + m * 16) * 1024;
#pragma unroll
                    for (int bj = 0; bj < 2; ++bj) { const int ix = (((ai * 2 + bj) * 4 + m)) << 9; const v4u g = (SG + ix)[tid], tm = (TMP + ix)[tid];
                        *(pg8::u32x4*)(rowp + bj * 128) = pk8(bf4lo(tm) + acc[ai][bj][m][0] * bf4lo(g), bf4hi(tm) + acc[ai][bj][m][1] * bf4hi(g)); asm volatile("" ::: "memory"); } }
        }
    }
};
struct SchedP8 {
    int pm, pn; const char* A; const char* B;
    __device__ __forceinline__ bool next(int i, pg8::Unit& u) const {
        if (i >= 1) return false;
        u.pm = pm; u.pn = pn; u.kind = 0; u.nt = 16; u.carry = 0; u.a = A + (size_t)pm * 256 * 1024 * 2; u.b = B + (size_t)pn * 256 * 1024 * 2; return true;
    }
};
struct EpiP8 {
    const float* x; float* out;
    __device__ __forceinline__ void operator()(f32x4 (&acc)[2][2][4][2], const pg8::Unit& u, int wr, int wc, int fr, int fq) const {
        const int row0 = u.pm * 256 + wr * 64 + fr; const int col0 = u.pn * 256 + wc * 32 + 8 * fq;
#pragma unroll
        for (int ai = 0; ai < 2; ++ai)
#pragma unroll
            for (int m = 0; m < 4; ++m) { const size_t off = (size_t)(row0 + ai * 128 + m * 16) * DM + col0;
#pragma unroll
                for (int bj = 0; bj < 2; ++bj) { const f32x4 x0 = *(const f32x4*)(x + off + bj * 128), x1 = *(const f32x4*)(x + off + bj * 128 + 4);
                    *(f32x4*)(out + off + bj * 128) = x0 + acc[ai][bj][m][0]; *(f32x4*)(out + off + bj * 128 + 4) = x1 + acc[ai][bj][m][1]; } }
    }
};
__device__ __forceinline__ void p9_final_norm(Frame& F) {
    const int gw = F.vcu * NWAVES + F.wave, NGW = F.G * NWAVES;
    const GAS f32x4* gp = (const GAS f32x4*)KIN(19) + F.lane;
    f32x4 g[4];
#pragma unroll
    for (int j = 0; j < 4; ++j) g[j] = gp[64 * j];
    for (int m = gw; m < T; m += NGW) {
        GAS f32x4* xr = (GAS f32x4*)(F.out + (size_t)m * DM) + F.lane;
        f32x4 v[4]; float s = 0.f;
#pragma unroll
        for (int j = 0; j < 4; ++j) { v[j] = xr[64 * j]; s += (v[j].x * v[j].x + v[j].y * v[j].y) + (v[j].z * v[j].z + v[j].w * v[j].w); }
        const float rstd = 1.f / sqrtf(wave_sum(s) * (1.f / DM) + RMS_EPS);
#pragma unroll
        for (int j = 0; j < 4; ++j) xr[64 * j] = v[j] * rstd * g[j];
    }
}

constexpr int N_PHASES = 10;
struct Args { const float* in[20]; float* out; unsigned char* ws; int ph_lo, ph_hi, variant, pad; };
__global__ void __launch_bounds__(NWAVES * 64, 2) hybrid_fwd(Args args) {
    extern __shared__ __attribute__((aligned(16))) unsigned char lds[];
    Frame F;
    F.lds = (LAS unsigned char*)lds; F.ldsg = lds;
    F.MISC = (volatile LAS unsigned*)(F.lds + MISC_OFF);
    F.tid = threadIdx.x; F.lane = F.tid & 63; F.wave = __builtin_amdgcn_readfirstlane(F.tid >> 6);
    F.G = gridDim.x; { const int bx = blockIdx.x; F.vcu = (bx % 8) * (F.G / 8) + bx / 8; }
    F.out = args.out; F.ws = args.ws;
    unsigned char* ws = args.ws;
    for (int u = F.tid; u < (LDS_BYTES - LDSCTL_OFF) / 4; u += NWAVES * 64) ((LAS unsigned*)(F.lds + LDSCTL_OFF))[u] = 0u;
    __syncthreads();
    const int lo = args.ph_lo, hi = args.ph_hi;
    const bool multi = (hi - lo) > 1;
    XcdBarrier bar; bar.bar = (unsigned*)(ws + WS_CTL) + CW_BAR; bar.x = 0; bar.st = nullptr;
    if (multi) bar = xcd_barrier_post((unsigned*)(ws + WS_CTL) + CW_BAR, F.MISC + 8);
#ifndef PH_MASK
#define PH_MASK 0x3ff
#endif
#define IN(k) (((PH_MASK >> (k)) & 1) && lo <= (k) && (k) < hi)
#define SEAM(k) do { if (IN(k) && IN((k) + 1)) xcd_barrier(bar); } while (0)
#define PF(Fp) Frame Fp = F; { int t_ = threadIdx.x; asm volatile("" : "+v"(t_)); Fp.tid = t_; Fp.lane = t_ & 63; Fp.wave = __builtin_amdgcn_readfirstlane(t_ >> 6); }
#ifndef RPT_MASK
#define RPT_MASK 0
#endif
#define NREP(k) (((RPT_MASK >> (k)) & 1) ? 2 : 1)
#ifndef PROBE_VARIANTS
#define PROBE_VARIANTS 0
#endif
    if (IN(0)) { PF(Fp); p0_prologue(Fp); SEAM(0); }
    if (IN(1)) {
        SchedP1 S{(int)blockIdx.x, F.G, (const char*)(ws + WS_ACOMB), (const char*)(ws + WS_WINT)};
        EpiP1 E{(bf16*)(ws + WS_UA), (bf16*)(ws + WS_UB), (float*)(ws + WS_US)};
        pg8::gemm_phase(F.lds + RING_OFF, ACOMB_LD, 1024, S, E);
        SEAM(1);
    }
    if (IN(2)) { PF(Fp); p2_prep<0>(Fp); SEAM(2); }
    if (IN(3)) { PF(Fp); p3_attention(Fp); SEAM(3); }
    if (IN(4)) { PF(Fp); p4_scan_a<0>(Fp); SEAM(4); }
    if (IN(5)) { PF(Fp); p5_scan_b<0>(Fp); SEAM(5); }
    if (IN(6)) { PF(Fp); p6_scan_c(Fp); SEAM(6); }
    const int pm = F.vcu >> 2, pn = F.vcu & 3;
    if (IN(7)) {
        SchedP7 S{pm, pn, (const char*)(ws + WS_ACOMB), (const char*)(ws + WS_WINT), (const char*)(ws + WS_WAB)};
        EpiP7 E{(v4u*)(ws + WS_UA) + (size_t)blockIdx.x * 8192, (v4u*)(ws + WS_UB) + (size_t)blockIdx.x * 8192, (bf16*)(ws + WS_MERGED)};
        pg8::gemm_phase(F.lds + RING_OFF, ACOMB_LD, 1024, S, E);
        SEAM(7);
    }
    if (IN(8)) {
        SchedP8 S{pm, pn, (const char*)(ws + WS_MERGED), (const char*)(ws + WS_WOUT)};
        EpiP8 E{KIN(0), F.out};
        pg8::gemm_phase(F.lds + RING_OFF, 1024, 1024, S, E);
        SEAM(8);
    }
    if (IN(9)) { PF(Fp); p9_final_norm(Fp); }
#undef IN
#undef SEAM
}


#if PROBE_VARIANTS
__global__ void __launch_bounds__(NWAVES * 64, 2) probe_fwd(Args args) {
    extern __shared__ __attribute__((aligned(16))) unsigned char lds[];
    Frame F;
    F.lds = (LAS unsigned char*)lds;
    F.MISC = (volatile LAS unsigned*)(F.lds + MISC_OFF);
    F.tid = threadIdx.x; F.lane = F.tid & 63; F.wave = __builtin_amdgcn_readfirstlane(F.tid >> 6);
    F.G = gridDim.x; { const int bx = blockIdx.x; F.vcu = (bx % 8) * (F.G / 8) + bx / 8; }
    F.out = args.out; F.ws = args.ws;
#ifndef PROBE_REP
#define PROBE_REP 1
#endif
    for (int rp = 0; rp < PROBE_REP; ++rp) {
    if (PROBE_VARIANTS == 1) p4_scan_a<0>(F);
    if (PROBE_VARIANTS == 2) p2_prep<1>(F);
    if (PROBE_VARIANTS == 3) p5_scan_b<1>(F);
    if (PROBE_VARIANTS == 4) p6_scan_c(F);
    if (PROBE_VARIANTS == 5) p0_prologue(F);
    __syncthreads(); }
}
#endif
#ifndef MK_N_LAUNCHES
#define MK_N_LAUNCHES 1
#endif
extern "C" void kernel_launch(void* const* d_in, const int* in_sizes, int n_in, void* d_out, int out_size, void* d_ws, size_t ws_size, hipStream_t stream) {
    static int grid = 0;
    if (grid == 0) {
        if (n_in != 20 || in_sizes[0] != T * DM || out_size != T * DM || ws_size < WS_END) { fprintf(stderr, "kernel_launch: unexpected shapes (n_in %d, in0 %d, out %d, ws %zu); nothing launched\n", n_in, n_in > 0 ? in_sizes[0] : -1, out_size, ws_size); grid = -1; return; }
        int dev = 0, cus = 0, per_cu = 0;
        if (hipGetDevice(&dev) != hipSuccess || hipDeviceGetAttribute(&cus, hipDeviceAttributeMultiprocessorCount, dev) != hipSuccess) { grid = -1; return; }
        #if PROBE_VARIANTS
        (void)hipFuncSetAttribute((const void*)probe_fwd, hipFuncAttributeMaxDynamicSharedMemorySize, LDS_BYTES);
#endif
        if (hipFuncSetAttribute((const void*)hybrid_fwd, hipFuncAttributeMaxDynamicSharedMemorySize, LDS_BYTES) != hipSuccess) { fprintf(stderr, "kernel_launch: hipFuncSetAttribute failed\n"); grid = -1; return; }
        if (hipOccupancyMaxActiveBlocksPerMultiprocessor(&per_cu, (const void*)hybrid_fwd, NWAVES * 64, LDS_BYTES) != hipSuccess || per_cu < 1) fprintf(stderr, "kernel_launch: note: occupancy query reports %d workgroups per CU\n", per_cu);
        (void)hipGetLastError();
        grid = 256;
        if (cus != 256) fprintf(stderr, "kernel_launch: device reports %d CUs; this kernel is built for 256\n", cus);
    }
    if (grid < 0) return;
    (void)hipMemsetAsync((char*)d_ws + WS_CTL, 0, CTL_ZERO_BYTES, stream);
    Args a{};
    for (int i = 0; i < 20; ++i) a.in[i] = (const float*)d_in[i];
    a.out = (float*)d_out; a.ws = (unsigned char*)d_ws;
    if (MK_N_LAUNCHES == 1) { a.ph_lo = 0; a.ph_hi = N_PHASES; hipLaunchKernelGGL(hybrid_fwd, dim3(grid), dim3(NWAVES * 64), LDS_BYTES, stream, a); }
#ifdef PROBE_LO
    if (MK_N_LAUNCHES == 1) { (void)hipMemsetAsync((char*)d_ws + WS_CTL, 0, CTL_ZERO_BYTES, stream); a.ph_lo = PROBE_LO; a.ph_hi = PROBE_HI; a.variant = PROBE_VARIANTS;
#if PROBE_VARIANTS
      hipLaunchKernelGGL(probe_fwd, dim3(grid), dim3(NWAVES * 64), LDS_BYTES, stream, a);
#else
      hipLaunchKernelGGL(hybrid_fwd, dim3(grid), dim3(NWAVES * 64), LDS_BYTES, stream, a);
#endif
    }
#endif
    else for (int p = 0; p < N_PHASES; ++p) { a.ph_lo = p; a.ph_hi = p + 1; hipLaunchKernelGGL(hybrid_fwd, dim3(grid), dim3(NWAVES * 64), LDS_BYTES, stream, a); }
}
```
